# Optimizing an MI355X kernel written in HIP

```python
import jax, jax.numpy as jnp
from jax import lax
import numpy as np

D_MODEL = 2048
BATCH = 1
SEQ = 8192
DEPTH = 4
DEC_BATCH = 16
DEC_SEQ = 32
PAST_LEN = 1024

CHUNK = 64
Q_BLOCK = 128
EPS = 1e-6
GLA_HEADS = 4
GLA_DK = 64
GLA_DV = 128
GLA_GATE_RANK = 16
GLA_TAU = 16.0
RET_HEADS = 4
RET_DK = 128
RET_DV = 128
ROPE_BASE = 10000.0
FOX_HEADS = 8
FOX_DH = 128
D_MIX = GLA_HEADS * GLA_DV + RET_HEADS * RET_DV + FOX_HEADS * FOX_DH
D_FF = -(-(8 * D_MODEL) // (3 * 256)) * 256
SPLIT_SIZES = (GLA_HEADS * GLA_DK, GLA_HEADS * GLA_DK, GLA_HEADS * GLA_DV, GLA_HEADS * GLA_DV, GLA_GATE_RANK,
               RET_HEADS * RET_DK, RET_HEADS * RET_DK, RET_HEADS * RET_DV, RET_HEADS * RET_DV,
               FOX_HEADS * FOX_DH, FOX_HEADS * FOX_DH, FOX_HEADS * FOX_DH, FOX_HEADS)
D_IN = sum(SPLIT_SIZES)

kernel_name = 'hybrid_gla_retention_fox_streaming_step'


def _rmsnorm(x, g):
    xf = x.astype(jnp.float32)
    y = xf * lax.rsqrt(jnp.mean(xf * xf, axis=-1, keepdims=True) + EPS)
    return (y * g.astype(jnp.float32)).astype(x.dtype)


def _groupnorm(x, g):
    xf = x.astype(jnp.float32)
    xc = xf - jnp.mean(xf, axis=-1, keepdims=True)
    y = xc * lax.rsqrt(jnp.mean(xc * xc, axis=-1, keepdims=True) + EPS)
    return (y * g.astype(jnp.float32)).astype(x.dtype)


def _rope(x, pos):
    half = x.shape[-1] // 2
    inv = ROPE_BASE ** (-jnp.arange(half, dtype=jnp.float32) / half)
    ang = pos.astype(jnp.float32)[:, None] * inv[None, :]
    cos = jnp.cos(ang)[None, :, None, :]
    sin = jnp.sin(ang)[None, :, None, :]
    x1 = x[..., :half].astype(jnp.float32)
    x2 = x[..., half:].astype(jnp.float32)
    return jnp.concatenate([x1 * cos - x2 * sin, x1 * sin + x2 * cos], axis=-1).astype(x.dtype)


def _gla_chunks(q, k, v, log_a, s0, chunk):
    b, t, h, dk = q.shape
    dv = v.shape[-1]
    nc = t // chunk

    def split(z):
        return z.reshape(b, nc, chunk, h, z.shape[-1]).astype(jnp.float32)

    qc, kc, vc, lac = split(q), split(k), split(v), split(log_a)
    bcum = jnp.cumsum(lac, axis=2)
    total = bcum[:, :, -1]
    u = jnp.einsum('bclhk,bclhv->cbhkv', kc * jnp.exp(total[:, :, None] - bcum), vc)
    decay = jnp.exp(jnp.moveaxis(total, 1, 0))

    def step(s, inp):
        a, uc = inp
        s = a[..., None] * s + uc
        return s, s

    s_last, s_all = lax.scan(step, s0.astype(jnp.float32), (decay, u))
    o = jnp.einsum('bclhk,cbhkv->bclhv', qc, s_all).reshape(b, t, h, dv)
    return o.astype(v.dtype), s_last


def _retention_chunks(q, k, v, s0, chunk):
    b, t, h, dk = q.shape
    dv = v.shape[-1]
    nc = t // chunk
    log_g = jnp.log1p(-jnp.exp2(-5.0 - jnp.arange(h, dtype=jnp.float32)))
    idx = jnp.arange(chunk, dtype=jnp.float32)
    d_intra = jnp.exp(log_g[:, None, None] * jnp.abs(idx[:, None] - idx[None, :]))
    q_inter = jnp.exp(log_g[None, :] * (idx[:, None] + 1.0))
    k_state = jnp.exp(log_g[None, :] * (chunk - 1.0 - idx[:, None]))
    chunk_decay = jnp.exp(log_g * chunk)[None, :, None, None]

    def split(z):
        return z.reshape(b, nc, chunk, h, z.shape[-1]).astype(jnp.float32)

    qc, kc, vc = split(q), split(k), split(v)
    scores = jnp.einsum('bclhk,bcshk->bchls', qc, kc) * d_intra
    o_intra = jnp.einsum('bchls,bcshv->bclhv', scores, vc)
    u = jnp.einsum('bclhk,bclhv->cbhkv', kc * k_state[:, :, None], vc)

    def step(s, uc):
        return chunk_decay * s + uc, s

    s_last, s_prev = lax.scan(step, s0.astype(jnp.float32), u)
    o_inter = jnp.einsum('bclhk,cbhkv->bclhv', qc, s_prev) * q_inter[:, :, None]
    return (o_intra + o_inter).reshape(b, t, h, dv).astype(v.dtype), s_last


def _fox_attend(qb, cq, qpos, k, v, ck, kpos):
    s = jnp.einsum('bqhd,bkhd->bhqk', qb, k, preferred_element_type=jnp.float32) * (qb.shape[-1] ** -0.5)
    s = s + cq[..., :, None] - ck[..., None, :]
    s = jnp.where(kpos[None, :] <= qpos[:, None], s, -jnp.inf)
    p = jax.nn.softmax(s, axis=-1).astype(v.dtype)
    return jnp.einsum('bhqk,bkhd->bqhd', p, v)


def _fox_prompt(q, k, v, logf):
    b, t, h, d = q.shape
    ck = jnp.moveaxis(jnp.cumsum(logf.astype(jnp.float32), axis=1), 1, 2)
    kpos = jnp.arange(t)

    def blk(i):
        start = i * Q_BLOCK
        qb = lax.dynamic_slice_in_dim(q, start, Q_BLOCK, axis=1)
        cq = lax.dynamic_slice_in_dim(ck, start, Q_BLOCK, axis=2)
        return _fox_attend(qb, cq, start + jnp.arange(Q_BLOCK), k, v, ck, kpos)

    out = lax.map(blk, jnp.arange(t // Q_BLOCK))
    return jnp.moveaxis(out, 0, 1).reshape(b, t, h, d)


def _fox_sample(q, k_new, v_new, lf_new, k_past, v_past, lf_past):
    p_len = k_past.shape[1]
    t = q.shape[1]
    k = jnp.concatenate([k_past.astype(k_new.dtype), k_new], axis=1)
    v = jnp.concatenate([v_past.astype(v_new.dtype), v_new], axis=1)
    lf = jnp.concatenate([lf_past.astype(jnp.float32), lf_new.astype(jnp.float32)], axis=1)
    ck = jnp.moveaxis(jnp.cumsum(lf, axis=1), 1, 2)
    return _fox_attend(q, ck[:, :, p_len:], p_len + jnp.arange(t), k, v, ck, jnp.arange(p_len + t))


def _token_mixers(xn, p, gla_s0, ret_s0, pos, chunk, fox_past):
    b, t, _ = xn.shape
    cuts = [int(c) for c in np.cumsum(SPLIT_SIZES)[:-1]]
    gq, gk, gv, gg, ga, rq, rk, rv, rg, fq, fk, fv, ff = jnp.split(xn @ p['w_in'], cuts, axis=-1)

    def heads(z, n):
        return z.reshape(b, t, n, -1)

    log_a = jax.nn.log_sigmoid((ga @ p['w_gla_gate'] + p['b_gla_gate']).astype(jnp.float32)) / GLA_TAU
    o_a, gla_s = _gla_chunks(heads(gq, GLA_HEADS) * (GLA_DK ** -0.5), heads(gk, GLA_HEADS),
                             heads(gv, GLA_HEADS), heads(log_a, GLA_HEADS), gla_s0, chunk)
    o_a = _rmsnorm(o_a, p['g_gla_out']) * jax.nn.silu(heads(gg, GLA_HEADS))
    o_b, ret_s = _retention_chunks(_rope(heads(rq, RET_HEADS), pos) * (RET_DK ** -0.5),
                                   _rope(heads(rk, RET_HEADS), pos), heads(rv, RET_HEADS), ret_s0, chunk)
    o_b = _groupnorm(o_b, p['g_ret_out']) * jax.nn.silu(heads(rg, RET_HEADS))
    fq = _rmsnorm(heads(fq, FOX_HEADS), p['g_fox_q'])
    fk = _rmsnorm(heads(fk, FOX_HEADS), p['g_fox_k'])
    fv = heads(fv, FOX_HEADS)
    logf = jax.nn.log_sigmoid(ff.astype(jnp.float32) + p['b_fox_f'].astype(jnp.float32))
    if fox_past is None:
        o_c = _fox_prompt(fq, fk, fv, logf)
    else:
        o_c = _fox_sample(fq, fk, fv, logf, fox_past[0], fox_past[1], fox_past[2])
    o_c = _rmsnorm(o_c, p['g_fox_out'])
    merged = jnp.concatenate([o_a.reshape(b, t, -1), o_b.reshape(b, t, -1), o_c.reshape(b, t, -1)], axis=-1)
    dt = xn.dtype
    return merged @ p['w_out'], (gla_s.astype(dt), ret_s.astype(dt), fk, fv, logf.astype(dt))


def _layer(x, p, gla_s0, ret_s0, pos, chunk, fox_past):
    m, st = _token_mixers(_rmsnorm(x, p['norm_mix']), p, gla_s0, ret_s0, pos, chunk, fox_past)
    h = x + m
    hn = _rmsnorm(h, p['norm_ffn'])
    y = h + (jax.nn.silu(hn @ p['w_ffn_gate']) * (hn @ p['w_ffn_up'])) @ p['w_ffn_down']
    return y, st


def setup_inputs(seed: int = 0) -> dict:
    key = jax.random.key(seed)
    ks = jax.random.split(key, 24)

    def nrm(k, shape, scale=1.0):
        return jax.random.normal(k, shape, jnp.float32) * scale

    def gain(k, shape):
        return 1.0 + 0.02 * jax.random.normal(k, shape, jnp.float32)

    return {
        'x_prompt': nrm(ks[0], (BATCH, SEQ, D_MODEL)),
        'x_sample': nrm(ks[1], (DEC_BATCH, DEC_SEQ, D_MODEL)),
        'state_gla': nrm(ks[2], (DEPTH, DEC_BATCH, GLA_HEADS, GLA_DK, GLA_DV), 0.5),
        'state_ret': nrm(ks[3], (DEPTH, DEC_BATCH, RET_HEADS, RET_DK, RET_DV), 2.0),
        'cache_fox_k': nrm(ks[4], (DEPTH, DEC_BATCH, PAST_LEN, FOX_HEADS, FOX_DH)),
        'cache_fox_v': nrm(ks[5], (DEPTH, DEC_BATCH, PAST_LEN, FOX_HEADS, FOX_DH)),
        'cache_fox_logf': jax.nn.log_sigmoid(3.0 + nrm(ks[6], (DEPTH, DEC_BATCH, PAST_LEN, FOX_HEADS))),
        'norm_mix': gain(ks[7], (DEPTH, D_MODEL)),
        'w_in': nrm(ks[8], (DEPTH, D_MODEL, D_IN), D_MODEL ** -0.5),
        'w_gla_gate': nrm(ks[9], (DEPTH, GLA_GATE_RANK, GLA_HEADS * GLA_DK), GLA_GATE_RANK ** -0.5),
        'b_gla_gate': nrm(ks[10], (DEPTH, GLA_HEADS * GLA_DK), 0.1),
        'g_gla_out': gain(ks[11], (DEPTH, GLA_DV)),
        'g_ret_out': gain(ks[12], (DEPTH, RET_DV)),
        'g_fox_q': gain(ks[13], (DEPTH, FOX_DH)),
        'g_fox_k': gain(ks[14], (DEPTH, FOX_DH)),
        'b_fox_f': 3.0 + nrm(ks[15], (DEPTH, FOX_HEADS), 0.5),
        'g_fox_out': gain(ks[16], (DEPTH, FOX_DH)),
        'w_out': nrm(ks[17], (DEPTH, D_MIX, D_MODEL), D_MIX ** -0.5),
        'norm_ffn': gain(ks[18], (DEPTH, D_MODEL)),
        'w_ffn_gate': nrm(ks[19], (DEPTH, D_MODEL, D_FF), D_MODEL ** -0.5),
        'w_ffn_up': nrm(ks[20], (DEPTH, D_MODEL, D_FF), D_MODEL ** -0.5),
        'w_ffn_down': nrm(ks[21], (DEPTH, D_FF, D_MODEL), D_FF ** -0.5),
    }


def reference(x_prompt, x_sample, state_gla, state_ret, cache_fox_k, cache_fox_v, cache_fox_logf,
              norm_mix, w_in, w_gla_gate, b_gla_gate, g_gla_out, g_ret_out, g_fox_q, g_fox_k, b_fox_f,
              g_fox_out, w_out, norm_ffn, w_ffn_gate, w_ffn_up, w_ffn_down):
    b_p, t_p, _ = x_prompt.shape
    t_s = x_sample.shape[1]
    past = cache_fox_k.shape[2]
    pos_p = jnp.arange(t_p)
    pos_s = past + jnp.arange(t_s)
    gla_zero = jnp.zeros((b_p, GLA_HEADS, GLA_DK, GLA_DV), jnp.float32)
    ret_zero = jnp.zeros((b_p, RET_HEADS, RET_DK, RET_DV), jnp.float32)
    hp, hs = x_prompt, x_sample
    st_prompt, st_sample = [], []
    for l in range(DEPTH):
        p = {'norm_mix': norm_mix[l], 'w_in': w_in[l], 'w_gla_gate': w_gla_gate[l], 'b_gla_gate': b_gla_gate[l],
             'g_gla_out': g_gla_out[l], 'g_ret_out': g_ret_out[l], 'g_fox_q': g_fox_q[l], 'g_fox_k': g_fox_k[l],
             'b_fox_f': b_fox_f[l], 'g_fox_out': g_fox_out[l], 'w_out': w_out[l], 'norm_ffn': norm_ffn[l],
             'w_ffn_gate': w_ffn_gate[l], 'w_ffn_up': w_ffn_up[l], 'w_ffn_down': w_ffn_down[l]}
        hp, stp = _layer(hp, p, gla_zero, ret_zero, pos_p, CHUNK, None)
        hs, sts = _layer(hs, p, state_gla[l], state_ret[l], pos_s, t_s,
                         (cache_fox_k[l], cache_fox_v[l], cache_fox_logf[l]))
        st_prompt.append(stp)
        st_sample.append(sts)

    def stack(states, i):
        return jnp.stack([s[i] for s in states], axis=0)

    return (hp, hs,
            stack(st_prompt, 0), stack(st_prompt, 1), stack(st_prompt, 2), stack(st_prompt, 3), stack(st_prompt, 4),
            stack(st_sample, 0), stack(st_sample, 1), stack(st_sample, 2), stack(st_sample, 3), stack(st_sample, 4))
```

```cpp
#include <hip/hip_runtime.h>
#include <cstdio>
#include <cstdint>
namespace pg8 {
#define PG8_LAS __attribute__((address_space(3)))
typedef unsigned short bf16_t;
typedef short bf16x8 __attribute__((ext_vector_type(8)));
typedef float f32x4 __attribute__((ext_vector_type(4)));
typedef unsigned u32x4 __attribute__((ext_vector_type(4)));
constexpr int BM = 256, BK = 64, HALF = 128, HTB = HALF * BK * 2  , STAGE_BYTES = 8 * HTB, NXCD = 8, WGM = 8;

__host__ __device__ __forceinline__ int lds_byte(int r, int c) { const int st = (r >> 4) * 2 + (c >> 5), rr = r & 15, cc = c & 31, ob = rr * 64 + cc * 2; return st * 1024 + (ob ^ (((ob >> 9) & 1) << 5)); }
__host__ __device__ __forceinline__ void stage_rc(int b, int& R, int& C) { const int st = b / 1024, sb = b % 1024, swz = sb ^ (((sb >> 9) & 1) << 5); R = (st >> 1) * 16 + swz / 64; C = (st & 1) * 32 + (swz % 64) / 2; }
__host__ __device__ __forceinline__ int perm32(int rho) { const int n = rho >> 4, i = rho & 15; return 8 * (i >> 2) + 4 * n + (i & 3); }

struct Unit { int pm, pn; };
struct Gemm { const bf16_t* A; const bf16_t* Bt; int M, N, K; };

struct StaticOrder {
    int nM, nN, nwg, G, c;
    __host__ __device__ void init(int M, int N, int G_, int c_) { nM = M / BM; nN = N / BM; nwg = nM * nN; G = G_; c = c_; }
    __host__ __device__ bool next(int i, Unit& u) const {
        const long L = (long)i * G + c; if (L >= nwg) return false;
        int wgid = (int)L; { const int q = nwg / NXCD, r = nwg % NXCD, xcd = wgid % NXCD, off = wgid / NXCD; wgid = (xcd < r ? xcd * (q + 1) : r * (q + 1) + (xcd - r) * q) + off; }
        const int nig = WGM * nN, gid = wgid / nig, fm = gid * WGM, gsz = (nM - fm) < WGM ? (nM - fm) : WGM;
        u.pm = fm + ((wgid % nig) % gsz); u.pn = (wgid % nig) / gsz; return true;
    }
    __device__ __forceinline__ void a_ready(const Unit&) const {}
    __device__ __forceinline__ void done(const Unit&) const {}
};

__device__ __forceinline__ unsigned cvt_pk_bf16(float lo, float hi) { unsigned r; asm volatile("v_cvt_pk_bf16_f32 %0, %1, %2" : "=v"(r) : "v"(lo), "v"(hi)); return r; }
typedef float f32x2 __attribute__((ext_vector_type(2)));
struct EpiF32 {
    static constexpr bool PERM = false, AFTER_DRAIN = false;
    float* C; int ldc;
    __device__ __forceinline__ void operator()(const f32x4 (&acc)[2][2][4][2], const Unit& u, int wr, int wc, int fr, int fq) const {
        const int row0 = u.pm * BM + wr * 64 + fr, col0 = u.pn * BM + wc * 32 + 4 * fq;
#pragma unroll
        for (int ai = 0; ai < 2; ++ai)
#pragma unroll
            for (int m = 0; m < 4; ++m) { float* rowp = C + (size_t)(row0 + ai * HALF + m * 16) * ldc + col0;
#pragma unroll
                for (int bj = 0; bj < 2; ++bj)
#pragma unroll
                    for (int n = 0; n < 2; ++n) *(f32x4*)(rowp + bj * HALF + n * 16) = acc[ai][bj][m][n]; }
    }
};
struct EpiRes {
    static constexpr bool PERM = false, AFTER_DRAIN = false;
    const float* base0; const float* base1; int split; float* out; int ldc;
    __device__ __forceinline__ void operator()(const f32x4 (&acc)[2][2][4][2], const Unit& u, int wr, int wc, int fr, int fq) const {
        const int row0 = u.pm * BM + wr * 64 + fr, col0 = u.pn * BM + wc * 32 + 4 * fq;
#pragma unroll
        for (int ai = 0; ai < 2; ++ai)
#pragma unroll
            for (int m = 0; m < 4; ++m) { const int row = row0 + ai * HALF + m * 16;
                const float* bp = (row < split ? base0 + (size_t)row * ldc : base1 + (size_t)(row - split) * ldc) + col0;
                float* rowp = out + (size_t)row * ldc + col0;
#pragma unroll
                for (int bj = 0; bj < 2; ++bj)
#pragma unroll
                    for (int n = 0; n < 2; ++n) { const f32x4 bs = *(const f32x4*)(bp + bj * HALF + n * 16); *(f32x4*)(rowp + bj * HALF + n * 16) = acc[ai][bj][m][n] + bs; } }
    }
};
__device__ __forceinline__ float silu_mul(float g, float u) { return g * u / (1.0f + __expf(-g)); }
struct EpiSwiGLU {
    static constexpr bool PERM = true, AFTER_DRAIN = false;
    bf16_t* O; int ldc;
    __device__ __forceinline__ void operator()(const f32x4 (&acc)[2][2][4][2], const Unit& u, int wr, int wc, int fr, int fq) const {
        const int row0 = u.pm * BM + wr * 64 + fr, col0 = u.pn * HALF + wc * 32 + 8 * fq;
#pragma unroll
        for (int ai = 0; ai < 2; ++ai)
#pragma unroll
            for (int m = 0; m < 4; ++m) { bf16_t* rowp = O + (size_t)(row0 + ai * HALF + m * 16) * ldc + col0;
                const f32x4 g0 = acc[ai][0][m][0], g1 = acc[ai][0][m][1], u0 = acc[ai][1][m][0], u1 = acc[ai][1][m][1];
                u32x4 w; w.x = cvt_pk_bf16(silu_mul(g0[0], u0[0]), silu_mul(g0[1], u0[1])); w.y = cvt_pk_bf16(silu_mul(g0[2], u0[2]), silu_mul(g0[3], u0[3]));
                w.z = cvt_pk_bf16(silu_mul(g1[0], u1[0]), silu_mul(g1[1], u1[1])); w.w = cvt_pk_bf16(silu_mul(g1[2], u1[2]), silu_mul(g1[3], u1[3]));
                *(u32x4*)rowp = w; }
    }
};
template <class Epi, class Sched, bool ALIGN_EPI = false, bool SP2 = false>
__device__ __forceinline__ void gemm_phase(PG8_LAS unsigned char* lds, const Gemm g, const Sched& S, const Epi& E) {
    const int tid = threadIdx.x, wid = __builtin_amdgcn_readfirstlane(tid >> 6), lane = tid & 63, wr = wid >> 2, wc = wid & 3, fr = lane & 15, fq = lane >> 4;
    const int K = g.K, nt = K / BK;
    unsigned voffA[2], voffB[2];
#pragma unroll
    for (int i = 0; i < 2; ++i) { int R, C; stage_rc(tid * 16 + i * 8192, R, C); const int Rb = Epi::PERM ? ((R & ~31) + perm32(R & 31)) : R;
        voffA[i] = (unsigned)(R * K + C) * 2u; voffB[i] = (unsigned)(Rb * K + C) * 2u; }
    const size_t kstep = (size_t)(BK * 2);
    const size_t hstep = (size_t)HALF * K * 2;
    const size_t tstep = 2 * hstep;
    const unsigned ldsw = (unsigned)wid * 1024u;
    const int aoff = lds_byte(wr * 64 + fr, fq * 8), boff = lds_byte(wc * 32 + fr, fq * 8);
#define PG8_SA(b, h) (((b) * 2 + (h)) * HTB)
#define PG8_SB(b, h) ((4 + (b) * 2 + (h)) * HTB)
#define PG8_STAGE(bufoff, gbase, voff) do { _Pragma("unroll") for (int _i = 0; _i < 2; ++_i) \
        __builtin_amdgcn_global_load_lds((const unsigned*)((const char*)(gbase) + (voff)[_i]), (PG8_LAS unsigned*)(lds + (bufoff) + ldsw + _i * 8192), 16, 0, 0); } while (0)
#define PG8_LDA(dst, b, h) do { _Pragma("unroll") for (int m = 0; m < 4; ++m) _Pragma("unroll") for (int k = 0; k < 2; ++k) dst[m][k] = *(const PG8_LAS bf16x8*)(lds + PG8_SA(b, h) + aoff + m * 2048 + k * 1024); } while (0)
#define PG8_LDB(dst, b, h) do { _Pragma("unroll") for (int n = 0; n < 2; ++n) _Pragma("unroll") for (int k = 0; k < 2; ++k) dst[n][k] = *(const PG8_LAS bf16x8*)(lds + PG8_SB(b, h) + boff + n * 2048 + k * 1024); } while (0)
#define PG8_MMA(ai, bj, At, Bt) do { __builtin_amdgcn_s_setprio(1); _Pragma("unroll") for (int m = 0; m < 4; ++m) _Pragma("unroll") for (int n = 0; n < 2; ++n) _Pragma("unroll") for (int k = 0; k < 2; ++k) \
        acc[ai][bj][m][n] = __builtin_amdgcn_mfma_f32_16x16x32_bf16(Bt[n][k], At[m][k], acc[ai][bj][m][n], 0, 0, 0); __builtin_amdgcn_s_setprio(0); } while (0)
#define PG8_WAIT_V(n) asm volatile("s_waitcnt vmcnt(" #n ")" ::: "memory")
#define PG8_WAIT_L(n) asm volatile("s_waitcnt lgkmcnt(" #n ")" ::: "memory")
#define PG8_BAR __builtin_amdgcn_s_barrier()
#define PG8_SCHED __builtin_amdgcn_sched_barrier(0)
    Unit cur, nxt; int ui = 0;
    if (!S.next(0, cur)) return;
    f32x4 acc[2][2][4][2];
#pragma unroll
    for (int a = 0; a < 2; ++a)
#pragma unroll
        for (int b = 0; b < 2; ++b)
#pragma unroll
            for (int m = 0; m < 4; ++m)
#pragma unroll
                for (int n = 0; n < 2; ++n) acc[a][b][m][n] = (f32x4){0.f, 0.f, 0.f, 0.f};
    bf16x8 At[4][2], B0[2][2], B1[2][2];
    const char* cA = (const char*)g.A + (size_t)cur.pm * tstep; const char* cB = (const char*)g.Bt + (size_t)cur.pn * tstep;
    S.a_ready(cur);
    if constexpr (SP2) {
        PG8_STAGE(PG8_SB(0, 0), cB, voffB); PG8_STAGE(PG8_SB(0, 1), cB + hstep, voffB); PG8_STAGE(PG8_SA(0, 0), cA, voffA); PG8_STAGE(PG8_SA(0, 1), cA + hstep, voffA);
        if (wr == 1) PG8_BAR;
        PG8_WAIT_V(2); PG8_BAR;
        PG8_STAGE(PG8_SB(1, 0), cB + kstep, voffB); PG8_STAGE(PG8_SA(1, 0), cA + kstep, voffA); PG8_STAGE(PG8_SB(1, 1), cB + hstep + kstep, voffB);
        PG8_WAIT_V(6); PG8_BAR;
    } else {
        PG8_STAGE(PG8_SB(0, 0), cB, voffB); PG8_STAGE(PG8_SA(0, 0), cA, voffA); PG8_STAGE(PG8_SB(0, 1), cB + hstep, voffB); PG8_STAGE(PG8_SA(0, 1), cA + hstep, voffA);
        if (wr == 1) PG8_BAR;
        PG8_WAIT_V(4); PG8_BAR;
        PG8_STAGE(PG8_SB(1, 0), cB + kstep, voffB); PG8_STAGE(PG8_SA(1, 0), cA + kstep, voffA); PG8_STAGE(PG8_SB(1, 1), cB + hstep + kstep, voffB);
        PG8_WAIT_V(6); PG8_BAR;
    }
    for (;;) {
        const bool has_next = S.next(ui + 1, nxt);
        const char* nA = has_next ? (const char*)g.A + (size_t)nxt.pm * tstep : cA; const char* nB = has_next ? (const char*)g.Bt + (size_t)nxt.pn * tstep : cB;
        for (int t = 0; t < nt; t += 2) {
            const bool last = (t == nt - 2);
            const char* a1 = cA + (size_t)(t + 1) * kstep;
            const char* a2 = last ? nA : cA + (size_t)(t + 2) * kstep; const char* b2 = last ? nB : cB + (size_t)(t + 2) * kstep;
            const char* a3 = a2 + kstep; const char* b3 = b2 + kstep;
            if (last && has_next) S.a_ready(nxt);
            if constexpr (SP2) {
            PG8_LDB(B0, 0, 0); PG8_LDB(B1, 0, 1); PG8_SCHED; PG8_LDA(At, 0, 0); PG8_STAGE(PG8_SA(1, 1), a1 + hstep, voffA);
            PG8_WAIT_V(8); PG8_WAIT_L(0); PG8_BAR; PG8_MMA(0, 0, At, B0); PG8_MMA(0, 1, At, B1); PG8_BAR; PG8_SCHED;
            PG8_LDA(At, 0, 1); PG8_STAGE(PG8_SB(0, 0), b2, voffB); PG8_STAGE(PG8_SB(0, 1), b2 + hstep, voffB); PG8_STAGE(PG8_SA(0, 0), a2, voffA);
            PG8_WAIT_V(8); PG8_WAIT_L(0); PG8_BAR; PG8_MMA(1, 0, At, B0); PG8_MMA(1, 1, At, B1); PG8_BAR; PG8_SCHED;
            PG8_LDB(B0, 1, 0); PG8_LDB(B1, 1, 1); PG8_SCHED; PG8_LDA(At, 1, 0); PG8_STAGE(PG8_SA(0, 1), a2 + hstep, voffA);
            PG8_WAIT_V(8); PG8_WAIT_L(0); PG8_BAR; PG8_MMA(0, 0, At, B0); PG8_MMA(0, 1, At, B1); PG8_BAR; PG8_SCHED;
            PG8_LDA(At, 1, 1); PG8_STAGE(PG8_SB(1, 0), b3, voffB); PG8_STAGE(PG8_SB(1, 1), b3 + hstep, voffB); PG8_STAGE(PG8_SA(1, 0), a3, voffA);
            PG8_WAIT_V(8); PG8_WAIT_L(0); PG8_BAR; PG8_MMA(1, 0, At, B0); PG8_MMA(1, 1, At, B1); PG8_BAR; PG8_SCHED;
            } else {
            PG8_LDB(B0, 0, 0); PG8_SCHED; PG8_LDA(At, 0, 0); PG8_STAGE(PG8_SA(1, 1), a1 + hstep, voffA);
            PG8_WAIT_L(8); PG8_BAR; PG8_WAIT_L(0); PG8_MMA(0, 0, At, B0); PG8_BAR; PG8_SCHED;
            PG8_LDB(B1, 0, 1); PG8_STAGE(PG8_SB(0, 0), b2, voffB);
            PG8_BAR; PG8_WAIT_L(0); PG8_MMA(0, 1, At, B1); PG8_BAR;
            PG8_LDA(At, 0, 1); PG8_STAGE(PG8_SA(0, 0), a2, voffA);
            PG8_BAR; PG8_WAIT_L(0); PG8_MMA(1, 0, At, B0); PG8_BAR; PG8_SCHED;
            PG8_STAGE(PG8_SB(0, 1), b2 + hstep, voffB);
            PG8_WAIT_V(6); PG8_BAR; PG8_MMA(1, 1, At, B1); PG8_BAR;
            PG8_LDB(B0, 1, 0); PG8_SCHED; PG8_LDA(At, 1, 0); PG8_STAGE(PG8_SA(0, 1), a2 + hstep, voffA);
            PG8_WAIT_L(8); PG8_BAR; PG8_WAIT_L(0); PG8_MMA(0, 0, At, B0); PG8_BAR; PG8_SCHED;
            PG8_LDB(B1, 1, 1); PG8_STAGE(PG8_SB(1, 0), b3, voffB);
            PG8_BAR; PG8_WAIT_L(0); PG8_MMA(0, 1, At, B1); PG8_BAR;
            PG8_LDA(At, 1, 1); PG8_STAGE(PG8_SA(1, 0), a3, voffA);
            PG8_BAR; PG8_WAIT_L(0); PG8_MMA(1, 0, At, B0); PG8_BAR; PG8_SCHED;
            PG8_STAGE(PG8_SB(1, 1), b3 + hstep, voffB);
            PG8_WAIT_V(6); PG8_BAR; PG8_MMA(1, 1, At, B1); PG8_BAR;
            }
        }
        if constexpr (ALIGN_EPI) { if (wr == 0) PG8_BAR; }
        if constexpr (!Epi::AFTER_DRAIN) { E(acc, cur, wr, wc, fr, fq); S.done(cur); }
        if (!has_next) break;
#pragma unroll
        for (int a = 0; a < 2; ++a)
#pragma unroll
            for (int b = 0; b < 2; ++b)
#pragma unroll
                for (int m = 0; m < 4; ++m)
#pragma unroll
                    for (int n = 0; n < 2; ++n) acc[a][b][m][n] = (f32x4){0.f, 0.f, 0.f, 0.f};
        cur = nxt; cA = nA; cB = nB; ++ui;
        if constexpr (ALIGN_EPI) { if (wr == 1) PG8_BAR; }
    }
    PG8_WAIT_V(0);
    if constexpr (!ALIGN_EPI) { if (wr == 0) PG8_BAR; }
    PG8_BAR;
    if constexpr (Epi::AFTER_DRAIN) { E.fused(acc, cur, wr, wc, fr, fq, lds, wid, lane); S.done(cur); }
#undef PG8_SA
#undef PG8_SB
#undef PG8_STAGE
#undef PG8_LDA
#undef PG8_LDB
#undef PG8_MMA
#undef PG8_WAIT_V
#undef PG8_WAIT_L
#undef PG8_BAR
#undef PG8_SCHED
}
}

#define LAS __attribute__((address_space(3)))
typedef unsigned short bf16;
typedef float f32x4 __attribute__((ext_vector_type(4)));
typedef unsigned u32x4v __attribute__((ext_vector_type(4)));
typedef unsigned u32x2v __attribute__((ext_vector_type(2)));

constexpr int DM = 2048, TP = 8192, NSB = 16, TS = 32, MS = NSB * TS, MT = TP + MS, NL = 4, PAST = 1024;
constexpr int DIN = 6680, DINP = 6912, DFF = 5632;
constexpr int C_GQ = 0, C_GK = 256, C_GV = 512, C_GG = 1024, C_GA = 1536, C_RQ = 1552, C_RK = 2064, C_RV = 2576, C_RG = 3088, C_FQ = 3600, C_FK = 4624, C_FV = 5648, C_FF = 6672;
constexpr float EPS = 1e-6f;
constexpr int NSLOT = 128 + NSB;
enum { I_XP = 0, I_XS, I_SGLA, I_SRET, I_CK, I_CV, I_CLF, I_NMIX, I_WIN, I_WGG, I_BGG, I_GGLA, I_GRET, I_GFQ, I_GFK, I_BFF, I_GFO, I_WOUT, I_NFFN, I_WG, I_WU, I_WD, N_IN };
constexpr size_t O_YP = 0, O_YS = O_YP + (size_t)TP * DM, O_GLAP = O_YS + (size_t)MS * DM, O_RETP = O_GLAP + (size_t)NL * 4 * 64 * 128,
                 O_FKP = O_RETP + (size_t)NL * 4 * 128 * 128, O_FVP = O_FKP + (size_t)NL * TP * 1024, O_LFP = O_FVP + (size_t)NL * TP * 1024,
                 O_GLAS = O_LFP + (size_t)NL * TP * 8, O_RETS = O_GLAS + (size_t)NL * NSB * 4 * 64 * 128, O_FKS = O_RETS + (size_t)NL * NSB * 4 * 128 * 128,
                 O_FVS = O_FKS + (size_t)NL * MS * 1024, O_LFS = O_FVS + (size_t)NL * MS * 1024, O_END = O_LFS + (size_t)NL * MS * 8;
static_assert(O_END == 96092160, "output size");
constexpr size_t al256(size_t x) { return (x + 255) & ~(size_t)255; }
constexpr size_t SZ_WIN = (size_t)DINP * DM * 2, SZ_WOUT = (size_t)DM * DM * 2, SZ_WGU = (size_t)2 * DFF * DM * 2, SZ_WDN = (size_t)DM * DFF * 2;
constexpr size_t WS_CTL = 0, WS_WIN = 1u << 20, WS_WOUT = WS_WIN + NL * SZ_WIN, WS_WGU = WS_WOUT + NL * SZ_WOUT, WS_WDN = WS_WGU + NL * SZ_WGU,
                 WS_H = WS_WDN + NL * SZ_WDN, WS_XN = WS_H + (size_t)MT * DM * 4, WS_PROJ = WS_XN + (size_t)MT * DM * 2,
                 WS_GQ = WS_PROJ + (size_t)MT * DINP * 4, WS_GK = WS_GQ + (size_t)MT * 256 * 4, WS_LA = WS_GK + (size_t)MT * 256 * 4,
                 WS_RQ = WS_LA + (size_t)MT * 256 * 4, WS_RK = WS_RQ + (size_t)MT * 512 * 4, WS_FQ = WS_RK + (size_t)MT * 512 * 4,
                 WS_LOGF = WS_FQ + (size_t)MT * 1024 * 4, WS_CKP = WS_LOGF + (size_t)MT * 8 * 4, WS_CKS = WS_CKP + (size_t)8 * TP * 4,
                 WS_GU = al256(WS_CKS + (size_t)NSB * 8 * (PAST + TS) * 4), WS_GDEC = WS_GU + (size_t)NSLOT * 4 * 64 * 128 * 4, WS_GS = WS_GDEC + (size_t)NSLOT * 4 * 64 * 4,
                 WS_RU = WS_GS + (size_t)NSLOT * 4 * 64 * 128 * 4, WS_RSP = WS_RU + (size_t)NSLOT * 4 * 128 * 128 * 4,
                 WS_MRG = WS_RSP + (size_t)NSLOT * 4 * 128 * 128 * 4, WS_ACT = WS_MRG + (size_t)MT * DM * 2, WS_END = WS_ACT + (size_t)MT * DFF * 2;

struct Ctx { const float* in[N_IN]; float* out; unsigned char* ws; };

__device__ __forceinline__ unsigned f2bf(float f) { unsigned u = __builtin_bit_cast(unsigned, f); return (u + 0x7fffu + ((u >> 16) & 1u)) >> 16; }
__device__ __forceinline__ unsigned pk2(float lo, float hi) { return f2bf(lo) | (f2bf(hi) << 16); }
__device__ __forceinline__ float wave_sum(float v) {
#pragma unroll
    for (int o = 1; o < 64; o <<= 1) v += __shfl_xor(v, o);
    return v;
}
__device__ __forceinline__ float grp8_sum(float v) { v += __shfl_xor(v, 1); v += __shfl_xor(v, 2); v += __shfl_xor(v, 4); return v; }
__device__ __forceinline__ float grp8_max(float v) { v = fmaxf(v, __shfl_xor(v, 1)); v = fmaxf(v, __shfl_xor(v, 2)); v = fmaxf(v, __shfl_xor(v, 4)); return v; }
__device__ __forceinline__ float logsigmoid_f(float x) { return fminf(x, 0.f) - log1pf(expf(-fabsf(x))); }
__device__ __forceinline__ float silu_f(float x) { return x / (1.0f + expf(-x)); }
__device__ __forceinline__ float ret_logg(int h) { return log1pf(-exp2f(-5.0f - (float)h)); }
__device__ __forceinline__ int slot_len(int slot) { return slot < 128 ? 64 : 32; }
__device__ __forceinline__ int slot_tok0(int slot) { return slot < 128 ? 64 * slot : TP + 32 * (slot - 128); }

__device__ __forceinline__ void cvt_item(const float* W, int ldw, int src_col0, int valid, bf16* out, int out_row0, int K, int k0, LAS float* scr, int lane) {
    const int c = lane & 31;
#pragma unroll 8
    for (int i = 0; i < 32; ++i) { const int kk = 2 * i + (lane >> 5); scr[kk * 33 + c] = (c < valid) ? W[(size_t)(k0 + kk) * ldw + src_col0 + c] : 0.f; }
    __builtin_amdgcn_s_waitcnt(0); asm volatile("" ::: "memory");
    const int ch = lane & 7;
#pragma unroll
    for (int j = 0; j < 4; ++j) { const int n = (lane >> 3) + 8 * j; const LAS float* s = scr + (8 * ch) * 33 + n;
        u32x4v o; o.x = pk2(s[0 * 33], s[1 * 33]); o.y = pk2(s[2 * 33], s[3 * 33]); o.z = pk2(s[4 * 33], s[5 * 33]); o.w = pk2(s[6 * 33], s[7 * 33]);
        *(u32x4v*)(out + (size_t)(out_row0 + n) * K + k0 + 8 * ch) = o; }
    __builtin_amdgcn_s_waitcnt(0); asm volatile("" ::: "memory");
}
__device__ __forceinline__ void phase_convert(const Ctx& c, int l, LAS unsigned char* lds, int bid, int nb) {
    const int lane = threadIdx.x & 63, wave = threadIdx.x >> 6;
    LAS float* scr = (LAS float*)(lds + wave * 16384);
    const int gw = bid * 8 + wave, ngw = nb * 8;
    const float* Win = c.in[I_WIN] + (size_t)l * DM * DIN; const float* Wout = c.in[I_WOUT] + (size_t)l * DM * DM;
    const float* Wg = c.in[I_WG] + (size_t)l * DM * DFF; const float* Wu = c.in[I_WU] + (size_t)l * DM * DFF; const float* Wd = c.in[I_WD] + (size_t)l * DFF * DM;
    bf16* oin = (bf16*)(c.ws + WS_WIN + l * SZ_WIN); bf16* oout = (bf16*)(c.ws + WS_WOUT + l * SZ_WOUT); bf16* ogu = (bf16*)(c.ws + WS_WGU + l * SZ_WGU); bf16* odn = (bf16*)(c.ws + WS_WDN + l * SZ_WDN);
    constexpr int NB_IN = DINP / 32, NB_OUT = DM / 32, NB_GU = 2 * DFF / 32, NB_DN = DM / 32;
    constexpr int I_IN = (DM / 64) * NB_IN, I_OUT = (DM / 64) * NB_OUT, I_GU = (DM / 64) * NB_GU, I_DN = (DFF / 64) * NB_DN;
    for (int it = gw; it < I_IN + I_OUT + I_GU + I_DN; it += ngw) {
        int r = it;
        if (r < I_IN) { const int kb = r / NB_IN, nbk = r % NB_IN, n0 = nbk * 32; int valid = DIN - n0; valid = valid < 0 ? 0 : (valid > 32 ? 32 : valid);
            cvt_item(Win, DIN, n0, valid, oin, n0, DM, kb * 64, scr, lane); continue; }
        r -= I_IN;
        if (r < I_OUT) { const int kb = r / NB_OUT, nbk = r % NB_OUT; cvt_item(Wout, DM, nbk * 32, 32, oout, nbk * 32, DM, kb * 64, scr, lane); continue; }
        r -= I_OUT;
        if (r < I_GU) { const int kb = r / NB_GU, nbk = r % NB_GU, n0 = nbk * 32; const int tile = n0 >> 8, rr = n0 & 255;
            const float* W = rr < 128 ? Wg : Wu; cvt_item(W, DFF, tile * 128 + (rr & 127), 32, ogu, n0, DM, kb * 64, scr, lane); continue; }
        r -= I_GU;
        { const int kb = r / NB_DN, nbk = r % NB_DN; cvt_item(Wd, DM, nbk * 32, 32, odn, nbk * 32, DFF, kb * 64, scr, lane); }
    }
}
__device__ __forceinline__ void phase_rmsnorm(const float* src0, const float* src1, const float* gain, bf16* xn, int bid, int nb) {
    const int lane = threadIdx.x & 63, wave = threadIdx.x >> 6;
    for (int m = bid * 8 + wave; m < MT; m += nb * 8) {
        const float* xr = m < TP ? src0 + (size_t)m * DM : src1 + (size_t)(m - TP) * DM;
        f32x4 v[8]; float s = 0.f;
#pragma unroll
        for (int j = 0; j < 8; ++j) { v[j] = *(const f32x4*)(xr + 4 * (lane + 64 * j)); s += (v[j].x * v[j].x + v[j].y * v[j].y) + (v[j].z * v[j].z + v[j].w * v[j].w); }
        const float r = rsqrtf(wave_sum(s) * (1.f / DM) + EPS);
#pragma unroll
        for (int j = 0; j < 8; ++j) { const f32x4 g = *(const f32x4*)(gain + 4 * (lane + 64 * j));
            u32x2v o; o.x = pk2(v[j].x * r * g.x, v[j].y * r * g.y); o.y = pk2(v[j].z * r * g.z, v[j].w * r * g.w);
            *(u32x2v*)(xn + (size_t)m * DM + 4 * (lane + 64 * j)) = o; }
    }
}
__device__ __forceinline__ void phase_postproj(const Ctx& c, int l, int bid, int nb) {
    const int lane = threadIdx.x & 63, wave = threadIdx.x >> 6;
    const float* PROJ = (const float*)(c.ws + WS_PROJ);
    float* GQ = (float*)(c.ws + WS_GQ); float* GK = (float*)(c.ws + WS_GK); float* LA = (float*)(c.ws + WS_LA);
    float* RQ = (float*)(c.ws + WS_RQ); float* RK = (float*)(c.ws + WS_RK); float* FQ = (float*)(c.ws + WS_FQ); float* LOGF = (float*)(c.ws + WS_LOGF);
    const float* Wgg = c.in[I_WGG] + (size_t)l * 16 * 256; const float* bgg = c.in[I_BGG] + (size_t)l * 256;
    const float* gfq = c.in[I_GFQ] + l * 128; const float* gfk = c.in[I_GFK] + l * 128; const float* bff = c.in[I_BFF] + l * 8;
    for (int m = bid * 8 + wave; m < MT; m += nb * 8) {
        const float* p = PROJ + (size_t)m * DINP;
#pragma unroll
        for (int j = 0; j < 4; ++j) { const int cc = lane + 64 * j; GQ[(size_t)m * 256 + cc] = p[C_GQ + cc] * 0.125f; GK[(size_t)m * 256 + cc] = p[C_GK + cc]; }
        float ga[16];
#pragma unroll
        for (int r = 0; r < 16; ++r) ga[r] = p[C_GA + r];
#pragma unroll
        for (int j = 0; j < 4; ++j) { const int cc = lane + 64 * j; float s = bgg[cc];
#pragma unroll
            for (int r = 0; r < 16; ++r) s += ga[r] * Wgg[r * 256 + cc];
            LA[(size_t)m * 256 + cc] = logsigmoid_f(s) * (1.f / 16.f); }
        const int pos = m < TP ? m : PAST + ((m - TP) & 31);
        const float inv = powf(10000.f, -(float)lane * (1.f / 64.f));
        const float ang = (float)pos * inv; float sn, cs; sincosf(ang, &sn, &cs);
#pragma unroll
        for (int h = 0; h < 4; ++h) {
            { const float x1 = p[C_RQ + h * 128 + lane], x2 = p[C_RQ + h * 128 + 64 + lane];
              RQ[(size_t)m * 512 + h * 128 + lane] = (x1 * cs - x2 * sn) * 0.08838834764831845f; RQ[(size_t)m * 512 + h * 128 + 64 + lane] = (x1 * sn + x2 * cs) * 0.08838834764831845f; }
            { const float x1 = p[C_RK + h * 128 + lane], x2 = p[C_RK + h * 128 + 64 + lane];
              RK[(size_t)m * 512 + h * 128 + lane] = x1 * cs - x2 * sn; RK[(size_t)m * 512 + h * 128 + 64 + lane] = x1 * sn + x2 * cs; }
        }
        float* fko = m < TP ? c.out + O_FKP + ((size_t)l * TP + m) * 1024 : c.out + O_FKS + ((size_t)l * MS + (m - TP)) * 1024;
        float* fvo = m < TP ? c.out + O_FVP + ((size_t)l * TP + m) * 1024 : c.out + O_FVS + ((size_t)l * MS + (m - TP)) * 1024;
        float* lfo = m < TP ? c.out + O_LFP + ((size_t)l * TP + m) * 8 : c.out + O_LFS + ((size_t)l * MS + (m - TP)) * 8;
        for (int h = 0; h < 8; ++h) {
            { const float a = p[C_FQ + h * 128 + lane], b = p[C_FQ + h * 128 + 64 + lane]; const float r = rsqrtf(wave_sum(a * a + b * b) * (1.f / 128.f) + EPS);
              FQ[(size_t)m * 1024 + h * 128 + lane] = a * r * gfq[lane]; FQ[(size_t)m * 1024 + h * 128 + 64 + lane] = b * r * gfq[64 + lane]; }
            { const float a = p[C_FK + h * 128 + lane], b = p[C_FK + h * 128 + 64 + lane]; const float r = rsqrtf(wave_sum(a * a + b * b) * (1.f / 128.f) + EPS);
              fko[h * 128 + lane] = a * r * gfk[lane]; fko[h * 128 + 64 + lane] = b * r * gfk[64 + lane]; }
            fvo[h * 128 + lane] = p[C_FV + h * 128 + lane]; fvo[h * 128 + 64 + lane] = p[C_FV + h * 128 + 64 + lane];
        }
        if (lane < 8) { const float v = logsigmoid_f(p[C_FF + lane] + bff[lane]); LOGF[(size_t)m * 8 + lane] = v; lfo[lane] = v; }
    }
}
__device__ __forceinline__ void phase_gla_u(const Ctx& c, LAS unsigned char* lds, int bid, int nb) {
    const int tid = threadIdx.x;
    LAS float* bc = (LAS float*)lds; LAS float* Kp = bc + 64 * 64; LAS float* Vs = Kp + 64 * 64; LAS float* tot = Vs + 64 * 128;
    const float* PROJ = (const float*)(c.ws + WS_PROJ); const float* GK = (const float*)(c.ws + WS_GK); const float* LA = (const float*)(c.ws + WS_LA);
    float* GU = (float*)(c.ws + WS_GU); float* GDEC = (float*)(c.ws + WS_GDEC);
    for (int u = bid; u < NSLOT * 4; u += nb) {
        const int slot = u >> 2, h = u & 3, L = slot_len(slot), tok0 = slot_tok0(slot);
        __syncthreads();
        for (int i = tid; i < 64 * 64; i += 512) { const int ll = i >> 6, k = i & 63; bc[i] = ll < L ? LA[(size_t)(tok0 + ll) * 256 + h * 64 + k] : 0.f; }
        __syncthreads();
        if (tid < 64) { float run = 0.f; for (int ll = 0; ll < L; ++ll) { run += bc[ll * 64 + tid]; bc[ll * 64 + tid] = run; } tot[tid] = run; GDEC[(size_t)u * 64 + tid] = expf(run); }
        __syncthreads();
        for (int i = tid; i < 64 * 64; i += 512) { const int ll = i >> 6, k = i & 63; Kp[i] = ll < L ? GK[(size_t)(tok0 + ll) * 256 + h * 64 + k] * expf(tot[k] - bc[i]) : 0.f; }
        for (int i = tid; i < 64 * 128; i += 512) { const int ll = i >> 7, v = i & 127; Vs[i] = ll < L ? PROJ[(size_t)(tok0 + ll) * DINP + C_GV + h * 128 + v] : 0.f; }
        __syncthreads();
        const int k = tid >> 3, v0 = (tid & 7) * 16; float acc[16];
#pragma unroll
        for (int i = 0; i < 16; ++i) acc[i] = 0.f;
        for (int ll = 0; ll < L; ++ll) { const float kv = Kp[ll * 64 + k];
#pragma unroll
            for (int i = 0; i < 16; ++i) acc[i] += kv * Vs[ll * 128 + v0 + i]; }
#pragma unroll
        for (int i = 0; i < 16; ++i) GU[((size_t)u * 64 + k) * 128 + v0 + i] = acc[i];
    }
}
__device__ __forceinline__ void phase_gla_scan(const Ctx& c, int l, int bid, int nb) {
    const float* GU = (const float*)(c.ws + WS_GU); const float* GDEC = (const float*)(c.ws + WS_GDEC); float* GS = (float*)(c.ws + WS_GS);
    constexpr int E = 4 * 64 * 128;
    for (int w = bid; w < (1 + NSB) * (E / 512); w += nb) {
        const int seq = w / (E / 512), e = (w % (E / 512)) * 512 + threadIdx.x, hk = e >> 7;
        if (seq == 0) { float S = 0.f;
            for (int cidx = 0; cidx < 128; ++cidx) { S = GDEC[(size_t)cidx * 256 + hk] * S + GU[(size_t)cidx * E + e]; GS[(size_t)cidx * E + e] = S; }
            c.out[O_GLAP + (size_t)l * E + e] = S;
        } else { const int b = seq - 1, slot = 128 + b; const float s0 = c.in[I_SGLA][((size_t)l * NSB + b) * E + e];
            const float S = GDEC[(size_t)slot * 256 + hk] * s0 + GU[(size_t)slot * E + e]; GS[(size_t)slot * E + e] = S; c.out[O_GLAS + ((size_t)l * NSB + b) * E + e] = S; }
    }
}
__device__ __forceinline__ void phase_gla_o(const Ctx& c, int l, LAS unsigned char* lds, int bid, int nb) {
    const int tid = threadIdx.x;
    LAS float* Ss = (LAS float*)lds; LAS float* Qs = Ss + 64 * 128;
    const float* PROJ = (const float*)(c.ws + WS_PROJ); const float* GQ = (const float*)(c.ws + WS_GQ); const float* GS = (const float*)(c.ws + WS_GS);
    const float* gg = c.in[I_GGLA] + l * 128; bf16* MRG = (bf16*)(c.ws + WS_MRG);
    for (int u = bid; u < NSLOT * 4; u += nb) {
        const int slot = u >> 2, h = u & 3, L = slot_len(slot), tok0 = slot_tok0(slot);
        __syncthreads();
        for (int i = tid; i < 64 * 128; i += 512) Ss[i] = GS[(size_t)u * 8192 + i];
        for (int i = tid; i < 64 * 64; i += 512) { const int ll = i >> 6, k = i & 63; Qs[ll * 68 + k] = ll < L ? GQ[(size_t)(tok0 + ll) * 256 + h * 64 + k] : 0.f; }
        __syncthreads();
        const int ll = tid >> 3, v0 = (tid & 7) * 16; float o[16];
#pragma unroll
        for (int i = 0; i < 16; ++i) o[i] = 0.f;
        for (int k = 0; k < 64; ++k) { const float q = Qs[ll * 68 + k];
#pragma unroll
            for (int i = 0; i < 16; ++i) o[i] += q * Ss[k * 128 + v0 + i]; }
        float ss = 0.f;
#pragma unroll
        for (int i = 0; i < 16; ++i) ss += o[i] * o[i];
        ss = grp8_sum(ss); const float r = rsqrtf(ss * (1.f / 128.f) + EPS);
        if (ll < L) { const int tok = tok0 + ll; const float* gate = PROJ + (size_t)tok * DINP + C_GG + h * 128 + v0; bf16* op = MRG + (size_t)tok * DM + h * 128 + v0;
#pragma unroll
            for (int i = 0; i < 16; i += 2) *(unsigned*)(op + i) = pk2(o[i] * r * gg[v0 + i] * silu_f(gate[i]), o[i + 1] * r * gg[v0 + i + 1] * silu_f(gate[i + 1])); }
    }
}
__device__ __forceinline__ void phase_ret_u(const Ctx& c, LAS unsigned char* lds, int bid, int nb) {
    const int tid = threadIdx.x;
    LAS float* Kp = (LAS float*)lds; LAS float* Vs = Kp + 64 * 128;
    const float* PROJ = (const float*)(c.ws + WS_PROJ); const float* RK = (const float*)(c.ws + WS_RK); float* RU = (float*)(c.ws + WS_RU);
    for (int u = bid; u < NSLOT * 4; u += nb) {
        const int slot = u >> 2, h = u & 3, L = slot_len(slot), tok0 = slot_tok0(slot); const float lg = ret_logg(h);
        __syncthreads();
        for (int i = tid; i < 64 * 128; i += 512) { const int ll = i >> 7, k = i & 127;
            Kp[i] = ll < L ? RK[(size_t)(tok0 + ll) * 512 + h * 128 + k] * expf(lg * (float)(L - 1 - ll)) : 0.f;
            Vs[i] = ll < L ? PROJ[(size_t)(tok0 + ll) * DINP + C_RV + h * 128 + k] : 0.f; }
        __syncthreads();
        const int k = tid >> 2, v0 = (tid & 3) * 32; float acc[32];
#pragma unroll
        for (int i = 0; i < 32; ++i) acc[i] = 0.f;
        for (int ll = 0; ll < L; ++ll) { const float kv = Kp[ll * 128 + k];
#pragma unroll
            for (int i = 0; i < 32; ++i) acc[i] += kv * Vs[ll * 128 + v0 + i]; }
#pragma unroll
        for (int i = 0; i < 32; ++i) RU[((size_t)u * 128 + k) * 128 + v0 + i] = acc[i];
    }
}
__device__ __forceinline__ void phase_ret_scan(const Ctx& c, int l, int bid, int nb) {
    const float* RU = (const float*)(c.ws + WS_RU); float* RSP = (float*)(c.ws + WS_RSP);
    constexpr int E = 4 * 128 * 128;
    for (int w = bid; w < (1 + NSB) * (E / 512); w += nb) {
        const int seq = w / (E / 512), e = (w % (E / 512)) * 512 + threadIdx.x, h = e >> 14; const float lg = ret_logg(h);
        if (seq == 0) { const float dec = expf(lg * 64.f); float S = 0.f;
            for (int cidx = 0; cidx < 128; ++cidx) { RSP[(size_t)cidx * E + e] = S; S = dec * S + RU[(size_t)cidx * E + e]; }
            c.out[O_RETP + (size_t)l * E + e] = S;
        } else { const int b = seq - 1, slot = 128 + b; const float s0 = c.in[I_SRET][((size_t)l * NSB + b) * E + e];
            RSP[(size_t)slot * E + e] = s0; c.out[O_RETS + ((size_t)l * NSB + b) * E + e] = expf(lg * 32.f) * s0 + RU[(size_t)slot * E + e]; }
    }
}
__device__ __forceinline__ void phase_ret_o(const Ctx& c, int l, LAS unsigned char* lds, int bid, int nb) {
    const int tid = threadIdx.x;
    LAS float* Qs = (LAS float*)lds; LAS float* Ks = Qs + 64 * 132; LAS float* Vs = Ks + 64 * 132; LAS float* Sc = Vs + 64 * 128;
    const float* PROJ = (const float*)(c.ws + WS_PROJ); const float* RQ = (const float*)(c.ws + WS_RQ); const float* RK = (const float*)(c.ws + WS_RK); const float* RSP = (const float*)(c.ws + WS_RSP);
    const float* gr = c.in[I_GRET] + l * 128; bf16* MRG = (bf16*)(c.ws + WS_MRG);
    for (int u = bid; u < NSLOT * 4; u += nb) {
        const int slot = u >> 2, h = u & 3, L = slot_len(slot), tok0 = slot_tok0(slot); const float lg = ret_logg(h);
        __syncthreads();
        for (int i = tid; i < 64 * 128; i += 512) { const int ll = i >> 7, k = i & 127; const bool ok = ll < L;
            Qs[ll * 132 + k] = ok ? RQ[(size_t)(tok0 + ll) * 512 + h * 128 + k] : 0.f; Ks[ll * 132 + k] = ok ? RK[(size_t)(tok0 + ll) * 512 + h * 128 + k] : 0.f;
            Vs[i] = ok ? PROJ[(size_t)(tok0 + ll) * DINP + C_RV + h * 128 + k] : 0.f; }
        __syncthreads();
        const int ll = tid >> 3, g = tid & 7;
        { float s[8];
#pragma unroll
          for (int j = 0; j < 8; ++j) s[j] = 0.f;
          for (int d = 0; d < 128; ++d) { const float q = Qs[ll * 132 + d];
#pragma unroll
              for (int j = 0; j < 8; ++j) s[j] += q * Ks[(g * 8 + j) * 132 + d]; }
#pragma unroll
          for (int j = 0; j < 8; ++j) { const int si = g * 8 + j; const int dd = ll > si ? ll - si : si - ll; Sc[ll * 68 + si] = s[j] * expf(lg * (float)dd); } }
        __syncthreads();
        const int v0 = g * 16; float o[16], o2[16];
#pragma unroll
        for (int i = 0; i < 16; ++i) { o[i] = 0.f; o2[i] = 0.f; }
        for (int si = 0; si < L; ++si) { const float p = Sc[ll * 68 + si];
#pragma unroll
            for (int i = 0; i < 16; ++i) o[i] += p * Vs[si * 128 + v0 + i]; }
        const float* Sp = RSP + (size_t)u * 16384 + v0;
        for (int k = 0; k < 128; ++k) { const float q = Qs[ll * 132 + k]; const f32x4 a = *(const f32x4*)(Sp + (size_t)k * 128), b = *(const f32x4*)(Sp + (size_t)k * 128 + 4), cc = *(const f32x4*)(Sp + (size_t)k * 128 + 8), d = *(const f32x4*)(Sp + (size_t)k * 128 + 12);
            o2[0] += q * a.x; o2[1] += q * a.y; o2[2] += q * a.z; o2[3] += q * a.w; o2[4] += q * b.x; o2[5] += q * b.y; o2[6] += q * b.z; o2[7] += q * b.w;
            o2[8] += q * cc.x; o2[9] += q * cc.y; o2[10] += q * cc.z; o2[11] += q * cc.w; o2[12] += q * d.x; o2[13] += q * d.y; o2[14] += q * d.z; o2[15] += q * d.w; }
        const float qi = expf(lg * (float)(ll + 1)); float sm = 0.f;
#pragma unroll
        for (int i = 0; i < 16; ++i) { o[i] += o2[i] * qi; sm += o[i]; }
        const float mean = grp8_sum(sm) * (1.f / 128.f); float sq = 0.f;
#pragma unroll
        for (int i = 0; i < 16; ++i) { o[i] -= mean; sq += o[i] * o[i]; }
        const float r = rsqrtf(grp8_sum(sq) * (1.f / 128.f) + EPS);
        if (ll < L) { const int tok = tok0 + ll; const float* gate = PROJ + (size_t)tok * DINP + C_RG + h * 128 + v0; bf16* op = MRG + (size_t)tok * DM + 512 + h * 128 + v0;
#pragma unroll
            for (int i = 0; i < 16; i += 2) *(unsigned*)(op + i) = pk2(o[i] * r * gr[v0 + i] * silu_f(gate[i]), o[i + 1] * r * gr[v0 + i + 1] * silu_f(gate[i + 1])); }
    }
}
__device__ __forceinline__ void phase_fox_cumsum(const Ctx& c, int l, LAS unsigned char* lds, int bid, int nb) {
    const int tid = threadIdx.x; LAS float* tot = (LAS float*)lds;
    const float* LOGF = (const float*)(c.ws + WS_LOGF); float* CKP = (float*)(c.ws + WS_CKP); float* CKS = (float*)(c.ws + WS_CKS);
    for (int u = bid; u < 8 + NSB * 8; u += nb) {
        __syncthreads();
        if (u < 8) { const int h = u; float v[16]; float run = 0.f;
#pragma unroll
            for (int i = 0; i < 16; ++i) { run += LOGF[(size_t)(tid * 16 + i) * 8 + h]; v[i] = run; }
            tot[tid] = run; __syncthreads();
            if (tid == 0) { float r2 = 0.f; for (int i = 0; i < 512; ++i) { const float t = tot[i]; tot[i] = r2; r2 += t; } }
            __syncthreads(); const float off = tot[tid];
#pragma unroll
            for (int i = 0; i < 16; ++i) CKP[(size_t)h * TP + tid * 16 + i] = v[i] + off;
        } else { const int bh = u - 8, b = bh >> 3, h = bh & 7; float v[3]; float run = 0.f;
#pragma unroll
            for (int i = 0; i < 3; ++i) { const int j = tid * 3 + i; float x = 0.f;
                if (j < PAST) x = c.in[I_CLF][(((size_t)l * NSB + b) * PAST + j) * 8 + h]; else if (j < PAST + TS) x = LOGF[(size_t)(TP + b * TS + (j - PAST)) * 8 + h];
                run += x; v[i] = run; }
            tot[tid] = run; __syncthreads();
            if (tid == 0) { float r2 = 0.f; for (int i = 0; i < 512; ++i) { const float t = tot[i]; tot[i] = r2; r2 += t; } }
            __syncthreads(); const float off = tot[tid];
#pragma unroll
            for (int i = 0; i < 3; ++i) { const int j = tid * 3 + i; if (j < PAST + TS) CKS[(size_t)bh * (PAST + TS) + j] = v[i] + off; }
        }
    }
}
__device__ __forceinline__ void fox_attn_unit(const float* Qp, int nq, const float* K0, const float* K1, const float* V0, const float* V1, int P, int nkeys, int qpos0,
                                              const float* ckq, const float* ckk, const float* gout, bf16* outp, LAS unsigned char* lds) {
    const int tid = threadIdx.x, q = tid >> 3, g = tid & 7;
    LAS float* Qs = (LAS float*)lds; LAS float* Ks = Qs + 64 * 132; LAS float* Vs = Ks + 64 * 132; LAS float* Ps = Vs + 64 * 128;
    __syncthreads();
    for (int i = tid; i < 64 * 32; i += 512) { const int r = i >> 5, c4 = i & 31; f32x4 v = {0.f, 0.f, 0.f, 0.f}; if (r < nq) v = *(const f32x4*)(Qp + (size_t)r * 1024 + c4 * 4); *(LAS f32x4*)(Qs + r * 132 + c4 * 4) = v; }
    float m_run = -1e30f, l_run = 0.f, o[16];
#pragma unroll
    for (int i = 0; i < 16; ++i) o[i] = 0.f;
    const float cq = q < nq ? ckq[q] : 0.f; const int qpos = qpos0 + q;
    const int ntiles = (nkeys + 63) >> 6;
    for (int kt = 0; kt < ntiles; ++kt) {
        __syncthreads();
        for (int i = tid; i < 64 * 32; i += 512) { const int r = i >> 5, c4 = i & 31, j = kt * 64 + r; f32x4 kv = {0.f, 0.f, 0.f, 0.f}, vv = {0.f, 0.f, 0.f, 0.f};
            if (j < nkeys) { const float* kr = j < P ? K0 + (size_t)j * 1024 : K1 + (size_t)(j - P) * 1024; const float* vr = j < P ? V0 + (size_t)j * 1024 : V1 + (size_t)(j - P) * 1024;
                kv = *(const f32x4*)(kr + c4 * 4); vv = *(const f32x4*)(vr + c4 * 4); }
            *(LAS f32x4*)(Ks + r * 132 + c4 * 4) = kv; *(LAS f32x4*)(Vs + r * 128 + c4 * 4) = vv; }
        __syncthreads();
        float s[8];
#pragma unroll
        for (int j = 0; j < 8; ++j) s[j] = 0.f;
        for (int d = 0; d < 128; d += 4) { const f32x4 qv = *(const LAS f32x4*)(Qs + q * 132 + d);
#pragma unroll
            for (int j = 0; j < 8; ++j) { const f32x4 kv = *(const LAS f32x4*)(Ks + (g * 8 + j) * 132 + d); s[j] += (qv.x * kv.x + qv.y * kv.y) + (qv.z * kv.z + qv.w * kv.w); } }
        float tmax = -__builtin_inff();
#pragma unroll
        for (int j = 0; j < 8; ++j) { const int kj = kt * 64 + g * 8 + j;
            if (kj < nkeys && kj <= qpos) s[j] = s[j] * 0.08838834764831845f + (cq - ckk[kj]); else s[j] = -__builtin_inff();
            tmax = fmaxf(tmax, s[j]); }
        tmax = grp8_max(tmax);
        const float m_new = fmaxf(m_run, tmax), alpha = expf(m_run - m_new); float psum = 0.f;
#pragma unroll
        for (int j = 0; j < 8; ++j) { const float p = expf(s[j] - m_new); psum += p; Ps[q * 68 + g * 8 + j] = p; }
        psum = grp8_sum(psum); l_run = l_run * alpha + psum; m_run = m_new;
#pragma unroll
        for (int i = 0; i < 16; ++i) o[i] *= alpha;
        __syncthreads();
        for (int j = 0; j < 64; ++j) { const float p = Ps[q * 68 + j];
#pragma unroll
            for (int i = 0; i < 16; ++i) o[i] += p * Vs[j * 128 + g * 16 + i]; }
    }
    const float il = 1.f / l_run; float ss = 0.f;
#pragma unroll
    for (int i = 0; i < 16; ++i) { o[i] *= il; ss += o[i] * o[i]; }
    const float r = rsqrtf(grp8_sum(ss) * (1.f / 128.f) + EPS);
    if (q < nq) { bf16* op = outp + (size_t)q * DM + g * 16;
#pragma unroll
        for (int i = 0; i < 16; i += 2) *(unsigned*)(op + i) = pk2(o[i] * r * gout[g * 16 + i], o[i + 1] * r * gout[g * 16 + i + 1]); }
}
__device__ __forceinline__ void phase_fox_attn(const Ctx& c, int l, LAS unsigned char* lds, int bid, int nb) {
    const float* FQ = (const float*)(c.ws + WS_FQ); const float* CKP = (const float*)(c.ws + WS_CKP); const float* CKS = (const float*)(c.ws + WS_CKS);
    const float* gout = c.in[I_GFO] + l * 128; bf16* MRG = (bf16*)(c.ws + WS_MRG);
    constexpr int NPU = 8 * 128;
    const int rounds = (NPU + nb - 1) / nb;
    for (int r = 0; r < rounds; ++r) {
        const int idx = r * nb + ((r & 1) ? (nb - 1 - bid) : bid); if (idx >= NPU) continue;
        const int qi = 127 - (idx >> 3), h = idx & 7, tok0 = qi * 64;
        const float* Kb = c.out + O_FKP + (size_t)l * TP * 1024 + h * 128; const float* Vb = c.out + O_FVP + (size_t)l * TP * 1024 + h * 128;
        fox_attn_unit(FQ + (size_t)tok0 * 1024 + h * 128, 64, Kb, Kb, Vb, Vb, 1 << 30, tok0 + 64, tok0, CKP + (size_t)h * TP + tok0, CKP + (size_t)h * TP, gout,
                      MRG + (size_t)tok0 * DM + 1024 + h * 128, lds);
    }
    for (int u = bid; u < NSB * 8; u += nb) {
        const int b = u >> 3, h = u & 7, tok0 = TP + b * TS;
        const float* K0 = c.in[I_CK] + ((size_t)l * NSB + b) * PAST * 1024 + h * 128; const float* V0 = c.in[I_CV] + ((size_t)l * NSB + b) * PAST * 1024 + h * 128;
        const float* K1 = c.out + O_FKS + ((size_t)l * MS + b * TS) * 1024 + h * 128; const float* V1 = c.out + O_FVS + ((size_t)l * MS + b * TS) * 1024 + h * 128;
        const float* ck = CKS + (size_t)u * (PAST + TS);
        fox_attn_unit(FQ + (size_t)tok0 * 1024 + h * 128, TS, K0, K1, V0, V1, PAST, PAST + TS, PAST, ck + PAST, ck, gout, MRG + (size_t)tok0 * DM + 1024 + h * 128, lds);
    }
}

constexpr int LDS_BYTES = 147456;
#define KARGS const Ctx c, int l
#define SHM extern __shared__ __attribute__((aligned(16))) unsigned char shm[]; LAS unsigned char* lds = (LAS unsigned char*)shm
__global__ void __launch_bounds__(512, 2) k_convert(KARGS) { SHM; phase_convert(c, l, lds, blockIdx.x, gridDim.x); }
__global__ void __launch_bounds__(512, 2) k_norm1(KARGS) { const float* s0 = l == 0 ? c.in[I_XP] : (const float*)(c.ws + WS_H); const float* s1 = l == 0 ? c.in[I_XS] : (const float*)(c.ws + WS_H) + (size_t)TP * DM;
    phase_rmsnorm(s0, s1, c.in[I_NMIX] + (size_t)l * DM, (bf16*)(c.ws + WS_XN), blockIdx.x, gridDim.x); }
__global__ void __launch_bounds__(512, 2) k_norm2(KARGS) { const float* s0 = (const float*)(c.ws + WS_H);
    phase_rmsnorm(s0, s0 + (size_t)TP * DM, c.in[I_NFFN] + (size_t)l * DM, (bf16*)(c.ws + WS_XN), blockIdx.x, gridDim.x); }
__global__ void __launch_bounds__(512, 2) k_gemm_in(KARGS) { SHM;
    pg8::Gemm g{(const bf16*)(c.ws + WS_XN), (const bf16*)(c.ws + WS_WIN + l * SZ_WIN), MT, DINP, DM}; pg8::StaticOrder S; S.init(MT, DINP, gridDim.x, blockIdx.x);
    pg8::EpiF32 E{(float*)(c.ws + WS_PROJ), DINP}; pg8::gemm_phase<pg8::EpiF32, pg8::StaticOrder, true, true>(lds, g, S, E); }
__global__ void __launch_bounds__(512, 2) k_gemm_out(KARGS) { SHM;
    pg8::Gemm g{(const bf16*)(c.ws + WS_MRG), (const bf16*)(c.ws + WS_WOUT + l * SZ_WOUT), MT, DM, DM}; pg8::StaticOrder S; S.init(MT, DM, gridDim.x, blockIdx.x);
    float* H = (float*)(c.ws + WS_H);
    pg8::EpiRes E{l == 0 ? c.in[I_XP] : H, l == 0 ? c.in[I_XS] : H + (size_t)TP * DM, TP, H, DM}; pg8::gemm_phase<pg8::EpiRes, pg8::StaticOrder, true, true>(lds, g, S, E); }
__global__ void __launch_bounds__(512, 2) k_gemm_gu(KARGS) { SHM;
    pg8::Gemm g{(const bf16*)(c.ws + WS_XN), (const bf16*)(c.ws + WS_WGU + l * SZ_WGU), MT, 2 * DFF, DM}; pg8::StaticOrder S; S.init(MT, 2 * DFF, gridDim.x, blockIdx.x);
    pg8::EpiSwiGLU E{(bf16*)(c.ws + WS_ACT), DFF}; pg8::gemm_phase<pg8::EpiSwiGLU, pg8::StaticOrder, true, true>(lds, g, S, E); }
__global__ void __launch_bounds__(512, 2) k_gemm_dn(KARGS) { SHM;
    pg8::Gemm g{(const bf16*)(c.ws + WS_ACT), (const bf16*)(c.ws + WS_WDN + l * SZ_WDN), MT, DM, DFF}; pg8::StaticOrder S; S.init(MT, DM, gridDim.x, blockIdx.x);
    float* H = (float*)(c.ws + WS_H); float* dst = l == NL - 1 ? c.out + O_YP : H;
    pg8::EpiRes E{H, H + (size_t)TP * DM, TP, dst, DM}; pg8::gemm_phase<pg8::EpiRes, pg8::StaticOrder, true, true>(lds, g, S, E); }
__global__ void __launch_bounds__(512, 2) k_postproj(KARGS) { phase_postproj(c, l, blockIdx.x, gridDim.x); }
__global__ void __launch_bounds__(512, 2) k_mix1(KARGS) { SHM; phase_gla_u(c, lds, blockIdx.x, gridDim.x); phase_ret_u(c, lds, blockIdx.x, gridDim.x); phase_fox_cumsum(c, l, lds, blockIdx.x, gridDim.x); }
__global__ void __launch_bounds__(512, 2) k_mix2(KARGS) { SHM; phase_gla_scan(c, l, blockIdx.x, gridDim.x); phase_ret_scan(c, l, blockIdx.x, gridDim.x); phase_fox_attn(c, l, lds, blockIdx.x, gridDim.x); }
__global__ void __launch_bounds__(512, 2) k_mix3(KARGS) { SHM; phase_gla_o(c, l, lds, blockIdx.x, gridDim.x); phase_ret_o(c, l, lds, blockIdx.x, gridDim.x); }

extern "C" void kernel_launch(void* const* d_in, const int* in_sizes, int n_in, void* d_out, int out_size, void* d_ws, size_t ws_size, hipStream_t stream) {
    if (n_in != N_IN || (size_t)out_size != O_END || ws_size < WS_END) { fprintf(stderr, "kernel_launch: unexpected shapes (n_in %d out %d ws %zu, need %zu)\n", n_in, out_size, ws_size, (size_t)WS_END); return; }
    Ctx c{}; for (int i = 0; i < N_IN; ++i) c.in[i] = (const float*)d_in[i]; c.out = (float*)d_out; c.ws = (unsigned char*)d_ws;
    const void* ks[] = {(const void*)k_convert, (const void*)k_norm1, (const void*)k_norm2, (const void*)k_gemm_in, (const void*)k_gemm_out, (const void*)k_gemm_gu, (const void*)k_gemm_dn,
                        (const void*)k_postproj, (const void*)k_mix1, (const void*)k_mix2, (const void*)k_mix3};
    for (const void* k : ks) (void)hipFuncSetAttribute(k, hipFuncAttributeMaxDynamicSharedMemorySize, LDS_BYTES);
    const dim3 G(256), B(512);
    for (int l = 0; l < NL; ++l) hipLaunchKernelGGL(k_convert, G, B, LDS_BYTES, stream, c, l);
    for (int l = 0; l < NL; ++l) {
        hipLaunchKernelGGL(k_norm1, G, B, LDS_BYTES, stream, c, l);
        hipLaunchKernelGGL(k_gemm_in, G, B, LDS_BYTES, stream, c, l);
        hipLaunchKernelGGL(k_postproj, G, B, LDS_BYTES, stream, c, l);
        hipLaunchKernelGGL(k_mix1, G, B, LDS_BYTES, stream, c, l);
        hipLaunchKernelGGL(k_mix2, G, B, LDS_BYTES, stream, c, l);
        hipLaunchKernelGGL(k_mix3, G, B, LDS_BYTES, stream, c, l);
        hipLaunchKernelGGL(k_gemm_out, G, B, LDS_BYTES, stream, c, l);
        hipLaunchKernelGGL(k_norm2, G, B, LDS_BYTES, stream, c, l);
        hipLaunchKernelGGL(k_gemm_gu, G, B, LDS_BYTES, stream, c, l);
        hipLaunchKernelGGL(k_gemm_dn, G, B, LDS_BYTES, stream, c, l);
    }
}
```

```cpp
#include <hip/hip_runtime.h>
#include <cstdio>
#include <cstdint>
namespace pg8 {
#define PG8_LAS __attribute__((address_space(3)))
typedef unsigned short bf16_t;
typedef short bf16x8 __attribute__((ext_vector_type(8)));
typedef float f32x4 __attribute__((ext_vector_type(4)));
typedef unsigned u32x4 __attribute__((ext_vector_type(4)));
constexpr int BM = 256, BK = 64, HALF = 128, HTB = HALF * BK * 2  , STAGE_BYTES = 8 * HTB, NXCD = 8, WGM = 4;

__host__ __device__ __forceinline__ int lds_byte(int r, int c) { const int st = (r >> 4) * 2 + (c >> 5), rr = r & 15, cc = c & 31, ob = rr * 64 + cc * 2; return st * 1024 + (ob ^ (((ob >> 9) & 1) << 5)); }
__host__ __device__ __forceinline__ void stage_rc(int b, int& R, int& C) { const int st = b / 1024, sb = b % 1024, swz = sb ^ (((sb >> 9) & 1) << 5); R = (st >> 1) * 16 + swz / 64; C = (st & 1) * 32 + (swz % 64) / 2; }
__host__ __device__ __forceinline__ int perm32(int rho) { const int n = rho >> 4, i = rho & 15; return 8 * (i >> 2) + 4 * n + (i & 3); }

struct Unit { int pm, pn, ko; };
struct Gemm { const bf16_t* A; const bf16_t* Bt; int M, N, K, KL; const bf16_t* As = nullptr; };

struct StaticOrder {
    int nM, nN, nwg, G, c; bool mix27 = false;
    __host__ __device__ void init(int M, int N, int G_, int c_) { nM = M / BM; nN = N / BM; nwg = nM * nN; G = G_; c = c_; }
    __host__ __device__ bool next(int i, Unit& u) const {
        const long L = (long)i * G + c; if (L >= nwg) return false;
        int wgid = (int)L; { const int q = nwg / NXCD, r = nwg % NXCD, xcd = wgid % NXCD, off = wgid / NXCD; wgid = (xcd < r ? xcd * (q + 1) : r * (q + 1) + (xcd - r) * q) + off; }
        const int nig = WGM * nN, gid = wgid / nig, fm = gid * WGM, gsz = (nM - fm) < WGM ? (nM - fm) : WGM;
        u.pm = fm + ((wgid % nig) % gsz); u.pn = (wgid % nig) / gsz; u.ko = 0;
        if (mix27) { const unsigned long long lo = 0x110310020f010e00ull, mi = 0x0814071306120504ull, hi = 0x180c170b160a0915ull, tp = 0x1a190dull;
            const int q = u.pn >> 3, s = (u.pn & 7) * 8; u.pn = (int)(((q == 0 ? lo : q == 1 ? mi : q == 2 ? hi : tp) >> s) & 0xff); }
        return true;
    }
    __device__ __forceinline__ void a_ready(const Unit&) const {}
    __device__ __forceinline__ void done(const Unit&) const {}
};

__device__ __forceinline__ unsigned cvt_pk_bf16(float lo, float hi) { unsigned r; asm volatile("v_cvt_pk_bf16_f32 %0, %1, %2" : "=v"(r) : "v"(lo), "v"(hi)); return r; }
typedef float f32x2 __attribute__((ext_vector_type(2)));
template <bool RB, bool OF>
struct EpiResT {
    static constexpr bool PERM = false, AFTER_DRAIN = false;
    typedef unsigned u32x2 __attribute__((ext_vector_type(2)));
    const float* base0; const float* base1; int split; float* out; int ldc; bf16_t* hb; float* ssp; PG8_LAS float* X; const bf16_t* rb;
    static __device__ __forceinline__ f32x4 unpack(const u32x2 w) { f32x4 r; r[0] = __uint_as_float(w.x << 16); r[1] = __uint_as_float(w.x & 0xffff0000u); r[2] = __uint_as_float(w.y << 16); r[3] = __uint_as_float(w.y & 0xffff0000u); return r; }
    __device__ __forceinline__ void operator()(const f32x4 (&acc)[2][2][4][2], const Unit& u, int wr, int wc, int fr_in, int fq_in) const {
        int fr = fr_in, fq = fq_in; asm volatile("" : "+v"(fr), "+v"(fq));
        const int row0 = u.pm * BM + wr * 64 + fr, col0 = u.pn * BM + wc * 32 + 4 * fq;
#pragma unroll
        for (int ai = 0; ai < 2; ++ai) {
            f32x4 bs[4][2][2]; u32x2 bw[4][2][2];
#pragma unroll
            for (int m = 0; m < 4; ++m) { const int row = row0 + ai * HALF + m * 16;
                if constexpr (RB) { const bf16_t* bp = rb + (size_t)row * ldc + col0;
#pragma unroll
                    for (int bj = 0; bj < 2; ++bj)
#pragma unroll
                        for (int n = 0; n < 2; ++n) bw[m][bj][n] = *(const u32x2*)(bp + bj * HALF + n * 16);
                } else { const float* bp = (row < split ? base0 + (size_t)row * ldc : base1 + (size_t)(row - split) * ldc) + col0;
#pragma unroll
                    for (int bj = 0; bj < 2; ++bj)
#pragma unroll
                        for (int n = 0; n < 2; ++n) bs[m][bj][n] = *(const f32x4*)(bp + bj * HALF + n * 16); } }
            asm volatile("" ::: "memory");
#pragma unroll
            for (int m = 0; m < 4; ++m) { const int row = row0 + ai * HALF + m * 16; float s = 0.f;
#pragma unroll
                for (int bj = 0; bj < 2; ++bj)
#pragma unroll
                    for (int n = 0; n < 2; ++n) { f32x4 r; if constexpr (RB) r = unpack(bw[m][bj][n]); else r = bs[m][bj][n];
                        const f32x4 v = acc[ai][bj][m][n] + r;
                        if constexpr (OF) *(f32x4*)(out + (size_t)row * ldc + col0 + bj * HALF + n * 16) = v;
                        if (hb) { u32x2 w; w.x = cvt_pk_bf16(v[0], v[1]); w.y = cvt_pk_bf16(v[2], v[3]);
                            *(u32x2*)(hb + (size_t)row * ldc + col0 + bj * HALF + n * 16) = w; s += (v[0] * v[0] + v[1] * v[1]) + (v[2] * v[2] + v[3] * v[3]); } }
                if (hb) { s += __shfl_xor(s, 16); s += __shfl_xor(s, 32); if (fq == 0) X[(ai * HALF + wr * 64 + m * 16 + fr) * 4 + wc] = s; } }
            asm volatile("" ::: "memory");
        }
    }
    __device__ __forceinline__ void strip(const f32x4 (&accS)[2], const Unit& u, int wr, int wc, int fr_in, int fq_in) const {
        int fr = fr_in, fq = fq_in; asm volatile("" : "+v"(fr), "+v"(fq));
        const int rs = u.pm * 16 + fr, col0 = u.pn * BM + wr * HALF + wc * 32 + 4 * fq; float s = 0.f;
        f32x4 r[2];
        if constexpr (RB) { u32x2 bw[2];
#pragma unroll
            for (int n = 0; n < 2; ++n) bw[n] = *(const u32x2*)(rb + (size_t)(split + rs) * ldc + col0 + n * 16);
            asm volatile("" ::: "memory");
            r[0] = unpack(bw[0]); r[1] = unpack(bw[1]);
        } else {
#pragma unroll
            for (int n = 0; n < 2; ++n) r[n] = *(const f32x4*)(base1 + (size_t)rs * ldc + col0 + n * 16);
            asm volatile("" ::: "memory"); }
#pragma unroll
        for (int n = 0; n < 2; ++n) { const f32x4 v = accS[n] + r[n];
            if constexpr (OF) *(f32x4*)(out + (size_t)(split + rs) * ldc + col0 + n * 16) = v;
            if (hb) { u32x2 w; w.x = cvt_pk_bf16(v[0], v[1]); w.y = cvt_pk_bf16(v[2], v[3]);
                *(u32x2*)(hb + (size_t)(split + rs) * ldc + col0 + n * 16) = w; s += (v[0] * v[0] + v[1] * v[1]) + (v[2] * v[2] + v[3] * v[3]); } }
        if (hb) {
            s += __shfl_xor(s, 16); s += __shfl_xor(s, 32); if (fq == 0) X[1024 + fr * 8 + wr * 4 + wc] = s;
            asm volatile("s_waitcnt lgkmcnt(0)" ::: "memory"); __builtin_amdgcn_s_barrier(); asm volatile("" ::: "memory");
            const int t = (wr * 4 + wc) * 64 + fq * 16 + fr;
            if (t < 256) { const f32x4 a = *(const PG8_LAS f32x4*)(X + t * 4); ssp[(size_t)(u.pm * BM + t) * 8 + u.pn] = (a[0] + a[1]) + (a[2] + a[3]); }
            else if (t < 272) { const int r2 = t - 256; const f32x4 a = *(const PG8_LAS f32x4*)(X + 1024 + r2 * 8), b = *(const PG8_LAS f32x4*)(X + 1024 + r2 * 8 + 4);
                ssp[(size_t)(split + u.pm * 16 + r2) * 8 + u.pn] = ((a[0] + a[1]) + (a[2] + a[3])) + ((b[0] + b[1]) + (b[2] + b[3])); }
        }
    }
};
__device__ __forceinline__ float silu_mul(float g, float u) { return g * u * __builtin_amdgcn_rcpf(1.0f + __builtin_amdgcn_exp2f(-1.4426950408889634f * g)); }

struct RowScale {
    const float* ssp; float inv_n, eps; PG8_LAS float* RT;
    __device__ __forceinline__ void load(const Unit& u, int tid, f32x4& a, f32x4& b) const { if (tid < 256) { const float* sp = ssp + (size_t)(u.pm * BM + tid) * 8; a = *(const f32x4*)sp; b = *(const f32x4*)(sp + 4); } }
    __device__ __forceinline__ void publish(int tid, const f32x4& a, const f32x4& b) const {
        if (tid < 256) RT[tid] = rsqrtf((((a[0] + a[1]) + (a[2] + a[3])) + ((b[0] + b[1]) + (b[2] + b[3]))) * inv_n + eps);
        asm volatile("s_waitcnt lgkmcnt(0)" ::: "memory"); __builtin_amdgcn_s_barrier(); asm volatile("" ::: "memory"); }
};
struct EpiSwiGLU {
    static constexpr bool PERM = true, AFTER_DRAIN = false;
    bf16_t* O; int ldc; RowScale rs;
    __device__ __forceinline__ void operator()(const f32x4 (&acc)[2][2][4][2], const Unit& u, int wr, int wc, int fr_in, int fq_in) const {
        int fr = fr_in, fq = fq_in; asm volatile("" : "+v"(fr), "+v"(fq));
        const int row0 = u.pm * BM + wr * 64 + fr, col0 = u.pn * HALF + wc * 32 + 8 * fq;
#pragma unroll
        for (int ai = 0; ai < 2; ++ai)
#pragma unroll
            for (int m = 0; m < 4; ++m) { const int row = row0 + ai * HALF + m * 16; const float r = rs.RT[ai * HALF + wr * 64 + m * 16 + fr]; bf16_t* rowp = O + (size_t)row * ldc + col0;
                const f32x4 g0 = acc[ai][0][m][0] * r, g1 = acc[ai][0][m][1] * r, u0 = acc[ai][1][m][0] * r, u1 = acc[ai][1][m][1] * r;
                u32x4 w; w.x = cvt_pk_bf16(silu_mul(g0[0], u0[0]), silu_mul(g0[1], u0[1])); w.y = cvt_pk_bf16(silu_mul(g0[2], u0[2]), silu_mul(g0[3], u0[3]));
                w.z = cvt_pk_bf16(silu_mul(g1[0], u1[0]), silu_mul(g1[1], u1[1])); w.w = cvt_pk_bf16(silu_mul(g1[2], u1[2]), silu_mul(g1[3], u1[3]));
                *(u32x4*)rowp = w; }
    }
};


struct EpiIn {
    static constexpr bool PERM = true, AFTER_DRAIN = false;
    bf16_t* P; int ldp; float* side; bf16_t* QB; bf16_t* KB; bf16_t* VB; float* fk_p; float* fk_s; float* fv_p; float* fv_s; const float* gq; const float* gk; PG8_LAS float* X; int split; float eps; RowScale rs;
    __device__ __forceinline__ void operator()(const f32x4 (&acc_in)[2][2][4][2], const Unit& u, int wr, int wc, int fr_in, int fq_in) const {
        int fr = fr_in, fq = fq_in; asm volatile("" : "+v"(fr), "+v"(fq));
        f32x4 (&acc)[2][2][4][2] = const_cast<f32x4 (&)[2][2][4][2]>(acc_in);
#pragma unroll
        for (int ai = 0; ai < 2; ++ai)
#pragma unroll
            for (int m = 0; m < 4; ++m) { const float r = rs.RT[ai * HALF + wr * 64 + m * 16 + fr];
#pragma unroll
                for (int bj = 0; bj < 2; ++bj)
#pragma unroll
                    for (int n = 0; n < 2; ++n) acc[ai][bj][m][n] *= r; }
        const int row0 = u.pm * BM + wr * 64 + fr, pn = u.pn;
        if (pn < 14) { const int col0 = pn * BM + wc * 32 + 8 * fq;
#pragma unroll
            for (int ai = 0; ai < 2; ++ai)
#pragma unroll
                for (int m = 0; m < 4; ++m) { bf16_t* rowp = P + (size_t)(row0 + ai * HALF + m * 16) * ldp + col0;
#pragma unroll
                    for (int bj = 0; bj < 2; ++bj) { const f32x4 v0 = acc[ai][bj][m][0], v1 = acc[ai][bj][m][1];
                        u32x4 w; w.x = cvt_pk_bf16(v0[0], v0[1]); w.y = cvt_pk_bf16(v0[2], v0[3]); w.z = cvt_pk_bf16(v1[0], v1[1]); w.w = cvt_pk_bf16(v1[2], v1[3]);
                        *(u32x4*)(rowp + bj * HALF) = w; } }
        } else if (pn < 22) { const bool isk = pn >= 18; const int hd0 = (pn - (isk ? 18 : 14)) * 2;
#pragma unroll
            for (int ai = 0; ai < 2; ++ai)
#pragma unroll
                for (int m = 0; m < 4; ++m)
#pragma unroll
                    for (int bj = 0; bj < 2; ++bj) { const f32x4 v0 = acc[ai][bj][m][0], v1 = acc[ai][bj][m][1];
                        float s = (v0[0] * v0[0] + v0[1] * v0[1]) + (v0[2] * v0[2] + v0[3] * v0[3]) + (v1[0] * v1[0] + v1[1] * v1[1]) + (v1[2] * v1[2] + v1[3] * v1[3]);
                        s += __shfl_xor(s, 16); s += __shfl_xor(s, 32);
                        if (fq == 0) X[(ai * HALF + wr * 64 + m * 16 + fr) * 8 + bj * 4 + wc] = s; }
            asm volatile("s_waitcnt lgkmcnt(0)" ::: "memory"); __builtin_amdgcn_s_barrier(); asm volatile("" ::: "memory");
            const float* gain = isk ? gk : gq; const f32x4 g0 = *(const f32x4*)(gain + wc * 32 + 8 * fq), g1 = *(const f32x4*)(gain + wc * 32 + 8 * fq + 4);
            bf16_t* Ob = isk ? KB : QB;
#pragma unroll
            for (int ai = 0; ai < 2; ++ai)
#pragma unroll
                for (int m = 0; m < 4; ++m) { const int rl = ai * HALF + wr * 64 + m * 16 + fr, row = u.pm * BM + rl;
#pragma unroll
                    for (int bj = 0; bj < 2; ++bj) { const f32x4 t = *(const PG8_LAS f32x4*)(X + rl * 8 + bj * 4); const float r = rsqrtf(((t[0] + t[1]) + (t[2] + t[3])) * (1.f / 128.f) + eps);
                        const f32x4 y0 = acc[ai][bj][m][0] * r * g0, y1 = acc[ai][bj][m][1] * r * g1; const int col = (hd0 + bj) * 128 + wc * 32 + 8 * fq;
                        u32x4 w; w.x = cvt_pk_bf16(y0[0], y0[1]); w.y = cvt_pk_bf16(y0[2], y0[3]); w.z = cvt_pk_bf16(y1[0], y1[1]); w.w = cvt_pk_bf16(y1[2], y1[3]);
                        *(u32x4*)(Ob + (size_t)row * 1024 + col) = w;
                        if (isk) { float* d = (row < split ? fk_p + (size_t)row * 1024 : fk_s + (size_t)(row - split) * 1024) + col; *(f32x4*)d = y0; *(f32x4*)(d + 4) = y1; } } }
        } else if (pn < 26) { const int hd0 = (pn - 22) * 2;
#pragma unroll
            for (int ai = 0; ai < 2; ++ai)
#pragma unroll
                for (int m = 0; m < 4; ++m) { const int row = row0 + ai * HALF + m * 16;
#pragma unroll
                    for (int bj = 0; bj < 2; ++bj) { const f32x4 v0 = acc[ai][bj][m][0], v1 = acc[ai][bj][m][1]; const int col = (hd0 + bj) * 128 + wc * 32 + 8 * fq;
                        u32x4 w; w.x = cvt_pk_bf16(v0[0], v0[1]); w.y = cvt_pk_bf16(v0[2], v0[3]); w.z = cvt_pk_bf16(v1[0], v1[1]); w.w = cvt_pk_bf16(v1[2], v1[3]);
                        *(u32x4*)(VB + (size_t)row * 1024 + col) = w;
                        float* d = (row < split ? fv_p + (size_t)row * 1024 : fv_s + (size_t)(row - split) * 1024) + col; *(f32x4*)d = v0; *(f32x4*)(d + 4) = v1; } }
        } else if (wc == 0) {
#pragma unroll
            for (int ai = 0; ai < 2; ++ai)
#pragma unroll
                for (int m = 0; m < 4; ++m) { float* sp = side + (size_t)(row0 + ai * HALF + m * 16) * 32 + 8 * fq; *(f32x4*)sp = acc[ai][0][m][0]; *(f32x4*)(sp + 4) = acc[ai][0][m][1]; }
        }
    }
};
template <class Epi, class Sched, bool ALIGN_EPI = false, bool SP2 = false, bool STRIP = false, bool ROWSCALE = false>
__device__ __forceinline__ void gemm_phase(PG8_LAS unsigned char* lds, const Gemm g, const Sched& S, const Epi& E) {
    int tid_ = threadIdx.x; asm volatile("" : "+v"(tid_));
    const int tid = tid_, wid = __builtin_amdgcn_readfirstlane(tid >> 6), lane = tid & 63, wr = wid >> 2, wc = wid & 3, fr = lane & 15, fq = lane >> 4;
    const int K = g.K, nt = g.KL / BK;
    unsigned voffA[2], voffB[2];
#pragma unroll
    for (int i = 0; i < 2; ++i) { int R, C; stage_rc(tid * 16 + i * 8192, R, C); const int Rb = Epi::PERM ? ((R & ~31) + perm32(R & 31)) : R;
        voffA[i] = (unsigned)(R * K + C) * 2u; voffB[i] = (unsigned)(Rb * K + C) * 2u; }
    const size_t kstep = (size_t)(BK * 2);
    const size_t hstep = (size_t)HALF * K * 2;
    const size_t tstep = 2 * hstep;
    const unsigned ldsw = (unsigned)wid * 1024u;
    const int aoff = lds_byte(wr * 64 + fr, fq * 8), boff = lds_byte(wc * 32 + fr, fq * 8);
    static_assert(!STRIP || SP2, "STRIP needs the SP2 loop");
    constexpr int SOFF = STAGE_BYTES + 8192;
    const unsigned voffS = (unsigned)(((2 * wid + (lane >> 5)) * K + (lane & 31) * 2) * 2);
    const int soff = fr * 128 + fq * 16;
#define PG8_SA(b, h) (((b) * 2 + (h)) * HTB)
#define PG8_SB(b, h) ((4 + (b) * 2 + (h)) * HTB)
#define PG8_STAGE(bufoff, gbase, voff) do { _Pragma("unroll") for (int _i = 0; _i < 2; ++_i) \
        __builtin_amdgcn_global_load_lds((const unsigned*)((const char*)(gbase) + (voff)[_i]), (PG8_LAS unsigned*)(lds + (bufoff) + ldsw + _i * 8192), 16, 0, 0); } while (0)
#define PG8_LDA(dst, b, h) do { _Pragma("unroll") for (int m = 0; m < 4; ++m) _Pragma("unroll") for (int k = 0; k < 2; ++k) dst[m][k] = *(const PG8_LAS bf16x8*)(lds + PG8_SA(b, h) + aoff + m * 2048 + k * 1024); } while (0)
#define PG8_LDB(dst, b, h) do { _Pragma("unroll") for (int n = 0; n < 2; ++n) _Pragma("unroll") for (int k = 0; k < 2; ++k) dst[n][k] = *(const PG8_LAS bf16x8*)(lds + PG8_SB(b, h) + boff + n * 2048 + k * 1024); } while (0)
#define PG8_MMA(ai, bj, At, Bt) do { __builtin_amdgcn_s_setprio(1); _Pragma("unroll") for (int m = 0; m < 4; ++m) _Pragma("unroll") for (int n = 0; n < 2; ++n) _Pragma("unroll") for (int k = 0; k < 2; ++k) \
        acc[ai][bj][m][n] = __builtin_amdgcn_mfma_f32_16x16x32_bf16(Bt[n][k], At[m][k], acc[ai][bj][m][n], 0, 0, 0); __builtin_amdgcn_s_setprio(0); } while (0)
#define PG8_WAIT_V(n) asm volatile("s_waitcnt vmcnt(" #n ")" ::: "memory")
#define PG8_SSTAGE(sb, gptr) do { if constexpr (STRIP) __builtin_amdgcn_global_load_lds((const unsigned*)((const char*)(gptr) + voffS), (PG8_LAS unsigned*)(lds + SOFF + (sb) * 2048 + wid * 256), 4, 0, 0); } while (0)
#define PG8_SLD(sb) do { if constexpr (STRIP) { Sf[0] = *(const PG8_LAS bf16x8*)(lds + SOFF + (sb) * 2048 + soff); Sf[1] = *(const PG8_LAS bf16x8*)(lds + SOFF + (sb) * 2048 + soff + 64); } } while (0)
#define PG8_SMMA() do { if constexpr (STRIP) { if (wr == 0) { _Pragma("unroll") for (int n = 0; n < 2; ++n) _Pragma("unroll") for (int k = 0; k < 2; ++k) accS[n] = __builtin_amdgcn_mfma_f32_16x16x32_bf16(B0[n][k], Sf[k], accS[n], 0, 0, 0); } \
        else { _Pragma("unroll") for (int n = 0; n < 2; ++n) _Pragma("unroll") for (int k = 0; k < 2; ++k) accS[n] = __builtin_amdgcn_mfma_f32_16x16x32_bf16(B1[n][k], Sf[k], accS[n], 0, 0, 0); } } } while (0)
#define PG8_WAIT_VL() do { if constexpr (STRIP) PG8_WAIT_V(9); else PG8_WAIT_V(8); } while (0)
#define PG8_WAIT_L(n) asm volatile("s_waitcnt lgkmcnt(" #n ")" ::: "memory")
#define PG8_BAR __builtin_amdgcn_s_barrier()
#define PG8_SCHED __builtin_amdgcn_sched_barrier(0)
    Unit cur, nxt; int ui = 0;
    if (!S.next(0, cur)) return;
    f32x4 acc[2][2][4][2];
#pragma unroll
    for (int a = 0; a < 2; ++a)
#pragma unroll
        for (int b = 0; b < 2; ++b)
#pragma unroll
            for (int m = 0; m < 4; ++m)
#pragma unroll
                for (int n = 0; n < 2; ++n) acc[a][b][m][n] = (f32x4){0.f, 0.f, 0.f, 0.f};
    bf16x8 At[4][2], B0[2][2], B1[2][2]; bf16x8 Sf[2]; f32x4 accS[2] = {(f32x4){0.f, 0.f, 0.f, 0.f}, (f32x4){0.f, 0.f, 0.f, 0.f}};
    const char* cA = (const char*)g.A + (size_t)cur.pm * tstep + (size_t)cur.ko * 2; const char* cB = (const char*)g.Bt + (size_t)cur.pn * tstep + (size_t)cur.ko * 2;
    const char* cS = STRIP ? (const char*)g.As + (size_t)cur.pm * 16 * K * 2 + (size_t)cur.ko * 2 : nullptr;
    S.a_ready(cur);
    f32x4 rsa = {0.f, 0.f, 0.f, 0.f}, rsb = rsa, rna = rsa, rnb = rsa; if constexpr (ROWSCALE) { static_assert(ALIGN_EPI, "ROWSCALE publishes behind a workgroup barrier inside the epilogue"); E.rs.load(cur, tid, rsa, rsb); }
    if constexpr (SP2) {
        PG8_STAGE(PG8_SB(0, 0), cB, voffB); PG8_STAGE(PG8_SB(0, 1), cB + hstep, voffB); PG8_STAGE(PG8_SA(0, 0), cA, voffA); PG8_STAGE(PG8_SA(0, 1), cA + hstep, voffA); PG8_SSTAGE(0, cS);
        if (wr == 1) PG8_BAR;
        if constexpr (STRIP) PG8_WAIT_V(3); else PG8_WAIT_V(2); PG8_BAR;
        PG8_STAGE(PG8_SB(1, 0), cB + kstep, voffB); PG8_STAGE(PG8_SA(1, 0), cA + kstep, voffA); PG8_STAGE(PG8_SB(1, 1), cB + hstep + kstep, voffB);
        PG8_WAIT_V(6); PG8_BAR;
    } else {
        PG8_STAGE(PG8_SB(0, 0), cB, voffB); PG8_STAGE(PG8_SA(0, 0), cA, voffA); PG8_STAGE(PG8_SB(0, 1), cB + hstep, voffB); PG8_STAGE(PG8_SA(0, 1), cA + hstep, voffA);
        if (wr == 1) PG8_BAR;
        PG8_WAIT_V(4); PG8_BAR;
        PG8_STAGE(PG8_SB(1, 0), cB + kstep, voffB); PG8_STAGE(PG8_SA(1, 0), cA + kstep, voffA); PG8_STAGE(PG8_SB(1, 1), cB + hstep + kstep, voffB);
        PG8_WAIT_V(6); PG8_BAR;
    }
    for (;;) {
        const bool has_next = S.next(ui + 1, nxt);
        const char* nS = (STRIP && has_next) ? (const char*)g.As + (size_t)nxt.pm * 16 * K * 2 + (size_t)nxt.ko * 2 : cS;
        const char* nA = has_next ? (const char*)g.A + (size_t)nxt.pm * tstep + (size_t)nxt.ko * 2 : cA; const char* nB = has_next ? (const char*)g.Bt + (size_t)nxt.pn * tstep + (size_t)nxt.ko * 2 : cB;
        for (int t = 0; t < nt; t += 2) {
            const bool last = (t == nt - 2);
            const char* a1 = cA + (size_t)(t + 1) * kstep;
            const char* a2 = last ? nA : cA + (size_t)(t + 2) * kstep; const char* b2 = last ? nB : cB + (size_t)(t + 2) * kstep;
            const char* a3 = a2 + kstep; const char* b3 = b2 + kstep;
            const char* s1 = STRIP ? cS + (size_t)(t + 1) * kstep : nullptr; const char* s2 = STRIP ? (last ? nS : cS + (size_t)(t + 2) * kstep) : nullptr;
            if (last && has_next) { S.a_ready(nxt); if constexpr (ROWSCALE) E.rs.load(nxt, tid, rna, rnb); }
            if constexpr (SP2) {
            PG8_LDB(B0, 0, 0); PG8_LDB(B1, 0, 1); PG8_SCHED; PG8_LDA(At, 0, 0); PG8_STAGE(PG8_SA(1, 1), a1 + hstep, voffA); PG8_SSTAGE(1, s1);
            PG8_WAIT_VL(); PG8_WAIT_L(0); PG8_BAR; PG8_MMA(0, 0, At, B0); PG8_MMA(0, 1, At, B1); PG8_BAR; PG8_SCHED;
            PG8_LDA(At, 0, 1); PG8_SLD(0); PG8_STAGE(PG8_SB(0, 0), b2, voffB); PG8_STAGE(PG8_SB(0, 1), b2 + hstep, voffB); PG8_STAGE(PG8_SA(0, 0), a2, voffA);
            PG8_WAIT_VL(); PG8_WAIT_L(0); PG8_BAR; PG8_MMA(1, 0, At, B0); PG8_MMA(1, 1, At, B1); PG8_SMMA(); PG8_BAR; PG8_SCHED;
            PG8_LDB(B0, 1, 0); PG8_LDB(B1, 1, 1); PG8_SCHED; PG8_LDA(At, 1, 0); PG8_STAGE(PG8_SA(0, 1), a2 + hstep, voffA); PG8_SSTAGE(0, s2);
            PG8_WAIT_VL(); PG8_WAIT_L(0); PG8_BAR; PG8_MMA(0, 0, At, B0); PG8_MMA(0, 1, At, B1); PG8_BAR; PG8_SCHED;
            PG8_LDA(At, 1, 1); PG8_SLD(1); PG8_STAGE(PG8_SB(1, 0), b3, voffB); PG8_STAGE(PG8_SB(1, 1), b3 + hstep, voffB); PG8_STAGE(PG8_SA(1, 0), a3, voffA);
            PG8_WAIT_VL(); PG8_WAIT_L(0); PG8_BAR; PG8_MMA(1, 0, At, B0); PG8_MMA(1, 1, At, B1); PG8_SMMA(); PG8_BAR; PG8_SCHED;
            } else {
            PG8_LDB(B0, 0, 0); PG8_SCHED; PG8_LDA(At, 0, 0); PG8_STAGE(PG8_SA(1, 1), a1 + hstep, voffA);
            PG8_WAIT_L(8); PG8_BAR; PG8_WAIT_L(0); PG8_MMA(0, 0, At, B0); PG8_BAR; PG8_SCHED;
            PG8_LDB(B1, 0, 1); PG8_STAGE(PG8_SB(0, 0), b2, voffB);
            PG8_BAR; PG8_WAIT_L(0); PG8_MMA(0, 1, At, B1); PG8_BAR;
            PG8_LDA(At, 0, 1); PG8_STAGE(PG8_SA(0, 0), a2, voffA);
            PG8_BAR; PG8_WAIT_L(0); PG8_MMA(1, 0, At, B0); PG8_BAR; PG8_SCHED;
            PG8_STAGE(PG8_SB(0, 1), b2 + hstep, voffB);
            PG8_WAIT_V(6); PG8_BAR; PG8_MMA(1, 1, At, B1); PG8_BAR;
            PG8_LDB(B0, 1, 0); PG8_SCHED; PG8_LDA(At, 1, 0); PG8_STAGE(PG8_SA(0, 1), a2 + hstep, voffA);
            PG8_WAIT_L(8); PG8_BAR; PG8_WAIT_L(0); PG8_MMA(0, 0, At, B0); PG8_BAR; PG8_SCHED;
            PG8_LDB(B1, 1, 1); PG8_STAGE(PG8_SB(1, 0), b3, voffB);
            PG8_BAR; PG8_WAIT_L(0); PG8_MMA(0, 1, At, B1); PG8_BAR;
            PG8_LDA(At, 1, 1); PG8_STAGE(PG8_SA(1, 0), a3, voffA);
            PG8_BAR; PG8_WAIT_L(0); PG8_MMA(1, 0, At, B0); PG8_BAR; PG8_SCHED;
            PG8_STAGE(PG8_SB(1, 1), b3 + hstep, voffB);
            PG8_WAIT_V(6); PG8_BAR; PG8_MMA(1, 1, At, B1); PG8_BAR;
            }
        }
        if constexpr (ALIGN_EPI) { if (wr == 0) PG8_BAR; }
        if constexpr (ROWSCALE) { E.rs.publish(tid, rsa, rsb); rsa = rna; rsb = rnb; }
        if constexpr (!Epi::AFTER_DRAIN) { E(acc, cur, wr, wc, fr, fq); if constexpr (STRIP) { E.strip(accS, cur, wr, wc, fr, fq); accS[0] = (f32x4){0.f, 0.f, 0.f, 0.f}; accS[1] = (f32x4){0.f, 0.f, 0.f, 0.f}; } S.done(cur); }
        if (!has_next) break;
#pragma unroll
        for (int a = 0; a < 2; ++a)
#pragma unroll
            for (int b = 0; b < 2; ++b)
#pragma unroll
                for (int m = 0; m < 4; ++m)
#pragma unroll
                    for (int n = 0; n < 2; ++n) acc[a][b][m][n] = (f32x4){0.f, 0.f, 0.f, 0.f};
        cur = nxt; cA = nA; cB = nB; cS = nS; ++ui;
        if constexpr (ALIGN_EPI) { if (wr == 1) PG8_BAR; }
    }
    PG8_WAIT_V(0);
    if constexpr (!ALIGN_EPI) { if (wr == 0) PG8_BAR; }
    PG8_BAR;
    if constexpr (Epi::AFTER_DRAIN) { E.fused(acc, cur, wr, wc, fr, fq, lds, wid, lane); S.done(cur); }
#undef PG8_SA
#undef PG8_SB
#undef PG8_STAGE
#undef PG8_SSTAGE
#undef PG8_SLD
#undef PG8_SMMA
#undef PG8_WAIT_VL
#undef PG8_LDA
#undef PG8_LDB
#undef PG8_MMA
#undef PG8_WAIT_V
#undef PG8_WAIT_L
#undef PG8_BAR
#undef PG8_SCHED
}
}

#define LAS __attribute__((address_space(3)))
typedef unsigned short bf16;
typedef float f32x4 __attribute__((ext_vector_type(4)));
typedef unsigned u32x4v __attribute__((ext_vector_type(4)));
typedef unsigned u32x2v __attribute__((ext_vector_type(2)));

constexpr int DM = 2048, TP = 8192, NSB = 16, TS = 32, MS = NSB * TS, MT = TP + MS, NL = 4, PAST = 1024;
constexpr int DIN = 6680, DINP = 6912, DFF = 5632;
constexpr int C_GQ = 0, C_GK = 256, C_GV = 512, C_GG = 1024, C_GA = 1536, C_RQ = 1552, C_RK = 2064, C_RV = 2576, C_RG = 3088, C_FQ = 3600, C_FK = 4624, C_FV = 5648, C_FF = 6672;
constexpr float EPS = 1e-6f;
constexpr int PBP = 3584, PB_GQ = 0, PB_GK = 256, PB_GV = 512, PB_GG = 1024, PB_RQ = 1536, PB_RK = 2048, PB_RV = 2560, PB_RG = 3072;
constexpr int NSLOT = 128 + NSB;
enum { I_XP = 0, I_XS, I_SGLA, I_SRET, I_CK, I_CV, I_CLF, I_NMIX, I_WIN, I_WGG, I_BGG, I_GGLA, I_GRET, I_GFQ, I_GFK, I_BFF, I_GFO, I_WOUT, I_NFFN, I_WG, I_WU, I_WD, N_IN };
constexpr size_t O_YP = 0, O_YS = O_YP + (size_t)TP * DM, O_GLAP = O_YS + (size_t)MS * DM, O_RETP = O_GLAP + (size_t)NL * 4 * 64 * 128,
                 O_FKP = O_RETP + (size_t)NL * 4 * 128 * 128, O_FVP = O_FKP + (size_t)NL * TP * 1024, O_LFP = O_FVP + (size_t)NL * TP * 1024,
                 O_GLAS = O_LFP + (size_t)NL * TP * 8, O_RETS = O_GLAS + (size_t)NL * NSB * 4 * 64 * 128, O_FKS = O_RETS + (size_t)NL * NSB * 4 * 128 * 128,
                 O_FVS = O_FKS + (size_t)NL * MS * 1024, O_LFS = O_FVS + (size_t)NL * MS * 1024, O_END = O_LFS + (size_t)NL * MS * 8;
static_assert(O_END == 96092160, "output size");
constexpr size_t al256(size_t x) { return (x + 255) & ~(size_t)255; }
constexpr size_t SZ_WIN = (size_t)DINP * DM * 2, SZ_WOUT = (size_t)DM * DM * 2, SZ_WGU = (size_t)2 * DFF * DM * 2, SZ_WDN = (size_t)DM * DFF * 2;
constexpr size_t WS_CTL = 0, WS_WIN = 1u << 20, WS_WOUT = WS_WIN + NL * SZ_WIN, WS_WGU = WS_WOUT + NL * SZ_WOUT, WS_WDN = WS_WGU + NL * SZ_WGU,
                 WS_H = WS_WDN + NL * SZ_WDN, WS_XN = WS_H + (size_t)MT * DM * 4, WS_PROJ = WS_XN + (size_t)MT * DM * 2,
                 WS_GQ = WS_PROJ + (size_t)MT * DINP * 4, WS_GK = WS_GQ + (size_t)MT * 256 * 4, WS_LA = WS_GK + (size_t)MT * 256 * 4,
                 WS_RQ = WS_LA + (size_t)MT * 256 * 4, WS_RK = WS_RQ + (size_t)MT * 512 * 4, WS_FQ = WS_RK + (size_t)MT * 512 * 4,
                 WS_LOGF = WS_FQ + (size_t)MT * 1024 * 4, WS_CKP = WS_LOGF + (size_t)MT * 8 * 4, WS_CKS = WS_CKP + (size_t)8 * TP * 4,
                 WS_GU = al256(WS_CKS + (size_t)NSB * 8 * (PAST + TS) * 4), WS_GDEC = WS_GU + (size_t)NSLOT * 4 * 64 * 128 * 4, WS_GS = WS_GDEC + (size_t)NSLOT * 4 * 64 * 4,
                 WS_RU = WS_GS + (size_t)NSLOT * 4 * 64 * 128 * 4, WS_RSP = WS_RU + (size_t)NSLOT * 4 * 128 * 128 * 4,
                 WS_MRG = WS_RSP + (size_t)NSLOT * 4 * 128 * 128 * 4, WS_ACT = WS_MRG + (size_t)MT * DM * 2, WS_QB = WS_ACT + (size_t)MT * DFF * 2,
                 WS_KB = WS_QB + (size_t)MT * 1024 * 2, WS_VB = WS_KB + (size_t)MT * 1024 * 2, WS_PART = WS_VB + (size_t)MT * 1024 * 2, WS_TABC = WS_PART + (size_t)8 * MS * DM * 4, WS_TABS = WS_TABC + (size_t)MT * 64 * 4, WS_RVT = WS_TABS + (size_t)MT * 64 * 4,
                 WS_FPART = WS_RVT + (size_t)NSLOT * 4 * 16 * 64 * 16, WS_SIDE = WS_FPART + (size_t)256 * (256 * 128 + 512) * 4, WS_SSP = WS_SIDE + (size_t)MT * 32 * 4, WS_SPART = WS_SSP + (size_t)8 * MT * 8 * 4, WS_END = WS_SPART + (size_t)256 * (32 * 128 + 64) * 4;

struct Ctx { const float* in[N_IN]; float* out; unsigned char* ws; };

typedef const __attribute__((address_space(4))) Ctx* KCtxP;
__device__ __forceinline__ KCtxP kctx() { KCtxP p = (KCtxP)__builtin_amdgcn_kernarg_segment_ptr(); asm volatile("" : "+s"(p)); return p; }
#define OPQ_PTRS const KCtxP kc_ = kctx(); unsigned char* const ws_ = kc_->ws; float* const out_ = kc_->out
__device__ __forceinline__ int otid() { int t = threadIdx.x; asm volatile("" : "+v"(t)); return t; }
__device__ __forceinline__ unsigned f2bf(float f) { unsigned u = __builtin_bit_cast(unsigned, f); return (u + 0x7fffu + ((u >> 16) & 1u)) >> 16; }
__device__ __forceinline__ unsigned pk2(float lo, float hi) { return f2bf(lo) | (f2bf(hi) << 16); }
__device__ __forceinline__ float wave_sum(float v) {
#pragma unroll
    for (int o = 1; o < 64; o <<= 1) v += __shfl_xor(v, o);
    return v;
}
__device__ __forceinline__ float grp8_sum(float v) { v += __shfl_xor(v, 1); v += __shfl_xor(v, 2); v += __shfl_xor(v, 4); return v; }
__device__ __forceinline__ float grp8_max(float v) { v = fmaxf(v, __shfl_xor(v, 1)); v = fmaxf(v, __shfl_xor(v, 2)); v = fmaxf(v, __shfl_xor(v, 4)); return v; }
__device__ __forceinline__ float logsigmoid_f(float x) { return fminf(x, 0.f) - log1pf(expf(-fabsf(x))); }
__device__ __forceinline__ float silu_f(float x) { return x / (1.0f + expf(-x)); }
__device__ __forceinline__ float ret_logg(int h) { return log1pf(-exp2f(-5.0f - (float)h)); }
__device__ __forceinline__ int slot_len(int slot) { return slot < 128 ? 64 : 32; }
__device__ __forceinline__ int slot_tok0(int slot) { return slot < 128 ? 64 * slot : TP + 32 * (slot - 128); }

__device__ __forceinline__ void cvt_item(const float* W, int ldw, int src_col0, int valid, bf16* out, int out_row0, int K, int k0, LAS float* scr, int lane, float scale = 1.f, bool gaff = false, const float* kgain = nullptr) {
    if (!gaff && valid == 32) {
        const int c4 = lane & 7;
#pragma unroll
        for (int i = 0; i < 8; ++i) { const int kk = 8 * i + (lane >> 3); const f32x4 v = *(const f32x4*)(W + (size_t)(k0 + kk) * ldw + src_col0 + 4 * c4); const float sk = kgain ? scale * kgain[k0 + kk] : scale;
            LAS float* d = scr + kk * 33 + 4 * c4; d[0] = v.x * sk; d[1] = v.y * sk; d[2] = v.z * sk; d[3] = v.w * sk; }
    } else {
    const int c = lane & 31;
    int sc = src_col0 + c; bool ok = c < valid;
    if (gaff) { ok = c < 24; sc = c < 16 ? C_GA + c : C_FF + (c - 16); }
#pragma unroll 8
    for (int i = 0; i < 32; ++i) { const int kk = 2 * i + (lane >> 5); scr[kk * 33 + c] = ok ? W[(size_t)(k0 + kk) * ldw + sc] * (kgain ? scale * kgain[k0 + kk] : scale) : 0.f; }
    }
    __builtin_amdgcn_s_waitcnt(0); asm volatile("" ::: "memory");
    const int ch = lane & 7;
#pragma unroll
    for (int j = 0; j < 4; ++j) { const int n = (lane >> 3) + 8 * j; const LAS float* s = scr + (8 * ch) * 33 + n;
        u32x4v o; o.x = pk2(s[0 * 33], s[1 * 33]); o.y = pk2(s[2 * 33], s[3 * 33]); o.z = pk2(s[4 * 33], s[5 * 33]); o.w = pk2(s[6 * 33], s[7 * 33]);
        *(u32x4v*)(out + (size_t)(out_row0 + n) * K + k0 + 8 * ch) = o; }
    __builtin_amdgcn_s_waitcnt(0); asm volatile("" ::: "memory");
}
__device__ __forceinline__ void cvt_decode(KCtxP kc_, unsigned char* ws_, int l, int part, int idx, const float*& W, int& ldw, int& col, bf16*& out, int& orow, int& K, int& k0, float& scale, bool& hasg) {
    constexpr int NB_OUT = DM / 32, NB_GU = 2 * DFF / 32, NB_DN = DM / 32, NBF = 6656 / 32;
    constexpr int I_OUT = (DM / 64) * NB_OUT, I_GU = (DM / 64) * NB_GU;
    int r = idx; scale = 1.f; hasg = false;
    if (part == 0) { const int kb = r / NBF, n0 = (r % NBF) * 32;
        W = kc_->in[I_WIN] + (size_t)l * DM * DIN; ldw = DIN; out = (bf16*)(ws_ + WS_WIN + l * SZ_WIN); orow = n0; K = DM; k0 = kb * 64; hasg = true;
        if (n0 < 1536) { col = n0; scale = n0 < 256 ? 0.125f : 1.f; } else { col = n0 + 16; scale = n0 < 2048 ? 0.08838834764831845f : 1.f; }
        return; }
    if (r < I_OUT) { const int kb = r / NB_OUT, nbk = r % NB_OUT; W = kc_->in[I_WOUT] + (size_t)l * DM * DM; ldw = DM; col = nbk * 32; out = (bf16*)(ws_ + WS_WOUT + l * SZ_WOUT); orow = nbk * 32; K = DM; k0 = kb * 64; return; }
    r -= I_OUT;
    if (r < I_GU) { const int kb = r / NB_GU, n0 = (r % NB_GU) * 32, tile = n0 >> 8, rr = n0 & 255;
        W = (rr < 128 ? kc_->in[I_WG] : kc_->in[I_WU]) + (size_t)l * DM * DFF; ldw = DFF; col = tile * 128 + (rr & 127); out = (bf16*)(ws_ + WS_WGU + l * SZ_WGU); orow = n0; K = DM; k0 = kb * 64; hasg = true; return; }
    r -= I_GU;
    { const int kb = r / NB_DN, nbk = r % NB_DN; W = kc_->in[I_WD] + (size_t)l * DFF * DM; ldw = DM; col = nbk * 32; out = (bf16*)(ws_ + WS_WDN + l * SZ_WDN); orow = nbk * 32; K = DFF; k0 = kb * 64; }
}
__device__ __forceinline__ void cvt_dma(KCtxP kc_, unsigned char* ws_, int l, int part, int idx, LAS float* buf, int lane) {
    const float* W; int ldw, col; bf16* out; int orow, K, k0; float scale; bool hasg;
    cvt_decode(kc_, ws_, l, part, idx, W, ldw, col, out, orow, K, k0, scale, hasg);
    const float* p0 = W + (size_t)(k0 + (lane >> 3)) * ldw + col; const int c = lane & 7;
#pragma unroll
    for (int i = 0; i < 8; ++i) __builtin_amdgcn_global_load_lds((const unsigned*)(p0 + (size_t)(8 * i) * ldw + 4 * (c ^ i)), (LAS unsigned*)(buf + i * 256), 16, 0, 0);
}
__device__ __forceinline__ void phase_convert(const Ctx& c, int l, LAS unsigned char* lds, int bid, int nb, int part, int lo = 0, int hi_ = -1) {
    OPQ_PTRS; (void)out_;
    const int tid_ = otid(), lane = tid_ & 63, wave = __builtin_amdgcn_readfirstlane(tid_ >> 6);
    LAS float* B0 = (LAS float*)(lds + wave * 16384);
    LAS float* G = (LAS float*)(lds + 131072);
    const int gw = bid * 8 + wave, ngw = nb * 8;
    constexpr int NB_OUT = DM / 32, NB_GU = 2 * DFF / 32, NB_DN = DM / 32;
    constexpr int I_OUT = (DM / 64) * NB_OUT, I_GU = (DM / 64) * NB_GU, I_DN = (DFF / 64) * NB_DN;
    __syncthreads();
    { const float* gsrc = (part == 0 ? kc_->in[I_NMIX] : kc_->in[I_NFFN]) + (size_t)l * DM; *(LAS f32x4*)(G + 4 * tid_) = *(const f32x4*)(gsrc + 4 * tid_); }
    if (part == 0 && hi_ < 0) {
        for (int s = gw; s < 256; s += ngw) { const int kb = s >> 3, n0 = 6656 + (s & 7) * 32;
            cvt_item(kc_->in[I_WIN] + (size_t)l * DM * DIN, DIN, 0, n0 == 6656 ? 32 : 0, (bf16*)(ws_ + WS_WIN + l * SZ_WIN), n0, DM, kb * 64, B0, lane, 1.f, n0 == 6656, kc_->in[I_NMIX] + (size_t)l * DM); } }
    __syncthreads();
    const int hi = hi_ >= 0 ? hi_ : (part == 0 ? 32 * 208 : I_OUT + I_GU + I_DN);
    const int c4 = lane & 7, kq = lane >> 3;
    int it = lo + gw;
    if (it < hi) {
        cvt_dma(kc_, ws_, l, part, it, B0, lane);
        if (it + ngw < hi) { cvt_dma(kc_, ws_, l, part, it + ngw, B0 + 2048, lane); asm volatile("s_waitcnt vmcnt(8)" ::: "memory"); } else asm volatile("s_waitcnt vmcnt(0)" ::: "memory");
        int cur = 0;
        while (true) {
            const float* W; int ldw, col; bf16* out; int orow, K, k0; float scale; bool hasg;
            cvt_decode(kc_, ws_, l, part, it, W, ldw, col, out, orow, K, k0, scale, hasg);
            LAS float* B = B0 + cur * 2048;
            float x[4][8]; f32x4 ga = {1.f, 1.f, 1.f, 1.f}, gb = ga;
            if (hasg) { ga = *(const LAS f32x4*)(G + k0 + 8 * c4); gb = *(const LAS f32x4*)(G + k0 + 8 * c4 + 4); }
#pragma unroll
            for (int j = 0; j < 4; ++j) { const int n = kq + 8 * j; const LAS float* s = B + (8 * c4) * 32 + (((n >> 2) ^ c4) * 4) + (n & 3);
#pragma unroll
                for (int r = 0; r < 8; ++r) x[j][r] = s[r * 32]; }
            asm volatile("s_waitcnt lgkmcnt(0)" ::: "memory");
            const int nx2 = it + 2 * ngw; const bool issued = nx2 < hi;
            if (issued) cvt_dma(kc_, ws_, l, part, nx2, B, lane);
            const float s0 = scale * ga[0], s1 = scale * ga[1], s2 = scale * ga[2], s3 = scale * ga[3], s4 = scale * gb[0], s5 = scale * gb[1], s6 = scale * gb[2], s7 = scale * gb[3];
#pragma unroll
            for (int j = 0; j < 4; ++j) { const int n = kq + 8 * j;
                u32x4v o; o.x = pg8::cvt_pk_bf16(x[j][0] * s0, x[j][1] * s1); o.y = pg8::cvt_pk_bf16(x[j][2] * s2, x[j][3] * s3); o.z = pg8::cvt_pk_bf16(x[j][4] * s4, x[j][5] * s5); o.w = pg8::cvt_pk_bf16(x[j][6] * s6, x[j][7] * s7);
                *(u32x4v*)(out + (size_t)(orow + n) * K + k0 + 8 * c4) = o; }
            asm volatile("" ::: "memory");
            it += ngw; if (it >= hi) break;
            cur ^= 1;
            if (issued) asm volatile("s_waitcnt vmcnt(12)" ::: "memory"); else asm volatile("s_waitcnt vmcnt(4)" ::: "memory");
        }
    }
    asm volatile("s_waitcnt vmcnt(0) lgkmcnt(0)" ::: "memory");
}

__device__ __forceinline__ float block_excl_offset(float run, int tid, LAS float* tot) {
    const int lane = tid & 63, wv = tid >> 6; float inc = run;
#pragma unroll
    for (int o = 1; o < 64; o <<= 1) { const float t = __shfl_up(inc, o); if (lane >= o) inc += t; }
    if (lane == 63) tot[wv] = inc;
    __syncthreads();
    float base = 0.f;
#pragma unroll
    for (int w = 0; w < 8; ++w) base += (w < wv) ? tot[w] : 0.f;
    return base + (inc - run);
}
__device__ __forceinline__ void phase_fox_cumsum2(const Ctx& c, int l, LAS unsigned char* lds, int bid, int nb) {
    OPQ_PTRS;
    const int tid = otid(); LAS float* tot = (LAS float*)lds;
    const float* SIDE = (const float*)(ws_ + WS_SIDE); float* CKP = (float*)(ws_ + WS_CKP); float* CKS = (float*)(ws_ + WS_CKS); const float* bff = kc_->in[I_BFF] + l * 8;
    for (int u = bid; u < 8 + NSB * 8; u += nb) {
        __syncthreads();
        if (u < 8) { const int h = u; const float bb = bff[h]; float v[16]; float run = 0.f;
#pragma unroll
            for (int i = 0; i < 16; ++i) { const int t = tid * 16 + i; const float x = logsigmoid_f(SIDE[(size_t)t * 32 + 16 + h] + bb); out_[O_LFP + ((size_t)l * TP + t) * 8 + h] = x; run += x; v[i] = run; }
            const float off = block_excl_offset(run, tid, tot);
#pragma unroll
            for (int i = 0; i < 16; ++i) CKP[(size_t)h * TP + tid * 16 + i] = v[i] + off;
        } else { const int bh = u - 8, b = bh >> 3, h = bh & 7; const float bb = bff[h]; float v[3]; float run = 0.f;
#pragma unroll
            for (int i = 0; i < 3; ++i) { const int j = tid * 3 + i; float x = 0.f;
                if (j < PAST) x = kc_->in[I_CLF][(((size_t)l * NSB + b) * PAST + j) * 8 + h];
                else if (j < PAST + TS) { const int s = b * TS + (j - PAST); x = logsigmoid_f(SIDE[(size_t)(TP + s) * 32 + 16 + h] + bb); out_[O_LFS + ((size_t)l * MS + s) * 8 + h] = x; }
                run += x; v[i] = run; }
            const float off = block_excl_offset(run, tid, tot);
#pragma unroll
            for (int i = 0; i < 3; ++i) { const int j = tid * 3 + i; if (j < PAST + TS) CKS[(size_t)bh * (PAST + TS) + j] = v[i] + off; }
        }
    }
}

__device__ __forceinline__ void phase_x_to_bf16(const float* src0, const float* src1, bf16* hb, float* ss, int bid, int nb) {
    const int tid_ = otid(), lane = tid_ & 63, wave = tid_ >> 6;
    for (int m = bid * 8 + wave; m < MT; m += nb * 8) {
        const float* xr = m < TP ? src0 + (size_t)m * DM : src1 + (size_t)(m - TP) * DM; float s = 0.f;
#pragma unroll
        for (int j = 0; j < 8; ++j) { const f32x4 v = *(const f32x4*)(xr + 4 * (lane + 64 * j)); s += (v.x * v.x + v.y * v.y) + (v.z * v.z + v.w * v.w);
            u32x2v o; o.x = pk2(v.x, v.y); o.y = pk2(v.z, v.w); *(u32x2v*)(hb + (size_t)m * DM + 4 * (lane + 64 * j)) = o; }
        s = wave_sum(s); if (lane < 8) ss[(size_t)m * 8 + lane] = lane == 0 ? s : 0.f;
    }
}

namespace mx {
typedef short bf16x8 __attribute__((ext_vector_type(8)));
typedef float f32x16 __attribute__((ext_vector_type(16)));
typedef unsigned u32x4 __attribute__((ext_vector_type(4)));
__device__ __forceinline__ unsigned cvtpk(float lo, float hi) { unsigned r; asm("v_cvt_pk_bf16_f32 %0, %1, %2" : "=v"(r) : "v"(lo), "v"(hi)); return r; }
__device__ __forceinline__ bf16x8 pack8(const f32x4 a, const f32x4 b) { u32x4 w = {cvtpk(a[0], a[1]), cvtpk(a[2], a[3]), cvtpk(b[0], b[1]), cvtpk(b[2], b[3])}; return *reinterpret_cast<bf16x8*>(&w); }
__device__ __forceinline__ int crow(int r, int hi) { return (r & 3) + 8 * (r >> 2) + 4 * hi; }
__device__ __forceinline__ float ldf(const float* ubase, unsigned off) { return *(const float*)((const char*)ubase + off); }
__device__ __forceinline__ f32x4 ldf4(const float* ubase, unsigned off) { return *(const f32x4*)((const char*)ubase + off); }
__device__ __forceinline__ float logsig_fast(float x) { return fminf(x, 0.f) - __logf(1.f + __expf(-fabsf(x))); }
__device__ __forceinline__ float silu_fast(float x) { return x * __builtin_amdgcn_rcpf(1.f + __builtin_amdgcn_exp2f(-1.4426950408889634f * x)); }
#define MX_MFMA(a, b, c) __builtin_amdgcn_mfma_f32_32x32x16_bf16(a, b, c, 0, 0, 0)
__device__ __forceinline__ void ld_slab8(float (&x)[8], const float* rowbase, int pitch, unsigned voff) {
#pragma unroll
    for (int j = 0; j < 8; ++j) x[j] = ldf(rowbase + (size_t)(8 * (j >> 2) + (j & 3)) * pitch, voff);
}
__device__ __forceinline__ float bf2f(unsigned short v) { return __uint_as_float((unsigned)v << 16); }
__device__ __forceinline__ f32x4 ld4bf(const bf16* p) { const u32x2v w = *(const u32x2v*)p; return (f32x4){__uint_as_float(w.x << 16), __uint_as_float(w.x & 0xffff0000u), __uint_as_float(w.y << 16), __uint_as_float(w.y & 0xffff0000u)}; }
__device__ __forceinline__ bf16x8 ld8slot(const bf16* p) { const u32x2v a = *(const u32x2v*)p, b = *(const u32x2v*)(p + 8); u32x4 w = {a.x, a.y, b.x, b.y}; return *reinterpret_cast<bf16x8*>(&w); }
__device__ __forceinline__ unsigned short ldh(const bf16* ubase, unsigned off) { return *(const unsigned short*)((const char*)ubase + off); }
__device__ __forceinline__ void ld_slab8h(unsigned short (&x)[8], const bf16* rowbase, int pitch, unsigned voff) {
#pragma unroll
    for (int j = 0; j < 8; ++j) x[j] = ldh(rowbase + (size_t)(8 * (j >> 2) + (j & 3)) * pitch, voff);
}
__device__ __forceinline__ bf16x8 frag8h(const unsigned short (&x)[8]) { u32x4 w = {(unsigned)x[0] | ((unsigned)x[1] << 16), (unsigned)x[2] | ((unsigned)x[3] << 16), (unsigned)x[4] | ((unsigned)x[5] << 16), (unsigned)x[6] | ((unsigned)x[7] << 16)}; return *reinterpret_cast<bf16x8*>(&w); }
}

__device__ __forceinline__ int q_next(unsigned* q, int lane) { unsigned v = 0u; if (lane == 0) v = __hip_atomic_fetch_add(q, 1u, __ATOMIC_RELAXED, __HIP_MEMORY_SCOPE_AGENT); return (int)__builtin_amdgcn_readfirstlane(v); }
constexpr int CW_Q = 8192;
constexpr size_t SZ_TAB = (size_t)MT * 64 * 4;
__device__ __forceinline__ void phase_rope_tables(float* TABC, float* TABS, int bid, int nb) {
    const int tid = otid();
    for (int i = bid * 512 + tid; i < MT * 64; i += nb * 512) { const int m = i >> 6, j = i & 63; const int pos = m < TP ? m : PAST + ((m - TP) & 31);
        const float inv = powf(10000.f, -(float)j * (1.f / 64.f)); float sn, cs; sincosf((float)pos * inv, &sn, &cs); TABC[i] = cs; TABS[i] = sn; }
}
__device__ __forceinline__ void item_gla_u(KCtxP kc_, unsigned char* ws_, int l, int ug, int kb, int lane) {
    using namespace mx;
    const int slot = ug >> 2, h = ug & 3, L = slot_len(slot), tok0 = slot_tok0(slot), r32 = lane & 31, hi = lane >> 5, nlb = L >> 5;
    const bf16* PB = (const bf16*)(ws_ + WS_PROJ); const float* SIDE = (const float*)(ws_ + WS_SIDE);
    const int k = kb * 32 + r32, hk = h * 64 + k;
    const float* Wgg = kc_->in[I_WGG] + (size_t)l * 16 * 256; const float bg = kc_->in[I_BGG][l * 256 + hk];
    bf16x8 wf; { float w[8];
#pragma unroll
        for (int j = 0; j < 8; ++j) w[j] = Wgg[(8 * hi + j) * 256 + hk];
        wf = pack8((f32x4){w[0], w[1], w[2], w[3]}, (f32x4){w[4], w[5], w[6], w[7]}); }
    float la[2][16];
#pragma unroll
    for (int lb = 0; lb < 2; ++lb) {
        if (lb < nlb) { const float* gp = SIDE + (size_t)(tok0 + lb * 32 + r32) * 32 + 8 * hi;
            const bf16x8 af = pack8(*(const f32x4*)gp, *(const f32x4*)(gp + 4)); f32x16 sp = {}; sp = MX_MFMA(af, wf, sp);
#pragma unroll
            for (int r = 0; r < 16; ++r) la[lb][r] = logsig_fast(sp[r] + bg) * (1.f / 16.f); }
        else {
#pragma unroll
            for (int r = 0; r < 16; ++r) la[lb][r] = 0.f; }
    }
    float run = 0.f;
#pragma unroll
    for (int lb = 0; lb < 2; ++lb)
#pragma unroll
        for (int g = 0; g < 4; ++g) { float* v = &la[lb][4 * g]; v[1] += v[0]; v[2] += v[1]; v[3] += v[2]; const float gs = v[3], pg = __shfl_xor(gs, 32);
            const float off = run + (hi ? pg : 0.f); v[0] += off; v[1] += off; v[2] += off; v[3] += off; run += gs + pg; }
    const float tot = run;
    bf16x8 kf[4];
#pragma unroll
    for (int lb = 0; lb < 2; ++lb) {
        float kp[16];
#pragma unroll
        for (int r = 0; r < 16; ++r) kp[r] = 0.f;
        if (lb < nlb) {
#pragma unroll
            for (int r = 0; r < 16; ++r) kp[r] = bf2f(PB[(size_t)(tok0 + lb * 32 + crow(r, hi)) * PBP + PB_GK + hk]) * __expf(tot - la[lb][r]); }
        kf[2 * lb] = pack8((f32x4){kp[0], kp[1], kp[2], kp[3]}, (f32x4){kp[4], kp[5], kp[6], kp[7]});
        kf[2 * lb + 1] = pack8((f32x4){kp[8], kp[9], kp[10], kp[11]}, (f32x4){kp[12], kp[13], kp[14], kp[15]});
    }
    const unsigned voff = (unsigned)((4 * hi * PBP + r32) * 2);
    float* U = (float*)(ws_ + WS_GU);
    f32x16 acc[4];
#pragma unroll
    for (int vb = 0; vb < 4; ++vb) { acc[vb] = (f32x16){};
#pragma unroll
        for (int t = 0; t < 4; ++t) if (t < 2 * nlb) { unsigned short x[8]; ld_slab8h(x, PB + (size_t)(tok0 + 16 * t) * PBP + PB_GV + h * 128 + vb * 32, PBP, voff);
            acc[vb] = MX_MFMA(kf[t], frag8h(x), acc[vb]); }
        asm volatile("" ::: "memory"); }
    if (hi == 0) ((float*)(ws_ + WS_GDEC))[(size_t)ug * 64 + k] = __expf(tot);
    if (slot < 128) {
#pragma unroll
        for (int vb = 0; vb < 4; ++vb) { float* up = U + ((((size_t)ug * 2 + kb) * 4 + vb) * 64 + lane) * 16;
#pragma unroll
            for (int g = 0; g < 4; ++g) *(f32x4*)(up + 4 * g) = (f32x4){acc[vb][4 * g], acc[vb][4 * g + 1], acc[vb][4 * g + 2], acc[vb][4 * g + 3]}; }
    } else {
        const int b = slot - 128; float dk[16];
#pragma unroll
        for (int r = 0; r < 16; ++r) dk[r] = __expf(__shfl(tot, crow(r, hi)));
#pragma unroll
        for (int vb = 0; vb < 4; ++vb) { const float* s0p = kc_->in[I_SGLA] + (((size_t)l * NSB + b) * 4 + h) * 8192 + (size_t)(vb * 32 + r32); float s0v[16];
#pragma unroll
            for (int r = 0; r < 16; ++r) s0v[r] = s0p[(size_t)(kb * 32 + crow(r, hi)) * 128];
            float* so = kc_->out + O_GLAS + (((size_t)l * NSB + b) * 4 + h) * 8192 + (size_t)(vb * 32 + r32); unsigned short sh[16];
#pragma unroll
            for (int r = 0; r < 16; ++r) { const float S = dk[r] * s0v[r] + acc[vb][r]; so[(size_t)(kb * 32 + crow(r, hi)) * 128] = S; sh[r] = (unsigned short)f2bf(S); }
            bf16* gp = (bf16*)(ws_ + WS_GS) + ((((size_t)ug * 2 + kb) * 4 + vb) * 64 + lane) * 16;
            *(u32x4*)gp = (u32x4){(unsigned)sh[0] | ((unsigned)sh[1] << 16), (unsigned)sh[2] | ((unsigned)sh[3] << 16), (unsigned)sh[4] | ((unsigned)sh[5] << 16), (unsigned)sh[6] | ((unsigned)sh[7] << 16)};
            *(u32x4*)(gp + 8) = (u32x4){(unsigned)sh[8] | ((unsigned)sh[9] << 16), (unsigned)sh[10] | ((unsigned)sh[11] << 16), (unsigned)sh[12] | ((unsigned)sh[13] << 16), (unsigned)sh[14] | ((unsigned)sh[15] << 16)}; }
    }
}
__device__ __forceinline__ void item_ret_u(KCtxP kc_, unsigned char* ws_, int l, int ug, int kb, int lane) {
    using namespace mx;
    const int slot = ug >> 2, h = ug & 3, L = slot_len(slot), tok0 = slot_tok0(slot), r32 = lane & 31, hi = lane >> 5, nt = L >> 4;
    const bf16* PB = (const bf16*)(ws_ + WS_PROJ); const float* TABC = (const float*)(ws_ + WS_TABC); const float* TABS = (const float*)(ws_ + WS_TABS);
    const int k = kb * 32 + r32, jf = k & 63; const bool low = kb < 2; const float lg = ret_logg(h);
    const unsigned koff = (unsigned)((4 * hi * PBP + k) * 2), poff = (unsigned)((4 * hi * PBP + (k ^ 64)) * 2), toff = (unsigned)((4 * hi * 64 + jf) * 4);
    bf16x8 kf[4];
#pragma unroll
    for (int t = 0; t < 4; ++t) { float y[8];
#pragma unroll
        for (int j = 0; j < 8; ++j) y[j] = 0.f;
        if (t < nt) { unsigned short xsh[8], xph[8]; float xs[8], xp[8], cs[8], sn[8];
            ld_slab8h(xsh, PB + (size_t)(tok0 + 16 * t) * PBP + PB_RK + h * 128, PBP, koff); ld_slab8h(xph, PB + (size_t)(tok0 + 16 * t) * PBP + PB_RK + h * 128, PBP, poff);
#pragma unroll
            for (int j = 0; j < 8; ++j) { xs[j] = bf2f(xsh[j]); xp[j] = bf2f(xph[j]); }
            ld_slab8(cs, TABC + (size_t)(tok0 + 16 * t) * 64, 64, toff); ld_slab8(sn, TABS + (size_t)(tok0 + 16 * t) * 64, 64, toff);
#pragma unroll
            for (int j = 0; j < 8; ++j) { const int ll = 16 * t + 8 * (j >> 2) + 4 * hi + (j & 3); const float rot = low ? xs[j] * cs[j] - xp[j] * sn[j] : xp[j] * sn[j] + xs[j] * cs[j];
                y[j] = rot * __expf(lg * (float)(L - 1 - ll)); } }
        kf[t] = pack8((f32x4){y[0], y[1], y[2], y[3]}, (f32x4){y[4], y[5], y[6], y[7]}); }
    const unsigned voff = (unsigned)((4 * hi * PBP + r32) * 2);
    float* U = (float*)(ws_ + WS_RU); bf16x8* VT = (bf16x8*)(ws_ + WS_RVT);
    f32x16 acc[4];
#pragma unroll
    for (int vb = 0; vb < 4; ++vb) { acc[vb] = (f32x16){};
#pragma unroll
        for (int t = 0; t < 4; ++t) if (t < nt) { unsigned short x[8]; ld_slab8h(x, PB + (size_t)(tok0 + 16 * t) * PBP + PB_RV + h * 128 + vb * 32, PBP, voff);
            const bf16x8 vf = frag8h(x); if (kb == 0) VT[(((size_t)ug * 4 + vb) * 4 + t) * 64 + lane] = vf;
            acc[vb] = MX_MFMA(kf[t], vf, acc[vb]); }
        asm volatile("" ::: "memory"); }
    if (slot < 128) {
#pragma unroll
        for (int vb = 0; vb < 4; ++vb) { float* up = U + ((((size_t)ug * 4 + kb) * 4 + vb) * 64 + lane) * 16;
#pragma unroll
            for (int g = 0; g < 4; ++g) *(f32x4*)(up + 4 * g) = (f32x4){acc[vb][4 * g], acc[vb][4 * g + 1], acc[vb][4 * g + 2], acc[vb][4 * g + 3]}; }
    } else {
        const int b = slot - 128; const float dec = __expf(lg * 32.f);
#pragma unroll
        for (int vb = 0; vb < 4; ++vb) { const float* s0p = kc_->in[I_SRET] + (((size_t)l * NSB + b) * 4 + h) * 16384 + (size_t)(vb * 32 + r32); float s0v[16];
#pragma unroll
            for (int r = 0; r < 16; ++r) s0v[r] = s0p[(size_t)(kb * 32 + crow(r, hi)) * 128];
            float* so = kc_->out + O_RETS + (((size_t)l * NSB + b) * 4 + h) * 16384 + (size_t)(vb * 32 + r32); unsigned short sh[16];
#pragma unroll
            for (int r = 0; r < 16; ++r) { so[(size_t)(kb * 32 + crow(r, hi)) * 128] = dec * s0v[r] + acc[vb][r]; sh[r] = (unsigned short)f2bf(s0v[r]); }
            bf16* gp = (bf16*)(ws_ + WS_RSP) + ((((size_t)ug * 4 + kb) * 4 + vb) * 64 + lane) * 16;
            *(u32x4*)gp = (u32x4){(unsigned)sh[0] | ((unsigned)sh[1] << 16), (unsigned)sh[2] | ((unsigned)sh[3] << 16), (unsigned)sh[4] | ((unsigned)sh[5] << 16), (unsigned)sh[6] | ((unsigned)sh[7] << 16)};
            *(u32x4*)(gp + 8) = (u32x4){(unsigned)sh[8] | ((unsigned)sh[9] << 16), (unsigned)sh[10] | ((unsigned)sh[11] << 16), (unsigned)sh[12] | ((unsigned)sh[13] << 16), (unsigned)sh[14] | ((unsigned)sh[15] << 16)}; }
    }
}
__device__ __forceinline__ void phase_mix_u(const Ctx& c, int l, int bid, int nb) {
    OPQ_PTRS; (void)out_;
    const int tid = otid(), lane = tid & 63, skip = nb > 16 ? 8 : 0;
    const int gw = (bid - skip) * 8 + __builtin_amdgcn_readfirstlane(tid >> 6), ngw = (nb - skip) * 8;
    constexpr int N_G = NSLOT * 4 * 2, N_R = NSLOT * 4 * 4;
    if (bid >= skip)
    for (int it = gw; it < N_G + N_R; it += ngw) {
        if (it < N_R) item_ret_u(kc_, ws_, l, it >> 2, it & 3, lane);
        else { const int r = it - N_R; item_gla_u(kc_, ws_, l, r >> 1, r & 1, lane); }
    }
}
__device__ __forceinline__ void phase_scans(const Ctx& c, int l, int bid, int nb) {
    OPQ_PTRS;
    const int tid = otid();
    const float* GU = (const float*)(ws_ + WS_GU); const float* GDEC = (const float*)(ws_ + WS_GDEC); bf16* GS = (bf16*)(ws_ + WS_GS);
    const float* RU = (const float*)(ws_ + WS_RU); bf16* RS = (bf16*)(ws_ + WS_RSP);
    constexpr int EG = 4 * 64 * 128, ER = 4 * 128 * 128, WG = EG / 512, WR = ER / 512;
    for (int w = bid; w < WG + WR; w += nb) {
        if (w < WG) { const int e = w * 512 + tid, h = e >> 13, ee = e & 8191;
            const int r = ee & 15, ln = (ee >> 4) & 63, vb = (ee >> 10) & 3, kb = ee >> 12, k = kb * 32 + mx::crow(r, ln >> 5), v = vb * 32 + (ln & 31), hk = h * 64 + k;
            float S = 0.f;
            for (int c0 = 0; c0 < 128; c0 += 32) { float uu[32], dd[32];
#pragma unroll
                for (int i = 0; i < 32; ++i) { uu[i] = GU[(size_t)(c0 + i) * EG + e]; dd[i] = GDEC[(size_t)(c0 + i) * 256 + hk]; }
#pragma unroll
                for (int i = 0; i < 32; ++i) { S = dd[i] * S + uu[i]; GS[(size_t)(c0 + i) * EG + e] = (bf16)f2bf(S); } }
            out_[O_GLAP + (size_t)l * EG + h * 8192 + k * 128 + v] = S;
        } else { const int e = (w - WG) * 512 + tid, h = e >> 14, ee = e & 16383;
            const int r = ee & 15, ln = (ee >> 4) & 63, vb = (ee >> 10) & 3, kb = ee >> 12, k = kb * 32 + mx::crow(r, ln >> 5), v = vb * 32 + (ln & 31); const float lg = ret_logg(h);
            const float dec = __expf(lg * 64.f); float S = 0.f;
            for (int c0 = 0; c0 < 128; c0 += 32) { float uu[32];
#pragma unroll
                for (int i = 0; i < 32; ++i) uu[i] = RU[(size_t)(c0 + i) * ER + e];
#pragma unroll
                for (int i = 0; i < 32; ++i) { RS[(size_t)(c0 + i) * ER + e] = (bf16)f2bf(S); S = dec * S + uu[i]; } }
            out_[O_RETP + (size_t)l * ER + h * 16384 + k * 128 + v] = S;
        }
    }
}
__device__ __forceinline__ void item_gla_o(KCtxP kc_, unsigned char* ws_, int l, int ug, int lh, int lane, const LAS float* gains) {
    using namespace mx;
    const int slot = ug >> 2, h = ug & 3, tok = slot_tok0(slot) + lh * 32 + (lane & 31), hi = lane >> 5;
    const bf16* PB = (const bf16*)(ws_ + WS_PROJ); const bf16* GS = (const bf16*)(ws_ + WS_GS);
    const bf16* qp = PB + (size_t)tok * PBP + PB_GQ + h * 64 + 4 * hi;
    u32x2v graw[16];
    { const bf16* gate = PB + (size_t)tok * PBP + PB_GG + h * 128 + 4 * hi;
#pragma unroll
      for (int i = 0; i < 16; ++i) graw[i] = *(const u32x2v*)(gate + (i >> 2) * 32 + 8 * (i & 3)); }
    bf16x8 qf[4];
#pragma unroll
    for (int s = 0; s < 4; ++s) qf[s] = ld8slot(qp + 16 * s);
    f32x16 acc[4];
#pragma unroll
    for (int vb = 0; vb < 4; ++vb) { acc[vb] = (f32x16){};
#pragma unroll
        for (int kb = 0; kb < 2; ++kb)
#pragma unroll
            for (int t = 0; t < 2; ++t) acc[vb] = MX_MFMA(*(const bf16x8*)(GS + ((((size_t)ug * 2 + kb) * 4 + vb) * 64 + lane) * 16 + 8 * t), qf[2 * kb + t], acc[vb]); }
    float ss = 0.f;
#pragma unroll
    for (int vb = 0; vb < 4; ++vb)
#pragma unroll
        for (int r = 0; r < 16; ++r) ss += acc[vb][r] * acc[vb][r];
    ss += __shfl_xor(ss, 32);
    const float rn = rsqrtf(ss * (1.f / 128.f) + EPS);
    bf16* op = (bf16*)(ws_ + WS_MRG) + (size_t)tok * DM + h * 128 + 4 * hi; const LAS float* gl = gains + 4 * hi;
    u32x2v w[16];
#pragma unroll
    for (int vb = 0; vb < 4; ++vb)
#pragma unroll
        for (int g = 0; g < 4; ++g) { const u32x2v gr = graw[vb * 4 + g]; const f32x4 gt = {__uint_as_float(gr.x << 16), __uint_as_float(gr.x & 0xffff0000u), __uint_as_float(gr.y << 16), __uint_as_float(gr.y & 0xffff0000u)};
            const f32x4 gn = *(const LAS f32x4*)(gl + vb * 32 + 8 * g);
            w[vb * 4 + g].x = cvtpk(acc[vb][4 * g] * rn * gn[0] * silu_fast(gt[0]), acc[vb][4 * g + 1] * rn * gn[1] * silu_fast(gt[1]));
            w[vb * 4 + g].y = cvtpk(acc[vb][4 * g + 2] * rn * gn[2] * silu_fast(gt[2]), acc[vb][4 * g + 3] * rn * gn[3] * silu_fast(gt[3])); }
#pragma unroll
    for (int vb = 0; vb < 4; ++vb)
#pragma unroll
        for (int g = 0; g < 4; ++g) *(u32x2v*)(op + vb * 32 + 8 * g) = w[vb * 4 + g];
}
__device__ __forceinline__ void rope_frags(mx::bf16x8 (&f)[8], const bf16* xr, const float* tc, const float* ts) {
    using namespace mx;
#pragma unroll
    for (int kb = 0; kb < 2; ++kb)
#pragma unroll
        for (int t = 0; t < 2; ++t) { const int o = kb * 32 + 16 * t;
            const f32x4 a0 = ld4bf(xr + o), a1 = ld4bf(xr + o + 8), b0 = ld4bf(xr + 64 + o), b1 = ld4bf(xr + 64 + o + 8);
            const f32x4 c0 = *(const f32x4*)(tc + o), c1 = *(const f32x4*)(tc + o + 8), s0 = *(const f32x4*)(ts + o), s1 = *(const f32x4*)(ts + o + 8);
            f[2 * kb + t] = pack8(a0 * c0 - b0 * s0, a1 * c1 - b1 * s1); f[2 * (kb + 2) + t] = pack8(a0 * s0 + b0 * c0, a1 * s1 + b1 * c1); }
}
__device__ __forceinline__ void item_ret_o(KCtxP kc_, unsigned char* ws_, int l, int ug, int lh, int lane, const LAS float* gains) {
    using namespace mx;
    const int slot = ug >> 2, h = ug & 3, L = slot_len(slot), tok0 = slot_tok0(slot), r32 = lane & 31, hi = lane >> 5, lq = lh * 32 + r32, tok = tok0 + lq, nsb = L >> 5;
    const bf16* PB = (const bf16*)(ws_ + WS_PROJ); const float* TABC = (const float*)(ws_ + WS_TABC); const float* TABS = (const float*)(ws_ + WS_TABS);
    const bf16* RS = (const bf16*)(ws_ + WS_RSP); const bf16x8* VT = (const bf16x8*)(ws_ + WS_RVT);
    const float lg2 = ret_logg(h) * 1.4426950408889634f;
    u32x2v graw[16];
    { const bf16* gate = PB + (size_t)tok * PBP + PB_RG + h * 128 + 4 * hi;
#pragma unroll
      for (int i = 0; i < 16; ++i) graw[i] = *(const u32x2v*)(gate + (i >> 2) * 32 + 8 * (i & 3)); }
    bf16x8 qf[8];
    rope_frags(qf, PB + (size_t)tok * PBP + PB_RQ + h * 128 + 4 * hi, TABC + (size_t)tok * 64 + 4 * hi, TABS + (size_t)tok * 64 + 4 * hi);
    f32x16 acc[4];
#pragma unroll
    for (int vb = 0; vb < 4; ++vb) { acc[vb] = (f32x16){};
#pragma unroll
        for (int kb = 0; kb < 4; ++kb)
#pragma unroll
            for (int t = 0; t < 2; ++t) acc[vb] = MX_MFMA(*(const bf16x8*)(RS + ((((size_t)ug * 4 + kb) * 4 + vb) * 64 + lane) * 16 + 8 * t), qf[2 * kb + t], acc[vb]); }
    { const float qi = __builtin_amdgcn_exp2f(lg2 * (float)(lq + 1));
#pragma unroll
      for (int vb = 0; vb < 4; ++vb)
#pragma unroll
          for (int r = 0; r < 16; ++r) acc[vb][r] *= qi; }
#pragma unroll
    for (int sb = 0; sb < 2; ++sb) if (sb < nsb) {
        const int ts = tok0 + sb * 32 + r32; bf16x8 kf[8];
        rope_frags(kf, PB + (size_t)ts * PBP + PB_RK + h * 128 + 4 * hi, TABC + (size_t)ts * 64 + 4 * hi, TABS + (size_t)ts * 64 + 4 * hi);
        f32x16 sc = {};
#pragma unroll
        for (int s = 0; s < 8; ++s) sc = MX_MFMA(kf[s], qf[s], sc);
#pragma unroll
        for (int r = 0; r < 16; ++r) { const int sd = lq - (sb * 32 + crow(r, hi)); sc[r] *= __builtin_amdgcn_exp2f(lg2 * (float)(sd < 0 ? -sd : sd)); }
        const bf16x8 p0 = pack8((f32x4){sc[0], sc[1], sc[2], sc[3]}, (f32x4){sc[4], sc[5], sc[6], sc[7]}), p1 = pack8((f32x4){sc[8], sc[9], sc[10], sc[11]}, (f32x4){sc[12], sc[13], sc[14], sc[15]});
#pragma unroll
        for (int vb = 0; vb < 4; ++vb) { acc[vb] = MX_MFMA(VT[(((size_t)ug * 4 + vb) * 4 + 2 * sb) * 64 + lane], p0, acc[vb]); acc[vb] = MX_MFMA(VT[(((size_t)ug * 4 + vb) * 4 + 2 * sb + 1) * 64 + lane], p1, acc[vb]); }
    }
    float sm = 0.f;
#pragma unroll
    for (int vb = 0; vb < 4; ++vb)
#pragma unroll
        for (int r = 0; r < 16; ++r) sm += acc[vb][r];
    sm += __shfl_xor(sm, 32); const float mean = sm * (1.f / 128.f); float sq = 0.f;
#pragma unroll
    for (int vb = 0; vb < 4; ++vb)
#pragma unroll
        for (int r = 0; r < 16; ++r) { acc[vb][r] -= mean; sq += acc[vb][r] * acc[vb][r]; }
    sq += __shfl_xor(sq, 32);
    const float rn = rsqrtf(sq * (1.f / 128.f) + EPS);
    bf16* op = (bf16*)(ws_ + WS_MRG) + (size_t)tok * DM + 512 + h * 128 + 4 * hi; const LAS float* gl = gains + 128 + 4 * hi;
    u32x2v w[16];
#pragma unroll
    for (int vb = 0; vb < 4; ++vb)
#pragma unroll
        for (int g = 0; g < 4; ++g) { const u32x2v gr = graw[vb * 4 + g]; const f32x4 gt = {__uint_as_float(gr.x << 16), __uint_as_float(gr.x & 0xffff0000u), __uint_as_float(gr.y << 16), __uint_as_float(gr.y & 0xffff0000u)};
            const f32x4 gn = *(const LAS f32x4*)(gl + vb * 32 + 8 * g);
            w[vb * 4 + g].x = cvtpk(acc[vb][4 * g] * rn * gn[0] * silu_fast(gt[0]), acc[vb][4 * g + 1] * rn * gn[1] * silu_fast(gt[1]));
            w[vb * 4 + g].y = cvtpk(acc[vb][4 * g + 2] * rn * gn[2] * silu_fast(gt[2]), acc[vb][4 * g + 3] * rn * gn[3] * silu_fast(gt[3])); }
#pragma unroll
    for (int vb = 0; vb < 4; ++vb)
#pragma unroll
        for (int g = 0; g < 4; ++g) *(u32x2v*)(op + vb * 32 + 8 * g) = w[vb * 4 + g];
}
__device__ __forceinline__ void phase_mix_o(const Ctx& c, int l, LAS unsigned char* lds, int bid, int nb) {
    OPQ_PTRS; (void)out_;
    LAS float* gains = (LAS float*)(lds + 135168);
    __syncthreads();
    if (threadIdx.x < 256) gains[threadIdx.x] = threadIdx.x < 128 ? kc_->in[I_GGLA][l * 128 + threadIdx.x] : kc_->in[I_GRET][l * 128 + threadIdx.x - 128];
    __syncthreads();
    const int tid = otid(), lane = tid & 63, wv = __builtin_amdgcn_readfirstlane(tid >> 6);
    constexpr int N_H = 128 * 4 * 2 + NSB * 4;
    const int nslots = nb * 8, s0 = bid * 8 + wv, ns = 1;
    for (int j = 0; ; ++j) { const int it = s0 + (ns == 2 ? (j & 1) + (j >> 1) * nslots : j * nslots); if (it >= 2 * N_H) break;
        const int r = it < N_H ? it : it - N_H; int ug, lh;
        if (r < 128 * 4 * 2) { ug = r >> 1; lh = r & 1; } else { ug = 128 * 4 + (r - 128 * 4 * 2); lh = 0; }
        if (it < N_H) item_ret_o(kc_, ws_, l, ug, lh, lane, gains); else item_gla_o(kc_, ws_, l, ug, lh, lane, gains);
    }
}

namespace fa {
typedef short bf16x8 __attribute__((ext_vector_type(8)));
typedef short s16x4 __attribute__((ext_vector_type(4)));
typedef float f32x16 __attribute__((ext_vector_type(16)));
typedef float f32x4 __attribute__((ext_vector_type(4)));
typedef unsigned u32x4 __attribute__((ext_vector_type(4)));
constexpr int D = 128, NW = 8, QBLK = 32, KVBLK = 64, QB = NW * QBLK;
constexpr int PQ = 1024;
constexpr int PO = 2048;
constexpr int SHM_V = KVBLK * D * 2, SHM_K = KVBLK * D * 2;
constexpr int OFF_WS = 2 * SHM_V + 2 * SHM_K;
constexpr int OFF_TAB = OFF_WS + NW * 64 * 4;
constexpr int LDS_NEED = OFF_TAB + 8192 * 4;
constexpr float SCALE = 0.08838834764831845f, THR = 16.f;
constexpr unsigned WBIG = 0x40000000u;

#define KSWZ(row, colB) ((row) * 256 + ((colB) ^ (((row) & 7) << 4)))
#define SBAR() __builtin_amdgcn_sched_barrier(0)
__device__ __forceinline__ int v_st(int k, int c) { const int kk = (k & ~0xC) | ((k & 4) << 1) | ((k & 8) >> 1); return ((kk >> 3) * 4 + (c >> 5)) * 512 + ((kk & 7) * 32 + (c & 31)) * 2; }
__device__ __forceinline__ int v_rd_base(int lane) { return ((lane & 3) << 3) | (((lane >> 2) & 3) << 6) | (((lane >> 4) & 1) << 5) | (((lane >> 5) & 1) << 8); }
constexpr int v_rd_off(int d0, int ks, int half) { return d0 * 512 + ks * 4096 + half * 2048; }
__device__ __forceinline__ int crow(int r, int hi) { return (r & 3) + 8 * (r >> 2) + 4 * hi; }
__device__ __forceinline__ unsigned cvtpk(float lo, float hi) { unsigned r; asm volatile("v_cvt_pk_bf16_f32 %0, %1, %2" : "=v"(r) : "v"(lo), "v"(hi)); return r; }
__device__ __forceinline__ bf16x8 load8(const bf16* p) { return *reinterpret_cast<const bf16x8*>(p); }
__device__ __forceinline__ void mask_tile(f32x16& p0, f32x16& p1, int dq, unsigned W) {
    const float NEG = -__builtin_inff();
#pragma unroll
    for (int r = 0; r < 16; ++r) {
        const int c = (r & 3) + 8 * (r >> 2);
        if ((unsigned)(dq - c) >= W) p0[r] = NEG;
        if ((unsigned)(dq - c - 32) >= W) p1[r] = NEG;
    }
}
__device__ __forceinline__ void partialSM(f32x16& p0, f32x16& p1, float& m_reg, float& mn, float& alpha) {
    float pmax = p0[0];
#pragma unroll
    for (int r = 1; r < 16; ++r) pmax = fmaxf(pmax, p0[r]);
#pragma unroll
    for (int r = 0; r < 16; ++r) pmax = fmaxf(pmax, p1[r]);
    { auto rr = __builtin_amdgcn_permlane32_swap(__float_as_uint(pmax), __float_as_uint(pmax), false, false);
      pmax = fmaxf(__uint_as_float(rr[0]), __uint_as_float(rr[1])); }
    constexpr float C2 = 1.4426950408889634f * SCALE;
    if (__builtin_expect(__all((pmax - m_reg) * SCALE <= THR), 1)) { mn = m_reg; alpha = 1.f; }
    else { mn = fmaxf(m_reg, pmax); alpha = __builtin_amdgcn_exp2f((m_reg - mn) * C2); m_reg = mn; }
    const float mnL = -mn * C2;
#pragma unroll
    for (int r = 0; r < 16; ++r) p0[r] = fmaf(p0[r], C2, mnL);
#pragma unroll
    for (int r = 0; r < 16; ++r) p1[r] = fmaf(p1[r], C2, mnL);
#pragma unroll
    for (int r = 0; r < 16; ++r) p0[r] = __builtin_amdgcn_exp2f(p0[r]);
}
__device__ __forceinline__ void finishSM(f32x16& p0, f32x16& p1, float alpha, float& l_reg, bf16x8& pa0, bf16x8& pa1, bf16x8& pa2, bf16x8& pa3) {
#pragma unroll
    for (int r = 0; r < 16; ++r) p1[r] = __builtin_amdgcn_exp2f(p1[r]);
    float ps = 0;
#pragma unroll
    for (int r = 0; r < 16; ++r) ps += p0[r];
#pragma unroll
    for (int r = 0; r < 16; ++r) ps += p1[r];
    { auto rr = __builtin_amdgcn_permlane32_swap(__float_as_uint(ps), __float_as_uint(ps), false, false);
      ps = __uint_as_float(rr[0]) + __uint_as_float(rr[1]); }
    l_reg = l_reg * alpha + ps;
#define PK4(P, B_, OUT) do { unsigned a0 = cvtpk(P[B_+0], P[B_+1]), a1 = cvtpk(P[B_+2], P[B_+3]);                          \
        unsigned b0 = cvtpk(P[B_+4], P[B_+5]), b1 = cvtpk(P[B_+6], P[B_+7]);                                             \
        auto r0 = __builtin_amdgcn_permlane32_swap(a0, b0, false, false); auto r1 = __builtin_amdgcn_permlane32_swap(a1, b1, false, false); \
        u32x4 w = {r0[0], r1[0], r0[1], r1[1]}; OUT = *reinterpret_cast<bf16x8*>(&w); } while (0)
    PK4(p0, 0, pa0); PK4(p0, 8, pa1); PK4(p1, 0, pa2); PK4(p1, 8, pa3);
#undef PK4
}
template <int KB>
__device__ __forceinline__ void qkt(f32x16& p0, f32x16& p1, const LAS char* K_lds, int r32, int hi, const bf16x8* qr, const LAS float* tb) {
    { const f32x4 a0 = *(const LAS f32x4*)(tb), a1 = *(const LAS f32x4*)(tb + 8), a2 = *(const LAS f32x4*)(tb + 16), a3 = *(const LAS f32x4*)(tb + 24);
      const f32x4 b0 = *(const LAS f32x4*)(tb + 32), b1 = *(const LAS f32x4*)(tb + 40), b2 = *(const LAS f32x4*)(tb + 48), b3 = *(const LAS f32x4*)(tb + 56);
      p0 = (f32x16){a0[0], a0[1], a0[2], a0[3], a1[0], a1[1], a1[2], a1[3], a2[0], a2[1], a2[2], a2[3], a3[0], a3[1], a3[2], a3[3]};
      p1 = (f32x16){b0[0], b0[1], b0[2], b0[3], b1[0], b1[1], b1[2], b1[3], b2[0], b2[1], b2[2], b2[3], b3[0], b3[1], b3[2], b3[3]}; }
    int kx = ((r32 >> 1) & 3) << 5; const int kb0 = r32 * 256 + ((hi * 16) ^ ((r32 & 1) << 4)); asm volatile("" : "+v"(kx));
#pragma unroll
    for (int d0 = 0; d0 < 8; ++d0) { const LAS char* a = K_lds + KB * SHM_K + (d0 >> 2) * 128 + kb0 + (((d0 & 3) * 32) ^ kx);
        bf16x8 b0 = *reinterpret_cast<const LAS bf16x8*>(a);
        bf16x8 b1 = *reinterpret_cast<const LAS bf16x8*>(a + 32 * 256);
        p0 = __builtin_amdgcn_mfma_f32_32x32x16_bf16(b0, qr[d0], p0, 0, 0, 0);
        p1 = __builtin_amdgcn_mfma_f32_32x32x16_bf16(b1, qr[d0], p1, 0, 0, 0); }
}
template <int VB>
__device__ __forceinline__ void pv_tile(f32x16* o, int vb0, bf16x8 pa0, bf16x8 pa1, bf16x8 pa2, bf16x8 pa3) {
#define TRRD(dst, off) asm volatile("ds_read_b64_tr_b16 %0, %1 offset:%2" : "=&v"(dst) : "v"(vb0), "i"(off) : "memory")
#define PV_D0(d0) do { s16x4 l0, l1, l2, l3, h0, h1, h2, h3; constexpr int b_ = VB * SHM_V + v_rd_off(d0, 0, 0);     \
        TRRD(l0, b_); TRRD(h0, b_ + 2048); TRRD(l1, b_ + 4096); TRRD(h1, b_ + 6144); TRRD(l2, b_ + 8192); TRRD(h2, b_ + 10240); TRRD(l3, b_ + 12288); TRRD(h3, b_ + 14336); \
        asm volatile("s_waitcnt lgkmcnt(0)" ::: "memory"); SBAR();                                                         \
        o[d0] = __builtin_amdgcn_mfma_f32_32x32x16_bf16(pa0, (bf16x8){l0[0], l0[1], l0[2], l0[3], h0[0], h0[1], h0[2], h0[3]}, o[d0], 0, 0, 0);   \
        o[d0] = __builtin_amdgcn_mfma_f32_32x32x16_bf16(pa1, (bf16x8){l1[0], l1[1], l1[2], l1[3], h1[0], h1[1], h1[2], h1[3]}, o[d0], 0, 0, 0);   \
        o[d0] = __builtin_amdgcn_mfma_f32_32x32x16_bf16(pa2, (bf16x8){l2[0], l2[1], l2[2], l2[3], h2[0], h2[1], h2[2], h2[3]}, o[d0], 0, 0, 0);   \
        o[d0] = __builtin_amdgcn_mfma_f32_32x32x16_bf16(pa3, (bf16x8){l3[0], l3[1], l3[2], l3[3], h3[0], h3[1], h3[2], h3[3]}, o[d0], 0, 0, 0); } while (0)
    PV_D0(0); PV_D0(1); PV_D0(2); PV_D0(3);
#undef PV_D0
#undef TRRD
}

struct BlockRef { const bf16* Q; const bf16* K; const bf16* V; bf16* O; float* part; int P0, j_lo, j_hi; };
constexpr int PART_FLOATS = 256 * 128 + 512;
struct Seam { bf16x8 qr[8]; bf16x8 st_v0, st_v1, st_k0, st_k1; };
__device__ __forceinline__ bf16x8 ld16(const bf16* base, unsigned off) { return *reinterpret_cast<const bf16x8*>((const char*)base + off); }
#define VMW() asm volatile("s_waitcnt vmcnt(0)" ::: "memory")
#define VMWN(n) asm volatile("s_waitcnt vmcnt(%0)" :: "i"(n) : "memory")
#define SLOAD_H(Kp, Vp, k0) do { S.st_v0 = ld16((Vp) + (size_t)(k0) * PQ, lo_kv); S.st_v1 = ld16((Vp) + (size_t)((k0) + 32) * PQ, lo_kv);              \
                         S.st_k0 = ld16((Kp) + (size_t)(k0) * PQ, lo_kv); S.st_k1 = ld16((Kp) + (size_t)((k0) + 32) * PQ, lo_kv); } while (0)
#define SWRITE_HK(bf) do { *(LAS bf16x8*)(K_lds + (bf) * SHM_K + kws) = S.st_k0; *(LAS bf16x8*)(K_lds + (bf) * SHM_K + kws + 32 * 256) = S.st_k1; } while (0)
#define SWRITE_HV(bf) do { *(LAS bf16x8*)(V_lds + (bf) * SHM_V + vst0) = S.st_v0; *(LAS bf16x8*)(V_lds + (bf) * SHM_V + vst0 + 8192) = S.st_v1; } while (0)
#define SWRITE_H(bf) do { SWRITE_HV(bf); SWRITE_HK(bf); } while (0)
__device__ __forceinline__ void prime(const BlockRef& cur, LAS char* lds, Seam& S, int tid) {
    const int wid = __builtin_amdgcn_readfirstlane(tid >> 6), lane = tid & 63, r32 = lane & 31, hi = lane >> 5;
    const int sr = tid >> 4, sc = (tid & 15) * 8, kws = KSWZ(sr, sc * 2); LAS char* K_lds = lds + 2 * SHM_V;
    const unsigned lo_kv = (unsigned)((sr * PQ + sc) * 2), lo_q = (unsigned)(((wid * QBLK + r32) * PQ + hi * 8) * 2);
    const int kb0 = cur.j_lo * KVBLK;
#pragma unroll
    for (int d0 = 0; d0 < 8; ++d0) S.qr[d0] = ld16(cur.Q + d0 * 16, lo_q);
    SLOAD_H(cur.K, cur.V, kb0); VMW(); SWRITE_HK(0);
    __syncthreads();
}
__device__ __forceinline__ void block(const BlockRef& cur, const BlockRef& nxt, LAS char* lds, Seam& S, const float* gout, int tid) {
    const int wid = __builtin_amdgcn_readfirstlane(tid >> 6), lane = tid & 63, r32 = lane & 31, hi = lane >> 5;
    const int j_lo = cur.j_lo, NT = cur.j_hi - cur.j_lo;
    const int kbn = nxt.j_lo * KVBLK;
    const int qlo = cur.P0 + wid * QBLK;
    LAS char* V_lds = lds; LAS char* K_lds = lds + 2 * SHM_V;
    LAS float* ws = (LAS float*)(lds + OFF_WS) + wid * 64; LAS float* li_l = ws; LAS float* al_l = ws + 32;
    const LAS float* tab = (const LAS float*)(lds + OFF_TAB) + 4 * hi;
    float m_reg = -1e30f, l_reg = 0; f32x16 o[4] = {};
    const int sr = tid >> 4, sc = (tid & 15) * 8, vst0 = v_st(sr, sc), kws = KSWZ(sr, sc * 2);
    const int vb0 = (int)(uintptr_t)V_lds + v_rd_base(lane);
    const unsigned lo_kv = (unsigned)((sr * PQ + sc) * 2);
    const bf16* Kh = cur.K; const bf16* Vh = cur.V;
#define RESC(a) do { if (__any((a) < 1.f)) { if (hi == 0) al_l[r32] = (a); asm volatile("s_waitcnt lgkmcnt(0)" ::: "memory");              \
                     for (int d_ = 0; d_ < 4; ++d_) for (int r = 0; r < 16; ++r) o[d_][r] *= al_l[crow(r, hi)]; } } while (0)
#define KBASE(t) ((j_lo + (t)) * KVBLK)
#define MASKT(P0_, P1_, t) do { const int kb_ = KBASE(t); if (kb_ + KVBLK - 1 > qlo) { const int t_ = otid(); mask_tile(P0_, P1_, qlo + (t_ & 31) - 4 * ((t_ >> 5) & 1) - kb_, WBIG); } } while (0)
    constexpr int NQL = 8;
#define SEAM_K0() do { VMWN(NQL); SWRITE_HK(0); SBAR(); } while (0)
    f32x16 pA0, pA1, pB0, pB1; float mnA, mnB, alA, alB; bf16x8 pa0, pa1, pa2, pa3;
    SWRITE_HV(0); SBAR();
    if (NT > 1) { SLOAD_H(Kh, Vh, KBASE(1)); }
    SBAR(); qkt<0>(pA0, pA1, K_lds, r32, hi, S.qr, tab + KBASE(0));
    MASKT(pA0, pA1, 0); partialSM(pA0, pA1, m_reg, mnA, alA);
    if (NT > 1) { VMW(); SWRITE_H(1); }
    __syncthreads();
#define HALF_STEP(PX0, PX1, mnX, alX, PY0, PY1, alY, t, KB, VB, SB) do {                                                      \
        SBAR(); qkt<KB>(PX0, PX1, K_lds, r32, hi, S.qr, tab + KBASE(t));                                                      \
        finishSM(PY0, PY1, alY, l_reg, pa0, pa1, pa2, pa3); SBAR();                                                           \
        if ((t) + 1 < NT) { SLOAD_H(Kh, Vh, KBASE((t) + 1)); SBAR(); }                                                        \
        pv_tile<VB>(o, vb0, pa0, pa1, pa2, pa3); MASKT(PX0, PX1, (t)); partialSM(PX0, PX1, m_reg, mnX, alX);                  \
        __syncthreads();                                                                                                      \
        if ((t) + 1 < NT) { VMW(); SWRITE_H(SB); }                                                                            \
        RESC(alX); __syncthreads(); } while (0)
    for (int t = 1; t + 1 < NT; t += 2) {
        HALF_STEP(pB0, pB1, mnB, alB, pA0, pA1, alA, t, 1, 0, 0);
        HALF_STEP(pA0, pA1, mnA, alA, pB0, pB1, alB, t + 1, 0, 1, 1);
    }
    const bool even = (NT & 1) == 0;
    if (even) { SBAR(); qkt<1>(pB0, pB1, K_lds, r32, hi, S.qr, tab + KBASE(NT - 1)); SBAR(); }
    SLOAD_H(nxt.K, nxt.V, kbn); SBAR();
    { const int t_ = otid(); const unsigned lo_q = (unsigned)((((t_ >> 6) * QBLK + (t_ & 31)) * PQ + ((t_ >> 5) & 1) * 8) * 2);
#pragma unroll
      for (int d0 = 0; d0 < 8; ++d0) S.qr[d0] = ld16(nxt.Q + d0 * 16, lo_q); }
    SBAR();
    finishSM(pA0, pA1, alA, l_reg, pa0, pa1, pa2, pa3); SBAR();
    pv_tile<0>(o, vb0, pa0, pa1, pa2, pa3);
    if (even) { MASKT(pB0, pB1, NT - 1); partialSM(pB0, pB1, m_reg, mnB, alB); __syncthreads(); RESC(alB);
        finishSM(pB0, pB1, alB, l_reg, pa0, pa1, pa2, pa3); SBAR(); pv_tile<1>(o, vb0, pa0, pa1, pa2, pa3); }
    SBAR(); SEAM_K0();
    const int te = otid(), r32e = te & 31, hie = (te >> 5) & 1;
    if (cur.part) {
        float* pb = cur.part; const unsigned lo_p = (unsigned)((((te >> 6) * QBLK + 4 * hie) * 128 + r32e) * 4);
#pragma unroll
        for (int r = 0; r < 16; ++r) { const float* prow = pb + ((r & 3) + 8 * (r >> 2)) * 128;
#pragma unroll
            for (int d0 = 0; d0 < 4; ++d0) *(float*)((char*)prow + d0 * 128 + lo_p) = o[d0][r]; }
        if (hie == 0) { pb[256 * 128 + (te >> 6) * QBLK + r32e] = m_reg; pb[256 * 128 + 256 + (te >> 6) * QBLK + r32e] = l_reg; }
    } else {
    LAS float* li_e = (LAS float*)(lds + OFF_WS) + (te >> 6) * 64;
    if (hie == 0) li_e[r32e] = l_reg; asm volatile("s_waitcnt lgkmcnt(0)" ::: "memory");
    float gv[4];
#pragma unroll
    for (int d0 = 0; d0 < 4; ++d0) gv[d0] = gout[d0 * 32 + r32e];
    const unsigned lo_o = (unsigned)((((te >> 6) * QBLK + 4 * hie) * PO + r32e) * 2);
#pragma unroll
    for (int r = 0; r < 16; ++r) { const float rl = __builtin_amdgcn_rcpf(li_e[crow(r, hie)]); float s = 0.f; float v[4];
#pragma unroll
        for (int d0 = 0; d0 < 4; ++d0) { v[d0] = o[d0][r] * rl; s += v[d0] * v[d0]; }
        s += __shfl_xor(s, 1); s += __shfl_xor(s, 2); s += __shfl_xor(s, 4); s += __shfl_xor(s, 8); s += __shfl_xor(s, 16);
        const float rn = rsqrtf(s * (1.f / 128.f) + EPS);
        const bf16* orow = cur.O + (size_t)((r & 3) + 8 * (r >> 2)) * PO;
#pragma unroll
        for (int d0 = 0; d0 < 4; ++d0) { const float y = v[d0] * rn * gv[d0]; const float yn = __shfl_xor(y, 1);
            if ((r32e & 1) == 0) *(unsigned*)((char*)orow + d0 * 64 + lo_o) = cvtpk(y, yn); } }
    }
    __syncthreads();
#undef RESC
#undef KBASE
#undef MASKT
#undef SEAM_K0
#undef HALF_STEP
}
#undef VMW
#undef VMWN
#undef SLOAD_H
#undef SWRITE_HK
#undef SWRITE_HV
#undef SWRITE_H
}
__device__ __forceinline__ fa::BlockRef fa_ref(const bf16* QB, const bf16* KB, const bf16* VB, bf16* MRG, int h, int qb) {
    fa::BlockRef r; const int P0 = qb * 256;
    r.Q = QB + (size_t)P0 * 1024 + h * 128; r.K = KB + h * 128; r.V = VB + h * 128; r.O = MRG + (size_t)P0 * DM + 1024 + h * 128; r.part = nullptr;
    r.P0 = P0; r.j_lo = 0; r.j_hi = P0 / 64 + 4; return r;
}
constexpr int FA_SPLIT = 70;
__device__ __forceinline__ void phase_fox_prompt_split(const Ctx& c, int l, LAS unsigned char* lds, int bid, int nb) {
    OPQ_PTRS; (void)out_;
    const int tid = otid();
    const bf16* QB = (const bf16*)(ws_ + WS_QB); const bf16* KB = (const bf16*)(ws_ + WS_KB); const bf16* VB = (const bf16*)(ws_ + WS_VB); bf16* MRG = (bf16*)(ws_ + WS_MRG);
    const float* CKP = (const float*)(ws_ + WS_CKP); const float* gout = kc_->in[I_GFO] + l * 128; float* FP = (float*)(ws_ + WS_FPART);
    LAS float* tabw = (LAS float*)(lds + fa::OFF_TAB);
    for (int w = bid; w < 256; w += nb) {
        const int h = w >> 5, x = (w >> 1) & 15, role = w & 1, hb = h * 16 + x;
        __syncthreads();
        for (int j = tid; j < TP; j += 512) tabw[j] = CKP[(size_t)h * TP + j] * (-1.f / fa::SCALE);
        const int full = (31 - x) * 4 + 4, cut = FA_SPLIT < full - 2 ? FA_SPLIT : full - 2;
        int qb_c = 31 - x, jl_c = role ? cut : 0, jh_c = role ? full : cut; float* pt_c = FP + (size_t)(hb * 2 + role) * fa::PART_FLOATS;
        fa::Seam S;
        { fa::BlockRef cur = fa_ref(QB, KB, VB, MRG, h, qb_c); cur.j_lo = jl_c; cur.j_hi = jh_c; cur.part = pt_c; fa::prime(cur, (LAS char*)lds, S, tid); }
        for (int i = 0; ; ++i) {
            const bool last = (role == 0) || (i == 1);
            const int qb_n = last ? qb_c : x, jl_n = last ? jl_c : 0, jh_n = last ? jh_c : x * 4 + 4; float* pt_n = last ? pt_c : nullptr;
            fa::BlockRef cur = fa_ref(QB, KB, VB, MRG, h, qb_c); cur.j_lo = jl_c; cur.j_hi = jh_c; cur.part = pt_c;
            fa::BlockRef nxt = fa_ref(QB, KB, VB, MRG, h, qb_n); nxt.j_lo = jl_n; nxt.j_hi = jh_n; nxt.part = pt_n;
            fa::block(cur, nxt, (LAS char*)lds, S, gout, tid);
            if (last) break;
            qb_c = qb_n; jl_c = jl_n; jh_c = jh_n; pt_c = pt_n;
        }
    }
}
__device__ __forceinline__ void phase_fox_merge(const Ctx& c, int l, int bid, int nb) {
    OPQ_PTRS; (void)out_;
    const int tid = otid(), lane = tid & 63;
    const float* FP = (const float*)(ws_ + WS_FPART); bf16* MRG = (bf16*)(ws_ + WS_MRG); const float* gout = kc_->in[I_GFO] + l * 128;
    constexpr float C2 = 1.4426950408889634f * fa::SCALE;
    const float g0 = gout[2 * lane], g1 = gout[2 * lane + 1];
    const int gw = bid * 8 + (tid >> 6), ngw = nb * 8;
    for (int R = gw; R < 128 * 256; R += ngw) {
        const int hb = R >> 8, row = R & 255, h = hb >> 4, x = hb & 15, tok = (31 - x) * 256 + row;
        const float* pa = FP + (size_t)(hb * 2) * fa::PART_FLOATS; const float* pb = pa + fa::PART_FLOATS;
        const float ma = pa[32768 + row], la = pa[32768 + 256 + row], mb = pb[32768 + row], lb = pb[32768 + 256 + row];
        const float M = fmaxf(ma, mb), fa_ = __builtin_amdgcn_exp2f((ma - M) * C2), fb_ = __builtin_amdgcn_exp2f((mb - M) * C2), il = 1.f / (fa_ * la + fb_ * lb);
        const float a0 = pa[row * 128 + 2 * lane], a1 = pa[row * 128 + 2 * lane + 1], b0 = pb[row * 128 + 2 * lane], b1 = pb[row * 128 + 2 * lane + 1];
        const float y0 = (fa_ * a0 + fb_ * b0) * il, y1 = (fa_ * a1 + fb_ * b1) * il;
        const float rn = rsqrtf(wave_sum(y0 * y0 + y1 * y1) * (1.f / 128.f) + EPS);
        *(unsigned*)(MRG + (size_t)tok * DM + 1024 + h * 128 + 2 * lane) = pk2(y0 * rn * g0, y1 * rn * g1);
    }
}
__device__ __forceinline__ fa::bf16x8 pack8f(const f32x4 a, const f32x4 b) { fa::u32x4 w = {mx::cvtpk(a[0], a[1]), mx::cvtpk(a[2], a[3]), mx::cvtpk(b[0], b[1]), mx::cvtpk(b[2], b[3])}; return *reinterpret_cast<fa::bf16x8*>(&w); }
__device__ __forceinline__ float ldf(const float* ubase, unsigned off) { return *(const float*)((const char*)ubase + off); }
__device__ __forceinline__ f32x4 ldf4(const float* ubase, unsigned off) { return *(const f32x4*)((const char*)ubase + off); }
constexpr int SPART_FLOATS = 32 * 128 + 64;
__device__ __forceinline__ void phase_fox_sample_half(const Ctx& c, int l, LAS unsigned char* lds, int bid, int nb) {
    OPQ_PTRS;
    using fa::f32x16; using fa::bf16x8;
    const int tid = otid(), lane = tid & 63, wid = __builtin_amdgcn_readfirstlane(tid >> 6), r32 = lane & 31, hi = lane >> 5;
    const bf16* QB = (const bf16*)(ws_ + WS_QB); const float* CKS = (const float*)(ws_ + WS_CKS); float* SP = (float*)(ws_ + WS_SPART);
    constexpr float C2 = 1.4426950408889634f * fa::SCALE;
    LAS float* Ol = (LAS float*)lds;
    LAS float* ml = (LAS float*)(lds + 131072);
    LAS float* al = (LAS float*)(lds + 131072 + 2048) + wid * 32;
    const unsigned kvo = (unsigned)((r32 * 1024 + hi * 8) * 4), vvo = (unsigned)((hi * 8 * 1024 + r32) * 4), cko = (unsigned)(hi * 16);
    for (int u2 = bid; u2 < NSB * 8 * 2; u2 += nb) {
        const int u = u2 >> 1, half = u2 & 1, b = u >> 3, h = u & 7, tok0 = TP + b * TS, tlo = half ? 17 : 0, thi = half ? 33 : 17;
        const float* Kc = kc_->in[I_CK] + ((size_t)l * NSB + b) * PAST * 1024 + h * 128; const float* Vc = kc_->in[I_CV] + ((size_t)l * NSB + b) * PAST * 1024 + h * 128;
        const float* Kn = out_ + O_FKS + ((size_t)l * MS + b * TS) * 1024 + h * 128; const float* Vn = out_ + O_FVS + ((size_t)l * MS + b * TS) * 1024 + h * 128;
        const float* ck = CKS + (size_t)u * (PAST + TS);
        const bf16* qrow = QB + (size_t)(tok0 + r32) * 1024 + h * 128 + hi * 8;
        float m_reg = -1e30f, l_reg = 0.f; f32x16 o[4] = {};
        __syncthreads();
        for (int t = tlo + wid; t < thi; t += 8) {
            const int j0 = t * 32;
            const float* Kt = t < 32 ? Kc + (size_t)j0 * 1024 : Kn; const float* Vt = t < 32 ? Vc + (size_t)j0 * 1024 : Vn; const float* ckt = ck + j0;
            f32x16 p = {};
            { f32x4 kraw[16]; bf16x8 qr[8];
#pragma unroll
              for (int d0 = 0; d0 < 8; ++d0) { kraw[2 * d0] = ldf4(Kt + d0 * 16, kvo); kraw[2 * d0 + 1] = ldf4(Kt + d0 * 16 + 4, kvo); qr[d0] = *(const bf16x8*)(qrow + d0 * 16); }
              asm volatile("" ::: "memory");
#pragma unroll
              for (int d0 = 0; d0 < 8; ++d0) p = __builtin_amdgcn_mfma_f32_32x32x16_bf16(pack8f(kraw[2 * d0], kraw[2 * d0 + 1]), qr[d0], p, 0, 0, 0); }
            f32x4 cb[4]; float v0[32], v1[32];
#pragma unroll
            for (int g = 0; g < 4; ++g) cb[g] = ldf4(ckt + 8 * g, cko);
#pragma unroll
            for (int d0 = 0; d0 < 4; ++d0)
#pragma unroll
                for (int jj = 0; jj < 8; ++jj) { v0[d0 * 8 + jj] = ldf(Vt + (size_t)jj * 1024 + d0 * 32, vvo); v1[d0 * 8 + jj] = ldf(Vt + (size_t)(16 + jj) * 1024 + d0 * 32, vvo); }
            asm volatile("" ::: "memory");
            { const float ns = -1.f / fa::SCALE;
#pragma unroll
              for (int r = 0; r < 16; ++r) p[r] += cb[r >> 2][r & 3] * ns; }
            if (t == 32) {
#pragma unroll
                for (int r = 0; r < 16; ++r) if (fa::crow(r, hi) > r32) p[r] = -__builtin_inff(); }
            float pmax = p[0];
#pragma unroll
            for (int r = 1; r < 16; ++r) pmax = fmaxf(pmax, p[r]);
            pmax = fmaxf(pmax, __shfl_xor(pmax, 32));
            const float mn = fmaxf(m_reg, pmax), alpha = __builtin_amdgcn_exp2f((m_reg - mn) * C2); m_reg = mn;
            float ps = 0.f;
#pragma unroll
            for (int r = 0; r < 16; ++r) { p[r] = __builtin_amdgcn_exp2f((p[r] - mn) * C2); ps += p[r]; }
            ps += __shfl_xor(ps, 32);
            l_reg = l_reg * alpha + ps;
            if (hi == 0) al[r32] = alpha; asm volatile("s_waitcnt lgkmcnt(0)" ::: "memory");
#pragma unroll
            for (int d = 0; d < 4; ++d)
#pragma unroll
                for (int r = 0; r < 16; ++r) o[d][r] *= al[fa::crow(r, hi)];
            bf16x8 pa0, pa1;
#define PK4(P, B_, OUT) do { unsigned a0 = mx::cvtpk(P[B_+0], P[B_+1]), a1 = mx::cvtpk(P[B_+2], P[B_+3]); unsigned b0 = mx::cvtpk(P[B_+4], P[B_+5]), b1 = mx::cvtpk(P[B_+6], P[B_+7]); \
        auto r0 = __builtin_amdgcn_permlane32_swap(a0, b0, false, false); auto r1 = __builtin_amdgcn_permlane32_swap(a1, b1, false, false); \
        fa::u32x4 w = {r0[0], r1[0], r0[1], r1[1]}; OUT = *reinterpret_cast<bf16x8*>(&w); } while (0)
            PK4(p, 0, pa0); PK4(p, 8, pa1);
#undef PK4
#pragma unroll
            for (int d0 = 0; d0 < 4; ++d0) o[d0] = __builtin_amdgcn_mfma_f32_32x32x16_bf16(pa0, pack8f((f32x4){v0[d0 * 8], v0[d0 * 8 + 1], v0[d0 * 8 + 2], v0[d0 * 8 + 3]}, (f32x4){v0[d0 * 8 + 4], v0[d0 * 8 + 5], v0[d0 * 8 + 6], v0[d0 * 8 + 7]}), o[d0], 0, 0, 0);
#pragma unroll
            for (int d0 = 0; d0 < 4; ++d0) o[d0] = __builtin_amdgcn_mfma_f32_32x32x16_bf16(pa1, pack8f((f32x4){v1[d0 * 8], v1[d0 * 8 + 1], v1[d0 * 8 + 2], v1[d0 * 8 + 3]}, (f32x4){v1[d0 * 8 + 4], v1[d0 * 8 + 5], v1[d0 * 8 + 6], v1[d0 * 8 + 7]}), o[d0], 0, 0, 0);
        }
        if (hi == 0) { ml[wid * 32 + r32] = m_reg; ml[256 + wid * 32 + r32] = l_reg; }
#pragma unroll
        for (int d0 = 0; d0 < 4; ++d0)
#pragma unroll
            for (int r = 0; r < 16; ++r) Ol[(wid * 32 + fa::crow(r, hi)) * 128 + d0 * 32 + r32] = o[d0][r];
        __syncthreads();
        { const int row = tid >> 4, c0 = (tid & 15) * 8; float M = -1e30f;
#pragma unroll
          for (int w = 0; w < 8; ++w) M = fmaxf(M, ml[w * 32 + row]);
          float L = 0.f, acc[8];
#pragma unroll
          for (int i = 0; i < 8; ++i) acc[i] = 0.f;
#pragma unroll
          for (int w = 0; w < 8; ++w) { const float f = __builtin_amdgcn_exp2f((ml[w * 32 + row] - M) * C2); L += f * ml[256 + w * 32 + row];
              const f32x4 x0 = *(const LAS f32x4*)(Ol + (w * 32 + row) * 128 + c0), x1 = *(const LAS f32x4*)(Ol + (w * 32 + row) * 128 + c0 + 4);
              acc[0] += f * x0[0]; acc[1] += f * x0[1]; acc[2] += f * x0[2]; acc[3] += f * x0[3]; acc[4] += f * x1[0]; acc[5] += f * x1[1]; acc[6] += f * x1[2]; acc[7] += f * x1[3]; }
          float* pp = SP + (size_t)u2 * SPART_FLOATS;
          *(f32x4*)(pp + row * 128 + c0) = (f32x4){acc[0], acc[1], acc[2], acc[3]}; *(f32x4*)(pp + row * 128 + c0 + 4) = (f32x4){acc[4], acc[5], acc[6], acc[7]};
          if ((tid & 15) == 0) { pp[32 * 128 + row] = M; pp[32 * 128 + 32 + row] = L; } }
    }
}
__device__ __forceinline__ void phase_fox_sample_merge(const Ctx& c, int l, int bid, int nb) {
    OPQ_PTRS; (void)out_;
    const int tid = otid(), lane = tid & 63, gw = bid * 8 + (tid >> 6), ngw = nb * 8;
    const float* SP = (const float*)(ws_ + WS_SPART); bf16* MRG = (bf16*)(ws_ + WS_MRG); const float* gout = kc_->in[I_GFO] + l * 128;
    constexpr float C2 = 1.4426950408889634f * fa::SCALE;
    const float g0 = gout[2 * lane], g1 = gout[2 * lane + 1];
    for (int R = gw; R < NSB * 8 * 32; R += ngw) {
        const int u = R >> 5, row = R & 31, b = u >> 3, h = u & 7, tok = TP + b * TS + row;
        const float* pa = SP + (size_t)(2 * u) * SPART_FLOATS; const float* pb = pa + SPART_FLOATS;
        const float ma = pa[4096 + row], la = pa[4096 + 32 + row], mb = pb[4096 + row], lb = pb[4096 + 32 + row];
        const float M = fmaxf(ma, mb), fa_ = __builtin_amdgcn_exp2f((ma - M) * C2), fb_ = __builtin_amdgcn_exp2f((mb - M) * C2), il = 1.f / (fa_ * la + fb_ * lb);
        const float a0 = pa[row * 128 + 2 * lane], a1 = pa[row * 128 + 2 * lane + 1], b0 = pb[row * 128 + 2 * lane], b1 = pb[row * 128 + 2 * lane + 1];
        const float y0 = (fa_ * a0 + fb_ * b0) * il, y1 = (fa_ * a1 + fb_ * b1) * il;
        const float rn = rsqrtf(wave_sum(y0 * y0 + y1 * y1) * (1.f / 128.f) + EPS);
        *(unsigned*)(MRG + (size_t)tok * DM + 1024 + h * 128 + 2 * lane) = pk2(y0 * rn * g0, y1 * rn * g1);
    }
}
#define XB_TMO      128
#define XB_XCNT(j)  (256  + 64 * (j))
#define XB_XSUB(j)  (1280 + 64 * (j))
#define XB_XGEN(j)  (2304 + 64 * (j))
#define XB_TOP      3328
#define XB_TOPGEN   3392
#define XCD_BAR_WORDS 3456
#define XB_SPIN_CAP (1u << 18)

__device__ __forceinline__ unsigned xb_ld(unsigned* p)              { return __hip_atomic_load(p, __ATOMIC_RELAXED, __HIP_MEMORY_SCOPE_AGENT); }
__device__ __forceinline__ unsigned xb_add(unsigned* p, unsigned v) { return __hip_atomic_fetch_add(p, v, __ATOMIC_RELAXED, __HIP_MEMORY_SCOPE_AGENT); }
__device__ __forceinline__ unsigned xb_xcc_id() { return (unsigned)__builtin_amdgcn_s_getreg((3 << 11) | 20) & 0xFu; }
#define XB_SPIN(cond, bar) do { unsigned _sp = 0; while (cond) { __builtin_amdgcn_s_sleep(1); \
    if ((++_sp & 255u) == 0u) { if (xb_ld(&(bar)[XB_TMO])) break; if (_sp > XB_SPIN_CAP) { atomicAdd(&(bar)[XB_TMO], 1u); break; } } } } while (0)

struct XcdBarrier {
    unsigned* bar; unsigned x;
    volatile LAS unsigned* st;
};

__device__ __forceinline__ XcdBarrier xcd_barrier_post(unsigned* bar, volatile LAS unsigned* st) {
    XcdBarrier b; b.bar = bar; b.x = xb_xcc_id(); b.st = st;
    if (threadIdx.x == 0) (void)xb_add(&bar[XB_XCNT(b.x)], 1u);
    return b;
}
__device__ __forceinline__ void xcd_barrier_complete(unsigned* bar, unsigned x, unsigned& nloc, unsigned& nx) {
    const unsigned G = gridDim.x * gridDim.y * gridDim.z;
    unsigned sum, cnt, mine, sp = 0u;
    for (;;) {
        sum = 0u; cnt = 0u; mine = 0u;
#pragma unroll
        for (unsigned j = 0; j < 16; ++j) { const unsigned c = xb_ld(&bar[XB_XCNT(j)]); sum += c; cnt += (c > 0u) ? 1u : 0u; mine = (j == x) ? c : mine; }
        if (sum == G) break;
        __builtin_amdgcn_s_sleep(1);
        if ((++sp & 255u) == 0u) { if (xb_ld(&bar[XB_TMO])) break; if (sp > XB_SPIN_CAP) { atomicAdd(&bar[XB_TMO], 1u); break; } }
    }
    nloc = mine > 0u ? mine : 1u; nx = cnt > 0u ? cnt : 1u;
}

__device__ __forceinline__ void xcd_barrier(const XcdBarrier& b) {
    asm volatile("s_waitcnt vmcnt(0)" ::: "memory");
    __syncthreads();
    if (threadIdx.x == 0) {
        unsigned* bar = b.bar;
        __builtin_amdgcn_s_waitcnt(0);
        unsigned nloc = b.st[0], nx = b.st[1];
        if (nloc == 0u) { xcd_barrier_complete(bar, b.x, nloc, nx); b.st[0] = nloc; b.st[1] = nx; }
        const unsigned old = xb_add(&bar[XB_XSUB(b.x)], 1u);
        const unsigned gen = old / nloc;
        if (old + 1u == (gen + 1u) * nloc) {
            __builtin_amdgcn_fence(__ATOMIC_RELEASE, "agent");
            asm volatile("s_waitcnt vmcnt(0)" ::: "memory");
            const unsigned og = xb_add(&bar[XB_TOP], 1u);
            const unsigned tg = og / nx;
            if (og + 1u == (tg + 1u) * nx) xb_add(&bar[XB_TOPGEN], 1u);
            else XB_SPIN(xb_ld(&bar[XB_TOPGEN]) == tg, bar);
            __builtin_amdgcn_fence(__ATOMIC_ACQUIRE, "agent");
            xb_add(&bar[XB_XGEN(b.x)], 1u);
            asm volatile("s_waitcnt vmcnt(0)" ::: "memory");
        } else {
            XB_SPIN(xb_ld(&bar[XB_XGEN(b.x)]) == gen, bar);
            __builtin_amdgcn_fence(__ATOMIC_ACQUIRE, "agent");
            asm volatile("s_waitcnt vmcnt(0)" ::: "memory");
        }
    }
    __syncthreads();
}

constexpr int LDS_BYTES = 147456;
constexpr int MISC_OFF = LDS_BYTES - 256;
constexpr int CW_BAR = 4096;
constexpr size_t CTL_ZERO_BYTES = 1u << 20;

template <int l>
__device__ __forceinline__ void layer_body(const Ctx& c, LAS unsigned char* lds, const XcdBarrier& bar, int bid, int nb) {
    OPQ_PTRS; bf16* XN = (bf16*)(ws_ + WS_XN);
        { pg8::Gemm g{XN, (const bf16*)(ws_ + WS_WIN + l * SZ_WIN), MT, DINP, DM, DM}; pg8::StaticOrder S; S.init(MT, DINP, nb, bid); S.mix27 = true;
          pg8::EpiIn E{(bf16*)(ws_ + WS_PROJ), PBP, (float*)(ws_ + WS_SIDE), (bf16*)(ws_ + WS_QB), (bf16*)(ws_ + WS_KB), (bf16*)(ws_ + WS_VB),
                       out_ + O_FKP + (size_t)l * TP * 1024, out_ + O_FKS + (size_t)l * MS * 1024, out_ + O_FVP + (size_t)l * TP * 1024, out_ + O_FVS + (size_t)l * MS * 1024,
                       kc_->in[I_GFQ] + l * 128, kc_->in[I_GFK] + l * 128, (PG8_LAS float*)(lds + 131072), TP, EPS,
                       pg8::RowScale{(const float*)(ws_ + WS_SSP) + (size_t)(2 * l) * MT * 8, 1.f / DM, EPS, (PG8_LAS float*)(lds + 143360)}};
          pg8::gemm_phase<pg8::EpiIn, pg8::StaticOrder, true, true, false, true>(lds, g, S, E); }
        constexpr int NU_IN = (MT / 256) * (DINP / 256), NU_GU = (MT / 256) * (2 * DFF / 256);
        constexpr int I_P1 = (DM / 64) * (DM / 32) + (DM / 64) * (2 * DFF / 32) + (DFF / 64) * (DM / 32);
        const int f_idle = NU_IN % nb, n_idle = f_idle ? nb - f_idle : 0, x_head = n_idle * 56 < I_P1 ? n_idle * 56 : I_P1;
        const int x1 = nb == 256 ? x_head + 64 * 8 * 5 : x_head;
        const int f_gu = NU_GU % nb, n_gu = f_gu ? nb - f_gu : 0, y_head = (l + 1 < NL && n_gu * 40 < 32 * 208) ? n_gu * 40 : 0;
        if (n_idle && bid >= f_idle) { __syncthreads(); phase_convert(c, l, lds, bid - f_idle, n_idle, 1, 0, x_head); __syncthreads(); }
        xcd_barrier(bar);
        phase_fox_cumsum2(c, l, lds, bid, nb); phase_mix_u(c, l, bid, nb);
        if (x1 > x_head && bid >= 192) { __syncthreads(); phase_convert(c, l, lds, bid - 192, 64, 1, x_head, x1); __syncthreads(); }
        xcd_barrier(bar);
        phase_scans(c, l, bid, nb);
        if (bid & 1) { __syncthreads(); phase_convert(c, l, lds, bid, nb, 1, x1); if (l + 1 < NL) phase_convert(c, l + 1, lds, bid, nb, 0, y_head); __syncthreads(); phase_fox_sample_half(c, l, lds, bid, nb); }
        phase_fox_prompt_split(c, l, lds, bid, nb);
        if (!(bid & 1)) { phase_fox_sample_half(c, l, lds, bid, nb); __syncthreads(); phase_convert(c, l, lds, bid, nb, 1, x1); if (l + 1 < NL) phase_convert(c, l + 1, lds, bid, nb, 0, y_head); __syncthreads(); }
        xcd_barrier(bar);
        phase_fox_sample_merge(c, l, bid, nb); phase_fox_merge(c, l, bid, nb); phase_mix_o(c, l, lds, bid, nb);
        xcd_barrier(bar);
        { pg8::Gemm g{(const bf16*)(ws_ + WS_MRG), (const bf16*)(ws_ + WS_WOUT + l * SZ_WOUT), TP, DM, DM, DM, (const bf16*)(ws_ + WS_MRG) + (size_t)TP * DM}; pg8::StaticOrder S; S.init(TP, DM, nb, bid);
          typedef pg8::EpiResT<(l > 0), false> ER;
          ER E{kc_->in[I_XP], kc_->in[I_XS], TP, nullptr, DM, XN, (float*)(ws_ + WS_SSP) + (size_t)(2 * l + 1) * MT * 8, (PG8_LAS float*)(lds + 131072), XN}; pg8::gemm_phase<ER, pg8::StaticOrder, true, true, true>(lds, g, S, E); }
        xcd_barrier(bar);
        { pg8::Gemm g{XN, (const bf16*)(ws_ + WS_WGU + l * SZ_WGU), MT, 2 * DFF, DM, DM}; pg8::StaticOrder S; S.init(MT, 2 * DFF, nb, bid);
          pg8::EpiSwiGLU E{(bf16*)(ws_ + WS_ACT), DFF, pg8::RowScale{(const float*)(ws_ + WS_SSP) + (size_t)(2 * l + 1) * MT * 8, 1.f / DM, EPS, (PG8_LAS float*)(lds + 143360)}}; pg8::gemm_phase<pg8::EpiSwiGLU, pg8::StaticOrder, true, true, false, true>(lds, g, S, E); }
        if (y_head && bid >= f_gu) { __syncthreads(); phase_convert(c, l + 1 < NL ? l + 1 : l, lds, bid - f_gu, n_gu, 0, 0, y_head); __syncthreads(); }
        xcd_barrier(bar);
        { float* dst = l == NL - 1 ? out_ + O_YP : nullptr;
          pg8::Gemm g{(const bf16*)(ws_ + WS_ACT), (const bf16*)(ws_ + WS_WDN + l * SZ_WDN), TP, DM, DFF, DFF, (const bf16*)(ws_ + WS_ACT) + (size_t)TP * DFF}; pg8::StaticOrder S; S.init(TP, DM, nb, bid);
          typedef pg8::EpiResT<true, (l == NL - 1)> ER;
          ER E{nullptr, nullptr, TP, dst, DM, l == NL - 1 ? nullptr : XN, (float*)(ws_ + WS_SSP) + (size_t)(2 * l + 2) * MT * 8, (PG8_LAS float*)(lds + 131072), XN}; pg8::gemm_phase<ER, pg8::StaticOrder, true, true, true>(lds, g, S, E); }
        if (l + 1 < NL) xcd_barrier(bar);
}

__global__ void __launch_bounds__(512, 2) fwd_mega(const Ctx c) {
    extern __shared__ __attribute__((aligned(16))) unsigned char shm[];
    LAS unsigned char* lds = (LAS unsigned char*)shm;
    const int bid = blockIdx.x, nb = gridDim.x;
    for (int u = threadIdx.x; u < (LDS_BYTES - MISC_OFF) / 4; u += 512) ((LAS unsigned*)(lds + MISC_OFF))[u] = 0u;
    __syncthreads();
    XcdBarrier bar = xcd_barrier_post((unsigned*)(kctx()->ws + WS_CTL) + CW_BAR, (volatile LAS unsigned*)(lds + MISC_OFF) + 8);
    phase_convert(c, 0, lds, bid, nb, 0);
    { OPQ_PTRS; (void)out_; phase_rope_tables((float*)(ws_ + WS_TABC), (float*)(ws_ + WS_TABS), bid, nb); }
    { OPQ_PTRS; phase_x_to_bf16(kc_->in[I_XP], kc_->in[I_XS], (bf16*)(ws_ + WS_XN), (float*)(ws_ + WS_SSP), bid, nb); (void)out_; }
    xcd_barrier(bar);
    layer_body<0>(c, lds, bar, bid, nb); layer_body<1>(c, lds, bar, bid, nb); layer_body<2>(c, lds, bar, bid, nb); layer_body<3>(c, lds, bar, bid, nb);
}

extern "C" void kernel_launch(void* const* d_in, const int* in_sizes, int n_in, void* d_out, int out_size, void* d_ws, size_t ws_size, hipStream_t stream) {
    if (n_in != N_IN || (size_t)out_size != O_END || ws_size < WS_END) { fprintf(stderr, "kernel_launch: unexpected shapes (n_in %d out %d ws %zu, need %zu)\n", n_in, out_size, ws_size, (size_t)WS_END); return; }
    Ctx c{}; for (int i = 0; i < N_IN; ++i) c.in[i] = (const float*)d_in[i]; c.out = (float*)d_out; c.ws = (unsigned char*)d_ws;
    int dev = 0, cus = 0, per_cu = 0;
    if (hipGetDevice(&dev) != hipSuccess || hipDeviceGetAttribute(&cus, hipDeviceAttributeMultiprocessorCount, dev) != hipSuccess || cus <= 0) { fprintf(stderr, "kernel_launch: device query failed\n"); return; }
    if (hipFuncSetAttribute((const void*)fwd_mega, hipFuncAttributeMaxDynamicSharedMemorySize, LDS_BYTES) != hipSuccess) { fprintf(stderr, "kernel_launch: hipFuncSetAttribute failed\n"); return; }
    if (hipOccupancyMaxActiveBlocksPerMultiprocessor(&per_cu, (const void*)fwd_mega, 512, LDS_BYTES) != hipSuccess || per_cu < 1) { fprintf(stderr, "kernel_launch: occupancy query says %d blocks per CU\n", per_cu); (void)hipGetLastError(); per_cu = 1; }
    const int grid = cus;
    (void)hipMemsetAsync((char*)d_ws + WS_CTL, 0, CTL_ZERO_BYTES, stream);
    hipLaunchKernelGGL(fwd_mega, dim3(grid), dim3(512), LDS_BYTES, stream, c);
}
```

```cpp
#include <hip/hip_runtime.h>
#include <cstdio>
#include <cstdint>
namespace pg8 {
#define PG8_LAS __attribute__((address_space(3)))
typedef unsigned short bf16_t;
typedef short bf16x8 __attribute__((ext_vector_type(8)));
typedef float f32x4 __attribute__((ext_vector_type(4)));
typedef unsigned u32x4 __attribute__((ext_vector_type(4)));
constexpr int BM = 256, BK = 64, HALF = 128, HTB = HALF * BK * 2  , STAGE_BYTES = 8 * HTB, NXCD = 8, WGM = 4;

__host__ __device__ __forceinline__ int lds_byte(int r, int c) { const int st = (r >> 4) * 2 + (c >> 5), rr = r & 15, cc = c & 31, ob = rr * 64 + cc * 2; return st * 1024 + (ob ^ (((ob >> 9) & 1) << 5)); }
__host__ __device__ __forceinline__ void stage_rc(int b, int& R, int& C) { const int st = b / 1024, sb = b % 1024, swz = sb ^ (((sb >> 9) & 1) << 5); R = (st >> 1) * 16 + swz / 64; C = (st & 1) * 32 + (swz % 64) / 2; }
__host__ __device__ __forceinline__ int perm32(int rho) { const int n = rho >> 4, i = rho & 15; return 8 * (i >> 2) + 4 * n + (i & 3); }

struct Unit { int pm, pn, ko; };
struct Gemm { const bf16_t* A; const bf16_t* Bt; int M, N, K, KL; const bf16_t* As = nullptr; };

struct StaticOrder {
    int nM, nN, nwg, G, c; bool mix27 = false;
    __host__ __device__ void init(int M, int N, int G_, int c_) { nM = M / BM; nN = N / BM; nwg = nM * nN; G = G_; c = c_; }
    __host__ __device__ bool next(int i, Unit& u) const {
        const long L = (long)i * G + c; if (L >= nwg) return false;
        int wgid = (int)L; { const int q = nwg / NXCD, r = nwg % NXCD, xcd = wgid % NXCD, off = wgid / NXCD; wgid = (xcd < r ? xcd * (q + 1) : r * (q + 1) + (xcd - r) * q) + off; }
        const int nig = WGM * nN, gid = wgid / nig, fm = gid * WGM, gsz = (nM - fm) < WGM ? (nM - fm) : WGM;
        u.pm = fm + ((wgid % nig) % gsz); u.pn = (wgid % nig) / gsz; u.ko = 0;
        if (mix27) { const unsigned long long lo = 0x110310020f010e00ull, mi = 0x0814071306120504ull, hi = 0x180c170b160a0915ull, tp = 0x1a190dull;
            const int q = u.pn >> 3, s = (u.pn & 7) * 8; u.pn = (int)(((q == 0 ? lo : q == 1 ? mi : q == 2 ? hi : tp) >> s) & 0xff); }
        return true;
    }
    __device__ __forceinline__ void a_ready(const Unit&) const {}
    __device__ __forceinline__ void done(const Unit&) const {}
};

__device__ __forceinline__ unsigned cvt_pk_bf16(float lo, float hi) { unsigned r; asm volatile("v_cvt_pk_bf16_f32 %0, %1, %2" : "=v"(r) : "v"(lo), "v"(hi)); return r; }
typedef float f32x2 __attribute__((ext_vector_type(2)));
template <bool RB, bool OF>
struct EpiResT {
    static constexpr bool PERM = false, AFTER_DRAIN = false;
    typedef unsigned u32x2 __attribute__((ext_vector_type(2)));
    const float* base0; const float* base1; int split; float* out; int ldc; bf16_t* hb; float* ssp; PG8_LAS float* X; const bf16_t* rb;
    static __device__ __forceinline__ f32x4 unpack(const u32x2 w) { f32x4 r; r[0] = __uint_as_float(w.x << 16); r[1] = __uint_as_float(w.x & 0xffff0000u); r[2] = __uint_as_float(w.y << 16); r[3] = __uint_as_float(w.y & 0xffff0000u); return r; }
    __device__ __forceinline__ void operator()(const f32x4 (&acc)[2][2][4][2], const Unit& u, int wr, int wc, int fr_in, int fq_in) const {
        int fr = fr_in, fq = fq_in; asm volatile("" : "+v"(fr), "+v"(fq));
        const int row0 = u.pm * BM + wr * 64 + fr, col0 = u.pn * BM + wc * 32 + 4 * fq;
#pragma unroll
        for (int ai = 0; ai < 2; ++ai) {
            f32x4 bs[4][2][2]; u32x2 bw[4][2][2];
#pragma unroll
            for (int m = 0; m < 4; ++m) { const int row = row0 + ai * HALF + m * 16;
                if constexpr (RB) { const bf16_t* bp = rb + (size_t)row * ldc + col0;
#pragma unroll
                    for (int bj = 0; bj < 2; ++bj)
#pragma unroll
                        for (int n = 0; n < 2; ++n) bw[m][bj][n] = *(const u32x2*)(bp + bj * HALF + n * 16);
                } else { const float* bp = (row < split ? base0 + (size_t)row * ldc : base1 + (size_t)(row - split) * ldc) + col0;
#pragma unroll
                    for (int bj = 0; bj < 2; ++bj)
#pragma unroll
                        for (int n = 0; n < 2; ++n) bs[m][bj][n] = *(const f32x4*)(bp + bj * HALF + n * 16); } }
            asm volatile("" ::: "memory");
#pragma unroll
            for (int m = 0; m < 4; ++m) { const int row = row0 + ai * HALF + m * 16; float s = 0.f;
#pragma unroll
                for (int bj = 0; bj < 2; ++bj)
#pragma unroll
                    for (int n = 0; n < 2; ++n) { f32x4 r; if constexpr (RB) r = unpack(bw[m][bj][n]); else r = bs[m][bj][n];
                        const f32x4 v = acc[ai][bj][m][n] + r;
                        if constexpr (OF) *(f32x4*)(out + (size_t)row * ldc + col0 + bj * HALF + n * 16) = v;
                        if (hb) { u32x2 w; w.x = cvt_pk_bf16(v[0], v[1]); w.y = cvt_pk_bf16(v[2], v[3]);
                            *(u32x2*)(hb + (size_t)row * ldc + col0 + bj * HALF + n * 16) = w; s += (v[0] * v[0] + v[1] * v[1]) + (v[2] * v[2] + v[3] * v[3]); } }
                if (hb) { s += __shfl_xor(s, 16); s += __shfl_xor(s, 32); if (fq == 0) X[(ai * HALF + wr * 64 + m * 16 + fr) * 4 + wc] = s; } }
            asm volatile("" ::: "memory");
        }
    }
    __device__ __forceinline__ void strip(const f32x4 (&accS)[2], const Unit& u, int wr, int wc, int fr_in, int fq_in) const {
        int fr = fr_in, fq = fq_in; asm volatile("" : "+v"(fr), "+v"(fq));
        const int rs = u.pm * 16 + fr, col0 = u.pn * BM + wr * HALF + wc * 32 + 4 * fq; float s = 0.f;
        f32x4 r[2];
        if constexpr (RB) { u32x2 bw[2];
#pragma unroll
            for (int n = 0; n < 2; ++n) bw[n] = *(const u32x2*)(rb + (size_t)(split + rs) * ldc + col0 + n * 16);
            asm volatile("" ::: "memory");
            r[0] = unpack(bw[0]); r[1] = unpack(bw[1]);
        } else {
#pragma unroll
            for (int n = 0; n < 2; ++n) r[n] = *(const f32x4*)(base1 + (size_t)rs * ldc + col0 + n * 16);
            asm volatile("" ::: "memory"); }
#pragma unroll
        for (int n = 0; n < 2; ++n) { const f32x4 v = accS[n] + r[n];
            if constexpr (OF) *(f32x4*)(out + (size_t)(split + rs) * ldc + col0 + n * 16) = v;
            if (hb) { u32x2 w; w.x = cvt_pk_bf16(v[0], v[1]); w.y = cvt_pk_bf16(v[2], v[3]);
                *(u32x2*)(hb + (size_t)(split + rs) * ldc + col0 + n * 16) = w; s += (v[0] * v[0] + v[1] * v[1]) + (v[2] * v[2] + v[3] * v[3]); } }
        if (hb) {
            s += __shfl_xor(s, 16); s += __shfl_xor(s, 32); if (fq == 0) X[1024 + fr * 8 + wr * 4 + wc] = s;
            asm volatile("s_waitcnt lgkmcnt(0)" ::: "memory"); __builtin_amdgcn_s_barrier(); asm volatile("" ::: "memory");
            const int t = (wr * 4 + wc) * 64 + fq * 16 + fr;
            if (t < 256) { const f32x4 a = *(const PG8_LAS f32x4*)(X + t * 4); ssp[(size_t)(u.pm * BM + t) * 8 + u.pn] = (a[0] + a[1]) + (a[2] + a[3]); }
            else if (t < 272) { const int r2 = t - 256; const f32x4 a = *(const PG8_LAS f32x4*)(X + 1024 + r2 * 8), b = *(const PG8_LAS f32x4*)(X + 1024 + r2 * 8 + 4);
                ssp[(size_t)(split + u.pm * 16 + r2) * 8 + u.pn] = ((a[0] + a[1]) + (a[2] + a[3])) + ((b[0] + b[1]) + (b[2] + b[3])); }
        }
    }
};
__device__ __forceinline__ float silu_mul(float g, float u) { return g * u * __builtin_amdgcn_rcpf(1.0f + __builtin_amdgcn_exp2f(-1.4426950408889634f * g)); }

struct RowScale {
    const float* ssp; float inv_n, eps; PG8_LAS float* RT;
    __device__ __forceinline__ void load(const Unit& u, int tid, f32x4& a, f32x4& b) const { if (tid < 256) { const float* sp = ssp + (size_t)(u.pm * BM + tid) * 8; a = *(const f32x4*)sp; b = *(const f32x4*)(sp + 4); } }
    __device__ __forceinline__ void publish(int tid, const f32x4& a, const f32x4& b) const {
        if (tid < 256) RT[tid] = rsqrtf((((a[0] + a[1]) + (a[2] + a[3])) + ((b[0] + b[1]) + (b[2] + b[3]))) * inv_n + eps);
        asm volatile("s_waitcnt lgkmcnt(0)" ::: "memory"); __builtin_amdgcn_s_barrier(); asm volatile("" ::: "memory"); }
};
struct EpiSwiGLU {
    static constexpr bool PERM = true, AFTER_DRAIN = false;
    bf16_t* O; int ldc; RowScale rs;
    __device__ __forceinline__ void operator()(const f32x4 (&acc)[2][2][4][2], const Unit& u, int wr, int wc, int fr_in, int fq_in) const {
        int fr = fr_in, fq = fq_in; asm volatile("" : "+v"(fr), "+v"(fq));
        const int row0 = u.pm * BM + wr * 64 + fr, col0 = u.pn * HALF + wc * 32 + 8 * fq;
#pragma unroll
        for (int ai = 0; ai < 2; ++ai)
#pragma unroll
            for (int m = 0; m < 4; ++m) { const int row = row0 + ai * HALF + m * 16; const float r = rs.RT[ai * HALF + wr * 64 + m * 16 + fr]; bf16_t* rowp = O + (size_t)row * ldc + col0;
                const f32x4 g0 = acc[ai][0][m][0] * r, g1 = acc[ai][0][m][1] * r, u0 = acc[ai][1][m][0] * r, u1 = acc[ai][1][m][1] * r;
                u32x4 w; w.x = cvt_pk_bf16(silu_mul(g0[0], u0[0]), silu_mul(g0[1], u0[1])); w.y = cvt_pk_bf16(silu_mul(g0[2], u0[2]), silu_mul(g0[3], u0[3]));
                w.z = cvt_pk_bf16(silu_mul(g1[0], u1[0]), silu_mul(g1[1], u1[1])); w.w = cvt_pk_bf16(silu_mul(g1[2], u1[2]), silu_mul(g1[3], u1[3]));
                *(u32x4*)rowp = w; }
    }
};


struct EpiIn {
    static constexpr bool PERM = true, AFTER_DRAIN = false;
    bf16_t* P; int ldp; float* side; bf16_t* QB; bf16_t* KB; bf16_t* VB; float* fk_p; float* fk_s; float* fv_p; float* fv_s; const float* gq; const float* gk; PG8_LAS float* X; int split; float eps; RowScale rs;
    __device__ __forceinline__ void operator()(const f32x4 (&acc_in)[2][2][4][2], const Unit& u, int wr, int wc, int fr_in, int fq_in) const {
        int fr = fr_in, fq = fq_in; asm volatile("" : "+v"(fr), "+v"(fq));
        f32x4 (&acc)[2][2][4][2] = const_cast<f32x4 (&)[2][2][4][2]>(acc_in);
#pragma unroll
        for (int ai = 0; ai < 2; ++ai)
#pragma unroll
            for (int m = 0; m < 4; ++m) { const float r = rs.RT[ai * HALF + wr * 64 + m * 16 + fr];
#pragma unroll
                for (int bj = 0; bj < 2; ++bj)
#pragma unroll
                    for (int n = 0; n < 2; ++n) acc[ai][bj][m][n] *= r; }
        const int row0 = u.pm * BM + wr * 64 + fr, pn = u.pn;
        if (pn < 14) { const int col0 = pn * BM + wc * 32 + 8 * fq;
#pragma unroll
            for (int ai = 0; ai < 2; ++ai)
#pragma unroll
                for (int m = 0; m < 4; ++m) { bf16_t* rowp = P + (size_t)(row0 + ai * HALF + m * 16) * ldp + col0;
#pragma unroll
                    for (int bj = 0; bj < 2; ++bj) { const f32x4 v0 = acc[ai][bj][m][0], v1 = acc[ai][bj][m][1];
                        u32x4 w; w.x = cvt_pk_bf16(v0[0], v0[1]); w.y = cvt_pk_bf16(v0[2], v0[3]); w.z = cvt_pk_bf16(v1[0], v1[1]); w.w = cvt_pk_bf16(v1[2], v1[3]);
                        *(u32x4*)(rowp + bj * HALF) = w; } }
        } else if (pn < 22) { const bool isk = pn >= 18; const int hd0 = (pn - (isk ? 18 : 14)) * 2;
#pragma unroll
            for (int ai = 0; ai < 2; ++ai)
#pragma unroll
                for (int m = 0; m < 4; ++m)
#pragma unroll
                    for (int bj = 0; bj < 2; ++bj) { const f32x4 v0 = acc[ai][bj][m][0], v1 = acc[ai][bj][m][1];
                        float s = (v0[0] * v0[0] + v0[1] * v0[1]) + (v0[2] * v0[2] + v0[3] * v0[3]) + (v1[0] * v1[0] + v1[1] * v1[1]) + (v1[2] * v1[2] + v1[3] * v1[3]);
                        s += __shfl_xor(s, 16); s += __shfl_xor(s, 32);
                        if (fq == 0) X[(ai * HALF + wr * 64 + m * 16 + fr) * 8 + bj * 4 + wc] = s; }
            asm volatile("s_waitcnt lgkmcnt(0)" ::: "memory"); __builtin_amdgcn_s_barrier(); asm volatile("" ::: "memory");
            const float* gain = isk ? gk : gq; const f32x4 g0 = *(const f32x4*)(gain + wc * 32 + 8 * fq), g1 = *(const f32x4*)(gain + wc * 32 + 8 * fq + 4);
            bf16_t* Ob = isk ? KB : QB;
#pragma unroll
            for (int ai = 0; ai < 2; ++ai)
#pragma unroll
                for (int m = 0; m < 4; ++m) { const int rl = ai * HALF + wr * 64 + m * 16 + fr, row = u.pm * BM + rl;
#pragma unroll
                    for (int bj = 0; bj < 2; ++bj) { const f32x4 t = *(const PG8_LAS f32x4*)(X + rl * 8 + bj * 4); const float r = rsqrtf(((t[0] + t[1]) + (t[2] + t[3])) * (1.f / 128.f) + eps);
                        const f32x4 y0 = acc[ai][bj][m][0] * r * g0, y1 = acc[ai][bj][m][1] * r * g1; const int col = (hd0 + bj) * 128 + wc * 32 + 8 * fq;
                        u32x4 w; w.x = cvt_pk_bf16(y0[0], y0[1]); w.y = cvt_pk_bf16(y0[2], y0[3]); w.z = cvt_pk_bf16(y1[0], y1[1]); w.w = cvt_pk_bf16(y1[2], y1[3]);
                        *(u32x4*)(Ob + (size_t)row * 1024 + col) = w;
                        if (isk) { float* d = (row < split ? fk_p + (size_t)row * 1024 : fk_s + (size_t)(row - split) * 1024) + col; *(f32x4*)d = y0; *(f32x4*)(d + 4) = y1; } } }
        } else if (pn < 26) { const int hd0 = (pn - 22) * 2;
#pragma unroll
            for (int ai = 0; ai < 2; ++ai)
#pragma unroll
                for (int m = 0; m < 4; ++m) { const int row = row0 + ai * HALF + m * 16;
#pragma unroll
                    for (int bj = 0; bj < 2; ++bj) { const f32x4 v0 = acc[ai][bj][m][0], v1 = acc[ai][bj][m][1]; const int col = (hd0 + bj) * 128 + wc * 32 + 8 * fq;
                        u32x4 w; w.x = cvt_pk_bf16(v0[0], v0[1]); w.y = cvt_pk_bf16(v0[2], v0[3]); w.z = cvt_pk_bf16(v1[0], v1[1]); w.w = cvt_pk_bf16(v1[2], v1[3]);
                        *(u32x4*)(VB + (size_t)row * 1024 + col) = w;
                        float* d = (row < split ? fv_p + (size_t)row * 1024 : fv_s + (size_t)(row - split) * 1024) + col; *(f32x4*)d = v0; *(f32x4*)(d + 4) = v1; } }
        } else if (wc == 0) {
#pragma unroll
            for (int ai = 0; ai < 2; ++ai)
#pragma unroll
                for (int m = 0; m < 4; ++m) { float* sp = side + (size_t)(row0 + ai * HALF + m * 16) * 32 + 8 * fq; *(f32x4*)sp = acc[ai][0][m][0]; *(f32x4*)(sp + 4) = acc[ai][0][m][1]; }
        }
    }
};
template <class Epi, class Sched, bool ALIGN_EPI = false, bool SP2 = false, bool STRIP = false, bool ROWSCALE = false>
__device__ __forceinline__ void gemm_phase(PG8_LAS unsigned char* lds, const Gemm g, const Sched& S, const Epi& E) {
    int tid_ = threadIdx.x; asm volatile("" : "+v"(tid_));
    const int tid = tid_, wid = __builtin_amdgcn_readfirstlane(tid >> 6), lane = tid & 63, wr = wid >> 2, wc = wid & 3, fr = lane & 15, fq = lane >> 4;
    const int K = g.K, nt = g.KL / BK;
    unsigned voffA[2], voffB[2];
#pragma unroll
    for (int i = 0; i < 2; ++i) { int R, C; stage_rc(tid * 16 + i * 8192, R, C); const int Rb = Epi::PERM ? ((R & ~31) + perm32(R & 31)) : R;
        voffA[i] = (unsigned)(R * K + C) * 2u; voffB[i] = (unsigned)(Rb * K + C) * 2u; }
    const size_t kstep = (size_t)(BK * 2);
    const size_t hstep = (size_t)HALF * K * 2;
    const size_t tstep = 2 * hstep;
    const unsigned ldsw = (unsigned)wid * 1024u;
    const int aoff = lds_byte(wr * 64 + fr, fq * 8), boff = lds_byte(wc * 32 + fr, fq * 8);
    static_assert(!STRIP || SP2, "STRIP needs the SP2 loop");
    constexpr int SOFF = STAGE_BYTES + 8192;
    const unsigned voffS = (unsigned)(((2 * wid + (lane >> 5)) * K + (lane & 31) * 2) * 2);
    const int soff = fr * 128 + fq * 16;
#define PG8_SA(b, h) (((b) * 2 + (h)) * HTB)
#define PG8_SB(b, h) ((4 + (b) * 2 + (h)) * HTB)
#define PG8_STAGE(bufoff, gbase, voff) do { _Pragma("unroll") for (int _i = 0; _i < 2; ++_i) \
        __builtin_amdgcn_global_load_lds((const unsigned*)((const char*)(gbase) + (voff)[_i]), (PG8_LAS unsigned*)(lds + (bufoff) + ldsw + _i * 8192), 16, 0, 0); } while (0)
#define PG8_LDA(dst, b, h) do { _Pragma("unroll") for (int m = 0; m < 4; ++m) _Pragma("unroll") for (int k = 0; k < 2; ++k) dst[m][k] = *(const PG8_LAS bf16x8*)(lds + PG8_SA(b, h) + aoff + m * 2048 + k * 1024); } while (0)
#define PG8_LDB(dst, b, h) do { _Pragma("unroll") for (int n = 0; n < 2; ++n) _Pragma("unroll") for (int k = 0; k < 2; ++k) dst[n][k] = *(const PG8_LAS bf16x8*)(lds + PG8_SB(b, h) + boff + n * 2048 + k * 1024); } while (0)
#define PG8_MMA(ai, bj, At, Bt) do { __builtin_amdgcn_s_setprio(1); _Pragma("unroll") for (int m = 0; m < 4; ++m) _Pragma("unroll") for (int n = 0; n < 2; ++n) _Pragma("unroll") for (int k = 0; k < 2; ++k) \
        acc[ai][bj][m][n] = __builtin_amdgcn_mfma_f32_16x16x32_bf16(Bt[n][k], At[m][k], acc[ai][bj][m][n], 0, 0, 0); __builtin_amdgcn_s_setprio(0); } while (0)
#define PG8_WAIT_V(n) asm volatile("s_waitcnt vmcnt(" #n ")" ::: "memory")
#define PG8_SSTAGE(sb, gptr) do { if constexpr (STRIP) __builtin_amdgcn_global_load_lds((const unsigned*)((const char*)(gptr) + voffS), (PG8_LAS unsigned*)(lds + SOFF + (sb) * 2048 + wid * 256), 4, 0, 0); } while (0)
#define PG8_SLD(sb) do { if constexpr (STRIP) { Sf[0] = *(const PG8_LAS bf16x8*)(lds + SOFF + (sb) * 2048 + soff); Sf[1] = *(const PG8_LAS bf16x8*)(lds + SOFF + (sb) * 2048 + soff + 64); } } while (0)
#define PG8_SMMA() do { if constexpr (STRIP) { if (wr == 0) { _Pragma("unroll") for (int n = 0; n < 2; ++n) _Pragma("unroll") for (int k = 0; k < 2; ++k) accS[n] = __builtin_amdgcn_mfma_f32_16x16x32_bf16(B0[n][k], Sf[k], accS[n], 0, 0, 0); } \
        else { _Pragma("unroll") for (int n = 0; n < 2; ++n) _Pragma("unroll") for (int k = 0; k < 2; ++k) accS[n] = __builtin_amdgcn_mfma_f32_16x16x32_bf16(B1[n][k], Sf[k], accS[n], 0, 0, 0); } } } while (0)
#define PG8_WAIT_VL() do { if constexpr (STRIP) PG8_WAIT_V(9); else PG8_WAIT_V(8); } while (0)
#define PG8_WAIT_L(n) asm volatile("s_waitcnt lgkmcnt(" #n ")" ::: "memory")
#define PG8_BAR __builtin_amdgcn_s_barrier()
#define PG8_SCHED __builtin_amdgcn_sched_barrier(0)
    Unit cur, nxt; int ui = 0;
    if (!S.next(0, cur)) return;
    f32x4 acc[2][2][4][2];
#pragma unroll
    for (int a = 0; a < 2; ++a)
#pragma unroll
        for (int b = 0; b < 2; ++b)
#pragma unroll
            for (int m = 0; m < 4; ++m)
#pragma unroll
                for (int n = 0; n < 2; ++n) acc[a][b][m][n] = (f32x4){0.f, 0.f, 0.f, 0.f};
    bf16x8 At[4][2], B0[2][2], B1[2][2]; bf16x8 Sf[2]; f32x4 accS[2] = {(f32x4){0.f, 0.f, 0.f, 0.f}, (f32x4){0.f, 0.f, 0.f, 0.f}};
    const char* cA = (const char*)g.A + (size_t)cur.pm * tstep + (size_t)cur.ko * 2; const char* cB = (const char*)g.Bt + (size_t)cur.pn * tstep + (size_t)cur.ko * 2;
    const char* cS = STRIP ? (const char*)g.As + (size_t)cur.pm * 16 * K * 2 + (size_t)cur.ko * 2 : nullptr;
    S.a_ready(cur);
    f32x4 rsa = {0.f, 0.f, 0.f, 0.f}, rsb = rsa, rna = rsa, rnb = rsa; if constexpr (ROWSCALE) { static_assert(ALIGN_EPI, "ROWSCALE publishes behind a workgroup barrier inside the epilogue"); E.rs.load(cur, tid, rsa, rsb); }
    if constexpr (SP2) {
        PG8_STAGE(PG8_SB(0, 0), cB, voffB); PG8_STAGE(PG8_SB(0, 1), cB + hstep, voffB); PG8_STAGE(PG8_SA(0, 0), cA, voffA); PG8_STAGE(PG8_SA(0, 1), cA + hstep, voffA); PG8_SSTAGE(0, cS);
        if (wr == 1) PG8_BAR;
        if constexpr (STRIP) PG8_WAIT_V(3); else PG8_WAIT_V(2); PG8_BAR;
        PG8_STAGE(PG8_SB(1, 0), cB + kstep, voffB); PG8_STAGE(PG8_SA(1, 0), cA + kstep, voffA); PG8_STAGE(PG8_SB(1, 1), cB + hstep + kstep, voffB);
        PG8_WAIT_V(6); PG8_BAR;
    } else {
        PG8_STAGE(PG8_SB(0, 0), cB, voffB); PG8_STAGE(PG8_SA(0, 0), cA, voffA); PG8_STAGE(PG8_SB(0, 1), cB + hstep, voffB); PG8_STAGE(PG8_SA(0, 1), cA + hstep, voffA);
        if (wr == 1) PG8_BAR;
        PG8_WAIT_V(4); PG8_BAR;
        PG8_STAGE(PG8_SB(1, 0), cB + kstep, voffB); PG8_STAGE(PG8_SA(1, 0), cA + kstep, voffA); PG8_STAGE(PG8_SB(1, 1), cB + hstep + kstep, voffB);
        PG8_WAIT_V(6); PG8_BAR;
    }
    for (;;) {
        const bool has_next = S.next(ui + 1, nxt);
        const char* nS = (STRIP && has_next) ? (const char*)g.As + (size_t)nxt.pm * 16 * K * 2 + (size_t)nxt.ko * 2 : cS;
        const char* nA = has_next ? (const char*)g.A + (size_t)nxt.pm * tstep + (size_t)nxt.ko * 2 : cA; const char* nB = has_next ? (const char*)g.Bt + (size_t)nxt.pn * tstep + (size_t)nxt.ko * 2 : cB;
        for (int t = 0; t < nt; t += 2) {
            const bool last = (t == nt - 2);
            const char* a1 = cA + (size_t)(t + 1) * kstep;
            const char* a2 = last ? nA : cA + (size_t)(t + 2) * kstep; const char* b2 = last ? nB : cB + (size_t)(t + 2) * kstep;
            const char* a3 = a2 + kstep; const char* b3 = b2 + kstep;
            const char* s1 = STRIP ? cS + (size_t)(t + 1) * kstep : nullptr; const char* s2 = STRIP ? (last ? nS : cS + (size_t)(t + 2) * kstep) : nullptr;
            if (last && has_next) { S.a_ready(nxt); if constexpr (ROWSCALE) E.rs.load(nxt, tid, rna, rnb); }
            if constexpr (SP2) {
            PG8_LDB(B0, 0, 0); PG8_LDB(B1, 0, 1); PG8_SCHED; PG8_LDA(At, 0, 0); PG8_STAGE(PG8_SA(1, 1), a1 + hstep, voffA); PG8_SSTAGE(1, s1);
            PG8_WAIT_VL(); PG8_WAIT_L(0); PG8_BAR; PG8_MMA(0, 0, At, B0); PG8_MMA(0, 1, At, B1); PG8_BAR; PG8_SCHED;
            PG8_LDA(At, 0, 1); PG8_SLD(0); PG8_STAGE(PG8_SB(0, 0), b2, voffB); PG8_STAGE(PG8_SB(0, 1), b2 + hstep, voffB); PG8_STAGE(PG8_SA(0, 0), a2, voffA);
            PG8_WAIT_VL(); PG8_WAIT_L(0); PG8_BAR; PG8_MMA(1, 0, At, B0); PG8_MMA(1, 1, At, B1); PG8_SMMA(); PG8_BAR; PG8_SCHED;
            PG8_LDB(B0, 1, 0); PG8_LDB(B1, 1, 1); PG8_SCHED; PG8_LDA(At, 1, 0); PG8_STAGE(PG8_SA(0, 1), a2 + hstep, voffA); PG8_SSTAGE(0, s2);
            PG8_WAIT_VL(); PG8_WAIT_L(0); PG8_BAR; PG8_MMA(0, 0, At, B0); PG8_MMA(0, 1, At, B1); PG8_BAR; PG8_SCHED;
            PG8_LDA(At, 1, 1); PG8_SLD(1); PG8_STAGE(PG8_SB(1, 0), b3, voffB); PG8_STAGE(PG8_SB(1, 1), b3 + hstep, voffB); PG8_STAGE(PG8_SA(1, 0), a3, voffA);
            PG8_WAIT_VL(); PG8_WAIT_L(0); PG8_BAR; PG8_MMA(1, 0, At, B0); PG8_MMA(1, 1, At, B1); PG8_SMMA(); PG8_BAR; PG8_SCHED;
            } else {
            PG8_LDB(B0, 0, 0); PG8_SCHED; PG8_LDA(At, 0, 0); PG8_STAGE(PG8_SA(1, 1), a1 + hstep, voffA);
            PG8_WAIT_L(8); PG8_BAR; PG8_WAIT_L(0); PG8_MMA(0, 0, At, B0); PG8_BAR; PG8_SCHED;
            PG8_LDB(B1, 0, 1); PG8_STAGE(PG8_SB(0, 0), b2, voffB);
            PG8_BAR; PG8_WAIT_L(0); PG8_MMA(0, 1, At, B1); PG8_BAR;
            PG8_LDA(At, 0, 1); PG8_STAGE(PG8_SA(0, 0), a2, voffA);
            PG8_BAR; PG8_WAIT_L(0); PG8_MMA(1, 0, At, B0); PG8_BAR; PG8_SCHED;
            PG8_STAGE(PG8_SB(0, 1), b2 + hstep, voffB);
            PG8_WAIT_V(6); PG8_BAR; PG8_MMA(1, 1, At, B1); PG8_BAR;
            PG8_LDB(B0, 1, 0); PG8_SCHED; PG8_LDA(At, 1, 0); PG8_STAGE(PG8_SA(0, 1), a2 + hstep, voffA);
            PG8_WAIT_L(8); PG8_BAR; PG8_WAIT_L(0); PG8_MMA(0, 0, At, B0); PG8_BAR; PG8_SCHED;
            PG8_LDB(B1, 1, 1); PG8_STAGE(PG8_SB(1, 0), b3, voffB);
            PG8_BAR; PG8_WAIT_L(0); PG8_MMA(0, 1, At, B1); PG8_BAR;
            PG8_LDA(At, 1, 1); PG8_STAGE(PG8_SA(1, 0), a3, voffA);
            PG8_BAR; PG8_WAIT_L(0); PG8_MMA(1, 0, At, B0); PG8_BAR; PG8_SCHED;
            PG8_STAGE(PG8_SB(1, 1), b3 + hstep, voffB);
            PG8_WAIT_V(6); PG8_BAR; PG8_MMA(1, 1, At, B1); PG8_BAR;
            }
        }
        if constexpr (ALIGN_EPI) { if (wr == 0) PG8_BAR; }
        if constexpr (ROWSCALE) { E.rs.publish(tid, rsa, rsb); rsa = rna; rsb = rnb; }
        if constexpr (!Epi::AFTER_DRAIN) { E(acc, cur, wr, wc, fr, fq); if constexpr (STRIP) { E.strip(accS, cur, wr, wc, fr, fq); accS[0] = (f32x4){0.f, 0.f, 0.f, 0.f}; accS[1] = (f32x4){0.f, 0.f, 0.f, 0.f}; } S.done(cur); }
        if (!has_next) break;
#pragma unroll
        for (int a = 0; a < 2; ++a)
#pragma unroll
            for (int b = 0; b < 2; ++b)
#pragma unroll
                for (int m = 0; m < 4; ++m)
#pragma unroll
                    for (int n = 0; n < 2; ++n) acc[a][b][m][n] = (f32x4){0.f, 0.f, 0.f, 0.f};
        cur = nxt; cA = nA; cB = nB; cS = nS; ++ui;
        if constexpr (ALIGN_EPI) { if (wr == 1) PG8_BAR; }
    }
    PG8_WAIT_V(0);
    if constexpr (!ALIGN_EPI) { if (wr == 0) PG8_BAR; }
    PG8_BAR;
    if constexpr (Epi::AFTER_DRAIN) { E.fused(acc, cur, wr, wc, fr, fq, lds, wid, lane); S.done(cur); }
#undef PG8_SA
#undef PG8_SB
#undef PG8_STAGE
#undef PG8_SSTAGE
#undef PG8_SLD
#undef PG8_SMMA
#undef PG8_WAIT_VL
#undef PG8_LDA
#undef PG8_LDB
#undef PG8_MMA
#undef PG8_WAIT_V
#undef PG8_WAIT_L
#undef PG8_BAR
#undef PG8_SCHED
}
}

#define LAS __attribute__((address_space(3)))
typedef unsigned short bf16;
typedef float f32x4 __attribute__((ext_vector_type(4)));
typedef unsigned u32x4v __attribute__((ext_vector_type(4)));
typedef unsigned u32x2v __attribute__((ext_vector_type(2)));

constexpr int DM = 2048, TP = 8192, NSB = 16, TS = 32, MS = NSB * TS, MT = TP + MS, NL = 4, PAST = 1024;
constexpr int DIN = 6680, DINP = 6912, DFF = 5632;
constexpr int C_GQ = 0, C_GK = 256, C_GV = 512, C_GG = 1024, C_GA = 1536, C_RQ = 1552, C_RK = 2064, C_RV = 2576, C_RG = 3088, C_FQ = 3600, C_FK = 4624, C_FV = 5648, C_FF = 6672;
constexpr float EPS = 1e-6f;
constexpr int PBP = 3584, PB_GQ = 0, PB_GK = 256, PB_GV = 512, PB_GG = 1024, PB_RQ = 1536, PB_RK = 2048, PB_RV = 2560, PB_RG = 3072;
constexpr int NSLOT = 128 + NSB;
enum { I_XP = 0, I_XS, I_SGLA, I_SRET, I_CK, I_CV, I_CLF, I_NMIX, I_WIN, I_WGG, I_BGG, I_GGLA, I_GRET, I_GFQ, I_GFK, I_BFF, I_GFO, I_WOUT, I_NFFN, I_WG, I_WU, I_WD, N_IN };
constexpr size_t O_YP = 0, O_YS = O_YP + (size_t)TP * DM, O_GLAP = O_YS + (size_t)MS * DM, O_RETP = O_GLAP + (size_t)NL * 4 * 64 * 128,
                 O_FKP = O_RETP + (size_t)NL * 4 * 128 * 128, O_FVP = O_FKP + (size_t)NL * TP * 1024, O_LFP = O_FVP + (size_t)NL * TP * 1024,
                 O_GLAS = O_LFP + (size_t)NL * TP * 8, O_RETS = O_GLAS + (size_t)NL * NSB * 4 * 64 * 128, O_FKS = O_RETS + (size_t)NL * NSB * 4 * 128 * 128,
                 O_FVS = O_FKS + (size_t)NL * MS * 1024, O_LFS = O_FVS + (size_t)NL * MS * 1024, O_END = O_LFS + (size_t)NL * MS * 8;
static_assert(O_END == 96092160, "output size");
constexpr size_t al256(size_t x) { return (x + 255) & ~(size_t)255; }
constexpr size_t SZ_WIN = (size_t)DINP * DM * 2, SZ_WOUT = (size_t)DM * DM * 2, SZ_WGU = (size_t)2 * DFF * DM * 2, SZ_WDN = (size_t)DM * DFF * 2;
constexpr size_t WS_CTL = 0, WS_WIN = 1u << 20, WS_WOUT = WS_WIN + NL * SZ_WIN, WS_WGU = WS_WOUT + NL * SZ_WOUT, WS_WDN = WS_WGU + NL * SZ_WGU,
                 WS_H = WS_WDN + NL * SZ_WDN, WS_XN = WS_H + (size_t)MT * DM * 4, WS_PROJ = WS_XN + (size_t)MT * DM * 2,
                 WS_GQ = WS_PROJ + (size_t)MT * DINP * 4, WS_GK = WS_GQ + (size_t)MT * 256 * 4, WS_LA = WS_GK + (size_t)MT * 256 * 4,
                 WS_RQ = WS_LA + (size_t)MT * 256 * 4, WS_RK = WS_RQ + (size_t)MT * 512 * 4, WS_FQ = WS_RK + (size_t)MT * 512 * 4,
                 WS_LOGF = WS_FQ + (size_t)MT * 1024 * 4, WS_CKP = WS_LOGF + (size_t)MT * 8 * 4, WS_CKS = WS_CKP + (size_t)8 * TP * 4,
                 WS_GU = al256(WS_CKS + (size_t)NSB * 8 * (PAST + TS) * 4), WS_GDEC = WS_GU + (size_t)NSLOT * 4 * 64 * 128 * 4, WS_GS = WS_GDEC + (size_t)NSLOT * 4 * 64 * 4,
                 WS_RU = WS_GS + (size_t)NSLOT * 4 * 64 * 128 * 4, WS_RSP = WS_RU + (size_t)NSLOT * 4 * 128 * 128 * 4,
                 WS_MRG = WS_RSP + (size_t)NSLOT * 4 * 128 * 128 * 4, WS_ACT = WS_MRG + (size_t)MT * DM * 2, WS_QB = WS_ACT + (size_t)MT * DFF * 2,
                 WS_KB = WS_QB + (size_t)MT * 1024 * 2, WS_VB = WS_KB + (size_t)MT * 1024 * 2, WS_PART = WS_VB + (size_t)MT * 1024 * 2, WS_TABC = WS_PART + (size_t)8 * MS * DM * 4, WS_TABS = WS_TABC + (size_t)MT * 64 * 4, WS_RVT = WS_TABS + (size_t)MT * 64 * 4,
                 WS_FPART = WS_RVT + (size_t)NSLOT * 4 * 16 * 64 * 16, WS_SIDE = WS_FPART + (size_t)256 * (256 * 128 + 512) * 4, WS_SSP = WS_SIDE + (size_t)MT * 32 * 4, WS_SPART = WS_SSP + (size_t)8 * MT * 8 * 4, WS_END = WS_SPART + (size_t)256 * (32 * 128 + 64) * 4;

struct Ctx { const float* in[N_IN]; float* out; unsigned char* ws; };

typedef const __attribute__((address_space(4))) Ctx* KCtxP;
__device__ __forceinline__ KCtxP kctx() { KCtxP p = (KCtxP)__builtin_amdgcn_kernarg_segment_ptr(); asm volatile("" : "+s"(p)); return p; }
#define OPQ_PTRS const KCtxP kc_ = kctx(); unsigned char* const ws_ = kc_->ws; float* const out_ = kc_->out
__device__ __forceinline__ int otid() { int t = threadIdx.x; asm volatile("" : "+v"(t)); return t; }
__device__ __forceinline__ unsigned f2bf(float f) { unsigned u = __builtin_bit_cast(unsigned, f); return (u + 0x7fffu + ((u >> 16) & 1u)) >> 16; }
__device__ __forceinline__ unsigned pk2(float lo, float hi) { return f2bf(lo) | (f2bf(hi) << 16); }
__device__ __forceinline__ float wave_sum(float v) {
#pragma unroll
    for (int o = 1; o < 64; o <<= 1) v += __shfl_xor(v, o);
    return v;
}
__device__ __forceinline__ float grp8_sum(float v) { v += __shfl_xor(v, 1); v += __shfl_xor(v, 2); v += __shfl_xor(v, 4); return v; }
__device__ __forceinline__ float grp8_max(float v) { v = fmaxf(v, __shfl_xor(v, 1)); v = fmaxf(v, __shfl_xor(v, 2)); v = fmaxf(v, __shfl_xor(v, 4)); return v; }
__device__ __forceinline__ float logsigmoid_f(float x) { return fminf(x, 0.f) - log1pf(expf(-fabsf(x))); }
__device__ __forceinline__ float silu_f(float x) { return x / (1.0f + expf(-x)); }
__device__ __forceinline__ float ret_logg(int h) { return log1pf(-exp2f(-5.0f - (float)h)); }
__device__ __forceinline__ int slot_len(int slot) { return slot < 128 ? 64 : 32; }
__device__ __forceinline__ int slot_tok0(int slot) { return slot < 128 ? 64 * slot : TP + 32 * (slot - 128); }

__device__ __forceinline__ void cvt_item(const float* W, int ldw, int src_col0, int valid, bf16* out, int out_row0, int K, int k0, LAS float* scr, int lane, float scale = 1.f, bool gaff = false, const float* kgain = nullptr) {
    if (!gaff && valid == 32) {
        const int c4 = lane & 7;
#pragma unroll
        for (int i = 0; i < 8; ++i) { const int kk = 8 * i + (lane >> 3); const f32x4 v = *(const f32x4*)(W + (size_t)(k0 + kk) * ldw + src_col0 + 4 * c4); const float sk = kgain ? scale * kgain[k0 + kk] : scale;
            LAS float* d = scr + kk * 33 + 4 * c4; d[0] = v.x * sk; d[1] = v.y * sk; d[2] = v.z * sk; d[3] = v.w * sk; }
    } else {
    const int c = lane & 31;
    int sc = src_col0 + c; bool ok = c < valid;
    if (gaff) { ok = c < 24; sc = c < 16 ? C_GA + c : C_FF + (c - 16); }
#pragma unroll 8
    for (int i = 0; i < 32; ++i) { const int kk = 2 * i + (lane >> 5); scr[kk * 33 + c] = ok ? W[(size_t)(k0 + kk) * ldw + sc] * (kgain ? scale * kgain[k0 + kk] : scale) : 0.f; }
    }
    __builtin_amdgcn_s_waitcnt(0); asm volatile("" ::: "memory");
    const int ch = lane & 7;
#pragma unroll
    for (int j = 0; j < 4; ++j) { const int n = (lane >> 3) + 8 * j; const LAS float* s = scr + (8 * ch) * 33 + n;
        u32x4v o; o.x = pk2(s[0 * 33], s[1 * 33]); o.y = pk2(s[2 * 33], s[3 * 33]); o.z = pk2(s[4 * 33], s[5 * 33]); o.w = pk2(s[6 * 33], s[7 * 33]);
        *(u32x4v*)(out + (size_t)(out_row0 + n) * K + k0 + 8 * ch) = o; }
    __builtin_amdgcn_s_waitcnt(0); asm volatile("" ::: "memory");
}
__device__ __forceinline__ void cvt_decode(KCtxP kc_, unsigned char* ws_, int l, int part, int idx, const float*& W, int& ldw, int& col, bf16*& out, int& orow, int& K, int& k0, float& scale, bool& hasg) {
    constexpr int NB_OUT = DM / 32, NB_GU = 2 * DFF / 32, NB_DN = DM / 32, NBF = 6656 / 32;
    constexpr int I_OUT = (DM / 64) * NB_OUT, I_GU = (DM / 64) * NB_GU;
    int r = idx; scale = 1.f; hasg = false;
    if (part == 0) { const int kb = r / NBF, n0 = (r % NBF) * 32;
        W = kc_->in[I_WIN] + (size_t)l * DM * DIN; ldw = DIN; out = (bf16*)(ws_ + WS_WIN + l * SZ_WIN); orow = n0; K = DM; k0 = kb * 64; hasg = true;
        if (n0 < 1536) { col = n0; scale = n0 < 256 ? 0.125f : 1.f; } else { col = n0 + 16; scale = n0 < 2048 ? 0.08838834764831845f : 1.f; }
        return; }
    if (r < I_OUT) { const int kb = r / NB_OUT, nbk = r % NB_OUT; W = kc_->in[I_WOUT] + (size_t)l * DM * DM; ldw = DM; col = nbk * 32; out = (bf16*)(ws_ + WS_WOUT + l * SZ_WOUT); orow = nbk * 32; K = DM; k0 = kb * 64; return; }
    r -= I_OUT;
    if (r < I_GU) { const int kb = r / NB_GU, n0 = (r % NB_GU) * 32, tile = n0 >> 8, rr = n0 & 255;
        W = (rr < 128 ? kc_->in[I_WG] : kc_->in[I_WU]) + (size_t)l * DM * DFF; ldw = DFF; col = tile * 128 + (rr & 127); out = (bf16*)(ws_ + WS_WGU + l * SZ_WGU); orow = n0; K = DM; k0 = kb * 64; hasg = true; return; }
    r -= I_GU;
    { const int kb = r / NB_DN, nbk = r % NB_DN; W = kc_->in[I_WD] + (size_t)l * DFF * DM; ldw = DM; col = nbk * 32; out = (bf16*)(ws_ + WS_WDN + l * SZ_WDN); orow = nbk * 32; K = DFF; k0 = kb * 64; }
}
__device__ __forceinline__ void cvt_dma(KCtxP kc_, unsigned char* ws_, int l, int part, int idx, LAS float* buf, int lane) {
    const float* W; int ldw, col; bf16* out; int orow, K, k0; float scale; bool hasg;
    cvt_decode(kc_, ws_, l, part, idx, W, ldw, col, out, orow, K, k0, scale, hasg);
    const float* p0 = W + (size_t)(k0 + (lane >> 3)) * ldw + col; const int c = lane & 7;
#pragma unroll
    for (int i = 0; i < 8; ++i) __builtin_amdgcn_global_load_lds((const unsigned*)(p0 + (size_t)(8 * i) * ldw + 4 * (c ^ i)), (LAS unsigned*)(buf + i * 256), 16, 0, 0);
}
__device__ __forceinline__ void phase_convert(const Ctx& c, int l, LAS unsigned char* lds, int bid, int nb, int part, int lo = 0, int hi_ = -1) {
    OPQ_PTRS; (void)out_;
    const int tid_ = otid(), lane = tid_ & 63, wave = __builtin_amdgcn_readfirstlane(tid_ >> 6);
    LAS float* B0 = (LAS float*)(lds + wave * 16384);
    LAS float* G = (LAS float*)(lds + 131072);
    const int gw = bid * 8 + wave, ngw = nb * 8;
    constexpr int NB_OUT = DM / 32, NB_GU = 2 * DFF / 32, NB_DN = DM / 32;
    constexpr int I_OUT = (DM / 64) * NB_OUT, I_GU = (DM / 64) * NB_GU, I_DN = (DFF / 64) * NB_DN;
    __syncthreads();
    { const float* gsrc = (part == 0 ? kc_->in[I_NMIX] : kc_->in[I_NFFN]) + (size_t)l * DM; *(LAS f32x4*)(G + 4 * tid_) = *(const f32x4*)(gsrc + 4 * tid_); }
    if (part == 0) {
        for (int s = gw; s < 256; s += ngw) { const int kb = s >> 3, n0 = 6656 + (s & 7) * 32;
            cvt_item(kc_->in[I_WIN] + (size_t)l * DM * DIN, DIN, 0, n0 == 6656 ? 32 : 0, (bf16*)(ws_ + WS_WIN + l * SZ_WIN), n0, DM, kb * 64, B0, lane, 1.f, n0 == 6656, kc_->in[I_NMIX] + (size_t)l * DM); } }
    __syncthreads();
    const int hi = hi_ >= 0 ? hi_ : (part == 0 ? 32 * 208 : I_OUT + I_GU + I_DN);
    const int c4 = lane & 7, kq = lane >> 3;
    int it = lo + gw;
    if (it < hi) {
        cvt_dma(kc_, ws_, l, part, it, B0, lane);
        if (it + ngw < hi) { cvt_dma(kc_, ws_, l, part, it + ngw, B0 + 2048, lane); asm volatile("s_waitcnt vmcnt(8)" ::: "memory"); } else asm volatile("s_waitcnt vmcnt(0)" ::: "memory");
        int cur = 0;
        while (true) {
            const float* W; int ldw, col; bf16* out; int orow, K, k0; float scale; bool hasg;
            cvt_decode(kc_, ws_, l, part, it, W, ldw, col, out, orow, K, k0, scale, hasg);
            LAS float* B = B0 + cur * 2048;
            float x[4][8]; f32x4 ga = {1.f, 1.f, 1.f, 1.f}, gb = ga;
            if (hasg) { ga = *(const LAS f32x4*)(G + k0 + 8 * c4); gb = *(const LAS f32x4*)(G + k0 + 8 * c4 + 4); }
#pragma unroll
            for (int j = 0; j < 4; ++j) { const int n = kq + 8 * j; const LAS float* s = B + (8 * c4) * 32 + (((n >> 2) ^ c4) * 4) + (n & 3);
#pragma unroll
                for (int r = 0; r < 8; ++r) x[j][r] = s[r * 32]; }
            asm volatile("s_waitcnt lgkmcnt(0)" ::: "memory");
            const int nx2 = it + 2 * ngw; const bool issued = nx2 < hi;
            if (issued) cvt_dma(kc_, ws_, l, part, nx2, B, lane);
            const float s0 = scale * ga[0], s1 = scale * ga[1], s2 = scale * ga[2], s3 = scale * ga[3], s4 = scale * gb[0], s5 = scale * gb[1], s6 = scale * gb[2], s7 = scale * gb[3];
#pragma unroll
            for (int j = 0; j < 4; ++j) { const int n = kq + 8 * j;
                u32x4v o; o.x = pg8::cvt_pk_bf16(x[j][0] * s0, x[j][1] * s1); o.y = pg8::cvt_pk_bf16(x[j][2] * s2, x[j][3] * s3); o.z = pg8::cvt_pk_bf16(x[j][4] * s4, x[j][5] * s5); o.w = pg8::cvt_pk_bf16(x[j][6] * s6, x[j][7] * s7);
                *(u32x4v*)(out + (size_t)(orow + n) * K + k0 + 8 * c4) = o; }
            asm volatile("" ::: "memory");
            it += ngw; if (it >= hi) break;
            cur ^= 1;
            if (issued) asm volatile("s_waitcnt vmcnt(12)" ::: "memory"); else asm volatile("s_waitcnt vmcnt(4)" ::: "memory");
        }
    }
    asm volatile("s_waitcnt vmcnt(0) lgkmcnt(0)" ::: "memory");
}

__device__ __forceinline__ float block_excl_offset(float run, int tid, LAS float* tot) {
    const int lane = tid & 63, wv = tid >> 6; float inc = run;
#pragma unroll
    for (int o = 1; o < 64; o <<= 1) { const float t = __shfl_up(inc, o); if (lane >= o) inc += t; }
    if (lane == 63) tot[wv] = inc;
    __syncthreads();
    float base = 0.f;
#pragma unroll
    for (int w = 0; w < 8; ++w) base += (w < wv) ? tot[w] : 0.f;
    return base + (inc - run);
}
__device__ __forceinline__ void phase_fox_cumsum2(const Ctx& c, int l, LAS unsigned char* lds, int bid, int nb) {
    OPQ_PTRS;
    const int tid = otid(); LAS float* tot = (LAS float*)lds;
    const float* SIDE = (const float*)(ws_ + WS_SIDE); float* CKP = (float*)(ws_ + WS_CKP); float* CKS = (float*)(ws_ + WS_CKS); const float* bff = kc_->in[I_BFF] + l * 8;
    for (int u = bid; u < 8 + NSB * 8; u += nb) {
        __syncthreads();
        if (u < 8) { const int h = u; const float bb = bff[h]; float v[16]; float run = 0.f;
#pragma unroll
            for (int i = 0; i < 16; ++i) { const int t = tid * 16 + i; const float x = logsigmoid_f(SIDE[(size_t)t * 32 + 16 + h] + bb); out_[O_LFP + ((size_t)l * TP + t) * 8 + h] = x; run += x; v[i] = run; }
            const float off = block_excl_offset(run, tid, tot);
#pragma unroll
            for (int i = 0; i < 16; ++i) CKP[(size_t)h * TP + tid * 16 + i] = v[i] + off;
        } else { const int bh = u - 8, b = bh >> 3, h = bh & 7; const float bb = bff[h]; float v[3]; float run = 0.f;
#pragma unroll
            for (int i = 0; i < 3; ++i) { const int j = tid * 3 + i; float x = 0.f;
                if (j < PAST) x = kc_->in[I_CLF][(((size_t)l * NSB + b) * PAST + j) * 8 + h];
                else if (j < PAST + TS) { const int s = b * TS + (j - PAST); x = logsigmoid_f(SIDE[(size_t)(TP + s) * 32 + 16 + h] + bb); out_[O_LFS + ((size_t)l * MS + s) * 8 + h] = x; }
                run += x; v[i] = run; }
            const float off = block_excl_offset(run, tid, tot);
#pragma unroll
            for (int i = 0; i < 3; ++i) { const int j = tid * 3 + i; if (j < PAST + TS) CKS[(size_t)bh * (PAST + TS) + j] = v[i] + off; }
        }
    }
}

__device__ __forceinline__ void phase_x_to_bf16(const float* src0, const float* src1, bf16* hb, float* ss, int bid, int nb) {
    const int tid_ = otid(), lane = tid_ & 63, wave = tid_ >> 6;
    for (int m = bid * 8 + wave; m < MT; m += nb * 8) {
        const float* xr = m < TP ? src0 + (size_t)m * DM : src1 + (size_t)(m - TP) * DM; float s = 0.f;
#pragma unroll
        for (int j = 0; j < 8; ++j) { const f32x4 v = *(const f32x4*)(xr + 4 * (lane + 64 * j)); s += (v.x * v.x + v.y * v.y) + (v.z * v.z + v.w * v.w);
            u32x2v o; o.x = pk2(v.x, v.y); o.y = pk2(v.z, v.w); *(u32x2v*)(hb + (size_t)m * DM + 4 * (lane + 64 * j)) = o; }
        s = wave_sum(s); if (lane < 8) ss[(size_t)m * 8 + lane] = lane == 0 ? s : 0.f;
    }
}

namespace mx {
typedef short bf16x8 __attribute__((ext_vector_type(8)));
typedef float f32x16 __attribute__((ext_vector_type(16)));
typedef unsigned u32x4 __attribute__((ext_vector_type(4)));
__device__ __forceinline__ unsigned cvtpk(float lo, float hi) { unsigned r; asm("v_cvt_pk_bf16_f32 %0, %1, %2" : "=v"(r) : "v"(lo), "v"(hi)); return r; }
__device__ __forceinline__ bf16x8 pack8(const f32x4 a, const f32x4 b) { u32x4 w = {cvtpk(a[0], a[1]), cvtpk(a[2], a[3]), cvtpk(b[0], b[1]), cvtpk(b[2], b[3])}; return *reinterpret_cast<bf16x8*>(&w); }
__device__ __forceinline__ int crow(int r, int hi) { return (r & 3) + 8 * (r >> 2) + 4 * hi; }
__device__ __forceinline__ float ldf(const float* ubase, unsigned off) { return *(const float*)((const char*)ubase + off); }
__device__ __forceinline__ f32x4 ldf4(const float* ubase, unsigned off) { return *(const f32x4*)((const char*)ubase + off); }
__device__ __forceinline__ float logsig_fast(float x) { return fminf(x, 0.f) - __logf(1.f + __expf(-fabsf(x))); }
__device__ __forceinline__ float silu_fast(float x) { return x * __builtin_amdgcn_rcpf(1.f + __builtin_amdgcn_exp2f(-1.4426950408889634f * x)); }
#define MX_MFMA(a, b, c) __builtin_amdgcn_mfma_f32_32x32x16_bf16(a, b, c, 0, 0, 0)
__device__ __forceinline__ void ld_slab8(float (&x)[8], const float* rowbase, int pitch, unsigned voff) {
#pragma unroll
    for (int j = 0; j < 8; ++j) x[j] = ldf(rowbase + (size_t)(8 * (j >> 2) + (j & 3)) * pitch, voff);
}
__device__ __forceinline__ float bf2f(unsigned short v) { return __uint_as_float((unsigned)v << 16); }
__device__ __forceinline__ f32x4 ld4bf(const bf16* p) { const u32x2v w = *(const u32x2v*)p; return (f32x4){__uint_as_float(w.x << 16), __uint_as_float(w.x & 0xffff0000u), __uint_as_float(w.y << 16), __uint_as_float(w.y & 0xffff0000u)}; }
__device__ __forceinline__ bf16x8 ld8slot(const bf16* p) { const u32x2v a = *(const u32x2v*)p, b = *(const u32x2v*)(p + 8); u32x4 w = {a.x, a.y, b.x, b.y}; return *reinterpret_cast<bf16x8*>(&w); }
__device__ __forceinline__ unsigned short ldh(const bf16* ubase, unsigned off) { return *(const unsigned short*)((const char*)ubase + off); }
__device__ __forceinline__ void ld_slab8h(unsigned short (&x)[8], const bf16* rowbase, int pitch, unsigned voff) {
#pragma unroll
    for (int j = 0; j < 8; ++j) x[j] = ldh(rowbase + (size_t)(8 * (j >> 2) + (j & 3)) * pitch, voff);
}
__device__ __forceinline__ bf16x8 frag8h(const unsigned short (&x)[8]) { u32x4 w = {(unsigned)x[0] | ((unsigned)x[1] << 16), (unsigned)x[2] | ((unsigned)x[3] << 16), (unsigned)x[4] | ((unsigned)x[5] << 16), (unsigned)x[6] | ((unsigned)x[7] << 16)}; return *reinterpret_cast<bf16x8*>(&w); }
}

__device__ __forceinline__ int q_next(unsigned* q, int lane) { unsigned v = 0u; if (lane == 0) v = __hip_atomic_fetch_add(q, 1u, __ATOMIC_RELAXED, __HIP_MEMORY_SCOPE_AGENT); return (int)__builtin_amdgcn_readfirstlane(v); }
constexpr int CW_Q = 8192;
constexpr size_t SZ_TAB = (size_t)MT * 64 * 4;
__device__ __forceinline__ void phase_rope_tables(float* TABC, float* TABS, int bid, int nb) {
    const int tid = otid();
    for (int i = bid * 512 + tid; i < MT * 64; i += nb * 512) { const int m = i >> 6, j = i & 63; const int pos = m < TP ? m : PAST + ((m - TP) & 31);
        const float inv = powf(10000.f, -(float)j * (1.f / 64.f)); float sn, cs; sincosf((float)pos * inv, &sn, &cs); TABC[i] = cs; TABS[i] = sn; }
}
__device__ __forceinline__ void item_gla_u(KCtxP kc_, unsigned char* ws_, int l, int ug, int kb, int lane) {
    using namespace mx;
    const int slot = ug >> 2, h = ug & 3, L = slot_len(slot), tok0 = slot_tok0(slot), r32 = lane & 31, hi = lane >> 5, nlb = L >> 5;
    const bf16* PB = (const bf16*)(ws_ + WS_PROJ); const float* SIDE = (const float*)(ws_ + WS_SIDE);
    const int k = kb * 32 + r32, hk = h * 64 + k;
    const float* Wgg = kc_->in[I_WGG] + (size_t)l * 16 * 256; const float bg = kc_->in[I_BGG][l * 256 + hk];
    bf16x8 wf; { float w[8];
#pragma unroll
        for (int j = 0; j < 8; ++j) w[j] = Wgg[(8 * hi + j) * 256 + hk];
        wf = pack8((f32x4){w[0], w[1], w[2], w[3]}, (f32x4){w[4], w[5], w[6], w[7]}); }
    float la[2][16];
#pragma unroll
    for (int lb = 0; lb < 2; ++lb) {
        if (lb < nlb) { const float* gp = SIDE + (size_t)(tok0 + lb * 32 + r32) * 32 + 8 * hi;
            const bf16x8 af = pack8(*(const f32x4*)gp, *(const f32x4*)(gp + 4)); f32x16 sp = {}; sp = MX_MFMA(af, wf, sp);
#pragma unroll
            for (int r = 0; r < 16; ++r) la[lb][r] = logsig_fast(sp[r] + bg) * (1.f / 16.f); }
        else {
#pragma unroll
            for (int r = 0; r < 16; ++r) la[lb][r] = 0.f; }
    }
    float run = 0.f;
#pragma unroll
    for (int lb = 0; lb < 2; ++lb)
#pragma unroll
        for (int g = 0; g < 4; ++g) { float* v = &la[lb][4 * g]; v[1] += v[0]; v[2] += v[1]; v[3] += v[2]; const float gs = v[3], pg = __shfl_xor(gs, 32);
            const float off = run + (hi ? pg : 0.f); v[0] += off; v[1] += off; v[2] += off; v[3] += off; run += gs + pg; }
    const float tot = run;
    bf16x8 kf[4];
#pragma unroll
    for (int lb = 0; lb < 2; ++lb) {
        float kp[16];
#pragma unroll
        for (int r = 0; r < 16; ++r) kp[r] = 0.f;
        if (lb < nlb) {
#pragma unroll
            for (int r = 0; r < 16; ++r) kp[r] = bf2f(PB[(size_t)(tok0 + lb * 32 + crow(r, hi)) * PBP + PB_GK + hk]) * __expf(tot - la[lb][r]); }
        kf[2 * lb] = pack8((f32x4){kp[0], kp[1], kp[2], kp[3]}, (f32x4){kp[4], kp[5], kp[6], kp[7]});
        kf[2 * lb + 1] = pack8((f32x4){kp[8], kp[9], kp[10], kp[11]}, (f32x4){kp[12], kp[13], kp[14], kp[15]});
    }
    const unsigned voff = (unsigned)((4 * hi * PBP + r32) * 2);
    float* U = (float*)(ws_ + WS_GU);
    f32x16 acc[4];
#pragma unroll
    for (int vb = 0; vb < 4; ++vb) { acc[vb] = (f32x16){};
#pragma unroll
        for (int t = 0; t < 4; ++t) if (t < 2 * nlb) { unsigned short x[8]; ld_slab8h(x, PB + (size_t)(tok0 + 16 * t) * PBP + PB_GV + h * 128 + vb * 32, PBP, voff);
            acc[vb] = MX_MFMA(kf[t], frag8h(x), acc[vb]); }
        asm volatile("" ::: "memory"); }
    if (hi == 0) ((float*)(ws_ + WS_GDEC))[(size_t)ug * 64 + k] = __expf(tot);
    if (slot < 128) {
#pragma unroll
        for (int vb = 0; vb < 4; ++vb) { float* up = U + ((((size_t)ug * 2 + kb) * 4 + vb) * 64 + lane) * 16;
#pragma unroll
            for (int g = 0; g < 4; ++g) *(f32x4*)(up + 4 * g) = (f32x4){acc[vb][4 * g], acc[vb][4 * g + 1], acc[vb][4 * g + 2], acc[vb][4 * g + 3]}; }
    } else {
        const int b = slot - 128; float dk[16];
#pragma unroll
        for (int r = 0; r < 16; ++r) dk[r] = __expf(__shfl(tot, crow(r, hi)));
#pragma unroll
        for (int vb = 0; vb < 4; ++vb) { const float* s0p = kc_->in[I_SGLA] + (((size_t)l * NSB + b) * 4 + h) * 8192 + (size_t)(vb * 32 + r32); float s0v[16];
#pragma unroll
            for (int r = 0; r < 16; ++r) s0v[r] = s0p[(size_t)(kb * 32 + crow(r, hi)) * 128];
            float* so = kc_->out + O_GLAS + (((size_t)l * NSB + b) * 4 + h) * 8192 + (size_t)(vb * 32 + r32); unsigned short sh[16];
#pragma unroll
            for (int r = 0; r < 16; ++r) { const float S = dk[r] * s0v[r] + acc[vb][r]; so[(size_t)(kb * 32 + crow(r, hi)) * 128] = S; sh[r] = (unsigned short)f2bf(S); }
            bf16* gp = (bf16*)(ws_ + WS_GS) + ((((size_t)ug * 2 + kb) * 4 + vb) * 64 + lane) * 16;
            *(u32x4*)gp = (u32x4){(unsigned)sh[0] | ((unsigned)sh[1] << 16), (unsigned)sh[2] | ((unsigned)sh[3] << 16), (unsigned)sh[4] | ((unsigned)sh[5] << 16), (unsigned)sh[6] | ((unsigned)sh[7] << 16)};
            *(u32x4*)(gp + 8) = (u32x4){(unsigned)sh[8] | ((unsigned)sh[9] << 16), (unsigned)sh[10] | ((unsigned)sh[11] << 16), (unsigned)sh[12] | ((unsigned)sh[13] << 16), (unsigned)sh[14] | ((unsigned)sh[15] << 16)}; }
    }
}
__device__ __forceinline__ void item_ret_u(KCtxP kc_, unsigned char* ws_, int l, int ug, int kb, int lane) {
    using namespace mx;
    const int slot = ug >> 2, h = ug & 3, L = slot_len(slot), tok0 = slot_tok0(slot), r32 = lane & 31, hi = lane >> 5, nt = L >> 4;
    const bf16* PB = (const bf16*)(ws_ + WS_PROJ); const float* TABC = (const float*)(ws_ + WS_TABC); const float* TABS = (const float*)(ws_ + WS_TABS);
    const int k = kb * 32 + r32, jf = k & 63; const bool low = kb < 2; const float lg = ret_logg(h);
    const unsigned koff = (unsigned)((4 * hi * PBP + k) * 2), poff = (unsigned)((4 * hi * PBP + (k ^ 64)) * 2), toff = (unsigned)((4 * hi * 64 + jf) * 4);
    bf16x8 kf[4];
#pragma unroll
    for (int t = 0; t < 4; ++t) { float y[8];
#pragma unroll
        for (int j = 0; j < 8; ++j) y[j] = 0.f;
        if (t < nt) { unsigned short xsh[8], xph[8]; float xs[8], xp[8], cs[8], sn[8];
            ld_slab8h(xsh, PB + (size_t)(tok0 + 16 * t) * PBP + PB_RK + h * 128, PBP, koff); ld_slab8h(xph, PB + (size_t)(tok0 + 16 * t) * PBP + PB_RK + h * 128, PBP, poff);
#pragma unroll
            for (int j = 0; j < 8; ++j) { xs[j] = bf2f(xsh[j]); xp[j] = bf2f(xph[j]); }
            ld_slab8(cs, TABC + (size_t)(tok0 + 16 * t) * 64, 64, toff); ld_slab8(sn, TABS + (size_t)(tok0 + 16 * t) * 64, 64, toff);
#pragma unroll
            for (int j = 0; j < 8; ++j) { const int ll = 16 * t + 8 * (j >> 2) + 4 * hi + (j & 3); const float rot = low ? xs[j] * cs[j] - xp[j] * sn[j] : xp[j] * sn[j] + xs[j] * cs[j];
                y[j] = rot * __expf(lg * (float)(L - 1 - ll)); } }
        kf[t] = pack8((f32x4){y[0], y[1], y[2], y[3]}, (f32x4){y[4], y[5], y[6], y[7]}); }
    const unsigned voff = (unsigned)((4 * hi * PBP + r32) * 2);
    float* U = (float*)(ws_ + WS_RU); bf16x8* VT = (bf16x8*)(ws_ + WS_RVT);
    f32x16 acc[4];
#pragma unroll
    for (int vb = 0; vb < 4; ++vb) { acc[vb] = (f32x16){};
#pragma unroll
        for (int t = 0; t < 4; ++t) if (t < nt) { unsigned short x[8]; ld_slab8h(x, PB + (size_t)(tok0 + 16 * t) * PBP + PB_RV + h * 128 + vb * 32, PBP, voff);
            const bf16x8 vf = frag8h(x); if (kb == 0) VT[(((size_t)ug * 4 + vb) * 4 + t) * 64 + lane] = vf;
            acc[vb] = MX_MFMA(kf[t], vf, acc[vb]); }
        asm volatile("" ::: "memory"); }
    if (slot < 128) {
#pragma unroll
        for (int vb = 0; vb < 4; ++vb) { float* up = U + ((((size_t)ug * 4 + kb) * 4 + vb) * 64 + lane) * 16;
#pragma unroll
            for (int g = 0; g < 4; ++g) *(f32x4*)(up + 4 * g) = (f32x4){acc[vb][4 * g], acc[vb][4 * g + 1], acc[vb][4 * g + 2], acc[vb][4 * g + 3]}; }
    } else {
        const int b = slot - 128; const float dec = __expf(lg * 32.f);
#pragma unroll
        for (int vb = 0; vb < 4; ++vb) { const float* s0p = kc_->in[I_SRET] + (((size_t)l * NSB + b) * 4 + h) * 16384 + (size_t)(vb * 32 + r32); float s0v[16];
#pragma unroll
            for (int r = 0; r < 16; ++r) s0v[r] = s0p[(size_t)(kb * 32 + crow(r, hi)) * 128];
            float* so = kc_->out + O_RETS + (((size_t)l * NSB + b) * 4 + h) * 16384 + (size_t)(vb * 32 + r32); unsigned short sh[16];
#pragma unroll
            for (int r = 0; r < 16; ++r) { so[(size_t)(kb * 32 + crow(r, hi)) * 128] = dec * s0v[r] + acc[vb][r]; sh[r] = (unsigned short)f2bf(s0v[r]); }
            bf16* gp = (bf16*)(ws_ + WS_RSP) + ((((size_t)ug * 4 + kb) * 4 + vb) * 64 + lane) * 16;
            *(u32x4*)gp = (u32x4){(unsigned)sh[0] | ((unsigned)sh[1] << 16), (unsigned)sh[2] | ((unsigned)sh[3] << 16), (unsigned)sh[4] | ((unsigned)sh[5] << 16), (unsigned)sh[6] | ((unsigned)sh[7] << 16)};
            *(u32x4*)(gp + 8) = (u32x4){(unsigned)sh[8] | ((unsigned)sh[9] << 16), (unsigned)sh[10] | ((unsigned)sh[11] << 16), (unsigned)sh[12] | ((unsigned)sh[13] << 16), (unsigned)sh[14] | ((unsigned)sh[15] << 16)}; }
    }
}
__device__ __forceinline__ void phase_mix_u(const Ctx& c, int l, int bid, int nb) {
    OPQ_PTRS; (void)out_;
    const int tid = otid(), lane = tid & 63, skip = nb > 16 ? 8 : 0;
    const int gw = (bid - skip) * 8 + __builtin_amdgcn_readfirstlane(tid >> 6), ngw = (nb - skip) * 8;
    constexpr int N_G = NSLOT * 4 * 2, N_R = NSLOT * 4 * 4;
    if (bid >= skip)
    for (int it = gw; it < N_G + N_R; it += ngw) {
        if (it < N_R) item_ret_u(kc_, ws_, l, it >> 2, it & 3, lane);
        else { const int r = it - N_R; item_gla_u(kc_, ws_, l, r >> 1, r & 1, lane); }
    }
}
__device__ __forceinline__ void phase_scans(const Ctx& c, int l, int bid, int nb) {
    OPQ_PTRS;
    const int tid = otid();
    const float* GU = (const float*)(ws_ + WS_GU); const float* GDEC = (const float*)(ws_ + WS_GDEC); bf16* GS = (bf16*)(ws_ + WS_GS);
    const float* RU = (const float*)(ws_ + WS_RU); bf16* RS = (bf16*)(ws_ + WS_RSP);
    constexpr int EG = 4 * 64 * 128, ER = 4 * 128 * 128, WG = EG / 512, WR = ER / 512;
    for (int w = bid; w < WG + WR; w += nb) {
        if (w < WG) { const int e = w * 512 + tid, h = e >> 13, ee = e & 8191;
            const int r = ee & 15, ln = (ee >> 4) & 63, vb = (ee >> 10) & 3, kb = ee >> 12, k = kb * 32 + mx::crow(r, ln >> 5), v = vb * 32 + (ln & 31), hk = h * 64 + k;
            float S = 0.f;
            for (int c0 = 0; c0 < 128; c0 += 32) { float uu[32], dd[32];
#pragma unroll
                for (int i = 0; i < 32; ++i) { uu[i] = GU[(size_t)(c0 + i) * EG + e]; dd[i] = GDEC[(size_t)(c0 + i) * 256 + hk]; }
#pragma unroll
                for (int i = 0; i < 32; ++i) { S = dd[i] * S + uu[i]; GS[(size_t)(c0 + i) * EG + e] = (bf16)f2bf(S); } }
            out_[O_GLAP + (size_t)l * EG + h * 8192 + k * 128 + v] = S;
        } else { const int e = (w - WG) * 512 + tid, h = e >> 14, ee = e & 16383;
            const int r = ee & 15, ln = (ee >> 4) & 63, vb = (ee >> 10) & 3, kb = ee >> 12, k = kb * 32 + mx::crow(r, ln >> 5), v = vb * 32 + (ln & 31); const float lg = ret_logg(h);
            const float dec = __expf(lg * 64.f); float S = 0.f;
            for (int c0 = 0; c0 < 128; c0 += 32) { float uu[32];
#pragma unroll
                for (int i = 0; i < 32; ++i) uu[i] = RU[(size_t)(c0 + i) * ER + e];
#pragma unroll
                for (int i = 0; i < 32; ++i) { RS[(size_t)(c0 + i) * ER + e] = (bf16)f2bf(S); S = dec * S + uu[i]; } }
            out_[O_RETP + (size_t)l * ER + h * 16384 + k * 128 + v] = S;
        }
    }
}
__device__ __forceinline__ void item_gla_o(KCtxP kc_, unsigned char* ws_, int l, int ug, int lh, int lane, const LAS float* gains) {
    using namespace mx;
    const int slot = ug >> 2, h = ug & 3, tok = slot_tok0(slot) + lh * 32 + (lane & 31), hi = lane >> 5;
    const bf16* PB = (const bf16*)(ws_ + WS_PROJ); const bf16* GS = (const bf16*)(ws_ + WS_GS);
    const bf16* qp = PB + (size_t)tok * PBP + PB_GQ + h * 64 + 4 * hi;
    u32x2v graw[16];
    { const bf16* gate = PB + (size_t)tok * PBP + PB_GG + h * 128 + 4 * hi;
#pragma unroll
      for (int i = 0; i < 16; ++i) graw[i] = *(const u32x2v*)(gate + (i >> 2) * 32 + 8 * (i & 3)); }
    bf16x8 qf[4];
#pragma unroll
    for (int s = 0; s < 4; ++s) qf[s] = ld8slot(qp + 16 * s);
    f32x16 acc[4];
#pragma unroll
    for (int vb = 0; vb < 4; ++vb) { acc[vb] = (f32x16){};
#pragma unroll
        for (int kb = 0; kb < 2; ++kb)
#pragma unroll
            for (int t = 0; t < 2; ++t) acc[vb] = MX_MFMA(*(const bf16x8*)(GS + ((((size_t)ug * 2 + kb) * 4 + vb) * 64 + lane) * 16 + 8 * t), qf[2 * kb + t], acc[vb]); }
    float ss = 0.f;
#pragma unroll
    for (int vb = 0; vb < 4; ++vb)
#pragma unroll
        for (int r = 0; r < 16; ++r) ss += acc[vb][r] * acc[vb][r];
    ss += __shfl_xor(ss, 32);
    const float rn = rsqrtf(ss * (1.f / 128.f) + EPS);
    bf16* op = (bf16*)(ws_ + WS_MRG) + (size_t)tok * DM + h * 128 + 4 * hi; const LAS float* gl = gains + 4 * hi;
    u32x2v w[16];
#pragma unroll
    for (int vb = 0; vb < 4; ++vb)
#pragma unroll
        for (int g = 0; g < 4; ++g) { const u32x2v gr = graw[vb * 4 + g]; const f32x4 gt = {__uint_as_float(gr.x << 16), __uint_as_float(gr.x & 0xffff0000u), __uint_as_float(gr.y << 16), __uint_as_float(gr.y & 0xffff0000u)};
            const f32x4 gn = *(const LAS f32x4*)(gl + vb * 32 + 8 * g);
            w[vb * 4 + g].x = cvtpk(acc[vb][4 * g] * rn * gn[0] * silu_fast(gt[0]), acc[vb][4 * g + 1] * rn * gn[1] * silu_fast(gt[1]));
            w[vb * 4 + g].y = cvtpk(acc[vb][4 * g + 2] * rn * gn[2] * silu_fast(gt[2]), acc[vb][4 * g + 3] * rn * gn[3] * silu_fast(gt[3])); }
#pragma unroll
    for (int vb = 0; vb < 4; ++vb)
#pragma unroll
        for (int g = 0; g < 4; ++g) *(u32x2v*)(op + vb * 32 + 8 * g) = w[vb * 4 + g];
}
__device__ __forceinline__ void rope_frags(mx::bf16x8 (&f)[8], const bf16* xr, const float* tc, const float* ts) {
    using namespace mx;
#pragma unroll
    for (int kb = 0; kb < 2; ++kb)
#pragma unroll
        for (int t = 0; t < 2; ++t) { const int o = kb * 32 + 16 * t;
            const f32x4 a0 = ld4bf(xr + o), a1 = ld4bf(xr + o + 8), b0 = ld4bf(xr + 64 + o), b1 = ld4bf(xr + 64 + o + 8);
            const f32x4 c0 = *(const f32x4*)(tc + o), c1 = *(const f32x4*)(tc + o + 8), s0 = *(const f32x4*)(ts + o), s1 = *(const f32x4*)(ts + o + 8);
            f[2 * kb + t] = pack8(a0 * c0 - b0 * s0, a1 * c1 - b1 * s1); f[2 * (kb + 2) + t] = pack8(a0 * s0 + b0 * c0, a1 * s1 + b1 * c1); }
}
__device__ __forceinline__ void item_ret_o(KCtxP kc_, unsigned char* ws_, int l, int ug, int lh, int lane, const LAS float* gains) {
    using namespace mx;
    const int slot = ug >> 2, h = ug & 3, L = slot_len(slot), tok0 = slot_tok0(slot), r32 = lane & 31, hi = lane >> 5, lq = lh * 32 + r32, tok = tok0 + lq, nsb = L >> 5;
    const bf16* PB = (const bf16*)(ws_ + WS_PROJ); const float* TABC = (const float*)(ws_ + WS_TABC); const float* TABS = (const float*)(ws_ + WS_TABS);
    const bf16* RS = (const bf16*)(ws_ + WS_RSP); const bf16x8* VT = (const bf16x8*)(ws_ + WS_RVT);
    const float lg2 = ret_logg(h) * 1.4426950408889634f;
    u32x2v graw[16];
    { const bf16* gate = PB + (size_t)tok * PBP + PB_RG + h * 128 + 4 * hi;
#pragma unroll
      for (int i = 0; i < 16; ++i) graw[i] = *(const u32x2v*)(gate + (i >> 2) * 32 + 8 * (i & 3)); }
    bf16x8 qf[8];
    rope_frags(qf, PB + (size_t)tok * PBP + PB_RQ + h * 128 + 4 * hi, TABC + (size_t)tok * 64 + 4 * hi, TABS + (size_t)tok * 64 + 4 * hi);
    f32x16 acc[4];
#pragma unroll
    for (int vb = 0; vb < 4; ++vb) { acc[vb] = (f32x16){};
#pragma unroll
        for (int kb = 0; kb < 4; ++kb)
#pragma unroll
            for (int t = 0; t < 2; ++t) acc[vb] = MX_MFMA(*(const bf16x8*)(RS + ((((size_t)ug * 4 + kb) * 4 + vb) * 64 + lane) * 16 + 8 * t), qf[2 * kb + t], acc[vb]); }
    { const float qi = __builtin_amdgcn_exp2f(lg2 * (float)(lq + 1));
#pragma unroll
      for (int vb = 0; vb < 4; ++vb)
#pragma unroll
          for (int r = 0; r < 16; ++r) acc[vb][r] *= qi; }
#pragma unroll
    for (int sb = 0; sb < 2; ++sb) if (sb < nsb) {
        const int ts = tok0 + sb * 32 + r32; bf16x8 kf[8];
        rope_frags(kf, PB + (size_t)ts * PBP + PB_RK + h * 128 + 4 * hi, TABC + (size_t)ts * 64 + 4 * hi, TABS + (size_t)ts * 64 + 4 * hi);
        f32x16 sc = {};
#pragma unroll
        for (int s = 0; s < 8; ++s) sc = MX_MFMA(kf[s], qf[s], sc);
#pragma unroll
        for (int r = 0; r < 16; ++r) { const int sd = lq - (sb * 32 + crow(r, hi)); sc[r] *= __builtin_amdgcn_exp2f(lg2 * (float)(sd < 0 ? -sd : sd)); }
        const bf16x8 p0 = pack8((f32x4){sc[0], sc[1], sc[2], sc[3]}, (f32x4){sc[4], sc[5], sc[6], sc[7]}), p1 = pack8((f32x4){sc[8], sc[9], sc[10], sc[11]}, (f32x4){sc[12], sc[13], sc[14], sc[15]});
#pragma unroll
        for (int vb = 0; vb < 4; ++vb) { acc[vb] = MX_MFMA(VT[(((size_t)ug * 4 + vb) * 4 + 2 * sb) * 64 + lane], p0, acc[vb]); acc[vb] = MX_MFMA(VT[(((size_t)ug * 4 + vb) * 4 + 2 * sb + 1) * 64 + lane], p1, acc[vb]); }
    }
    float sm = 0.f;
#pragma unroll
    for (int vb = 0; vb < 4; ++vb)
#pragma unroll
        for (int r = 0; r < 16; ++r) sm += acc[vb][r];
    sm += __shfl_xor(sm, 32); const float mean = sm * (1.f / 128.f); float sq = 0.f;
#pragma unroll
    for (int vb = 0; vb < 4; ++vb)
#pragma unroll
        for (int r = 0; r < 16; ++r) { acc[vb][r] -= mean; sq += acc[vb][r] * acc[vb][r]; }
    sq += __shfl_xor(sq, 32);
    const float rn = rsqrtf(sq * (1.f / 128.f) + EPS);
    bf16* op = (bf16*)(ws_ + WS_MRG) + (size_t)tok * DM + 512 + h * 128 + 4 * hi; const LAS float* gl = gains + 128 + 4 * hi;
    u32x2v w[16];
#pragma unroll
    for (int vb = 0; vb < 4; ++vb)
#pragma unroll
        for (int g = 0; g < 4; ++g) { const u32x2v gr = graw[vb * 4 + g]; const f32x4 gt = {__uint_as_float(gr.x << 16), __uint_as_float(gr.x & 0xffff0000u), __uint_as_float(gr.y << 16), __uint_as_float(gr.y & 0xffff0000u)};
            const f32x4 gn = *(const LAS f32x4*)(gl + vb * 32 + 8 * g);
            w[vb * 4 + g].x = cvtpk(acc[vb][4 * g] * rn * gn[0] * silu_fast(gt[0]), acc[vb][4 * g + 1] * rn * gn[1] * silu_fast(gt[1]));
            w[vb * 4 + g].y = cvtpk(acc[vb][4 * g + 2] * rn * gn[2] * silu_fast(gt[2]), acc[vb][4 * g + 3] * rn * gn[3] * silu_fast(gt[3])); }
#pragma unroll
    for (int vb = 0; vb < 4; ++vb)
#pragma unroll
        for (int g = 0; g < 4; ++g) *(u32x2v*)(op + vb * 32 + 8 * g) = w[vb * 4 + g];
}
__device__ __forceinline__ void phase_mix_o(const Ctx& c, int l, LAS unsigned char* lds, int bid, int nb) {
    OPQ_PTRS; (void)out_;
    LAS float* gains = (LAS float*)(lds + 135168);
    __syncthreads();
    if (threadIdx.x < 256) gains[threadIdx.x] = threadIdx.x < 128 ? kc_->in[I_GGLA][l * 128 + threadIdx.x] : kc_->in[I_GRET][l * 128 + threadIdx.x - 128];
    __syncthreads();
    const int tid = otid(), lane = tid & 63, wv = __builtin_amdgcn_readfirstlane(tid >> 6);
    constexpr int N_H = 128 * 4 * 2 + NSB * 4;
    const int nslots = nb * 8, s0 = bid * 8 + wv, ns = 1;
    for (int j = 0; ; ++j) { const int it = s0 + (ns == 2 ? (j & 1) + (j >> 1) * nslots : j * nslots); if (it >= 2 * N_H) break;
        const int r = it < N_H ? it : it - N_H; int ug, lh;
        if (r < 128 * 4 * 2) { ug = r >> 1; lh = r & 1; } else { ug = 128 * 4 + (r - 128 * 4 * 2); lh = 0; }
        if (it < N_H) item_ret_o(kc_, ws_, l, ug, lh, lane, gains); else item_gla_o(kc_, ws_, l, ug, lh, lane, gains);
    }
}

namespace fa {
typedef short bf16x8 __attribute__((ext_vector_type(8)));
typedef short s16x4 __attribute__((ext_vector_type(4)));
typedef float f32x16 __attribute__((ext_vector_type(16)));
typedef float f32x4 __attribute__((ext_vector_type(4)));
typedef unsigned u32x4 __attribute__((ext_vector_type(4)));
constexpr int D = 128, NW = 8, QBLK = 32, KVBLK = 64, QB = NW * QBLK;
constexpr int PQ = 1024;
constexpr int PO = 2048;
constexpr int SHM_V = KVBLK * D * 2, SHM_K = KVBLK * D * 2;
constexpr int OFF_WS = 2 * SHM_V + 2 * SHM_K;
constexpr int OFF_TAB = OFF_WS + NW * 64 * 4;
constexpr int LDS_NEED = OFF_TAB + 8192 * 4;
constexpr float SCALE = 0.08838834764831845f, THR = 16.f;
constexpr unsigned WBIG = 0x40000000u;

#define KSWZ(row, colB) ((row) * 256 + ((colB) ^ (((row) & 7) << 4)))
#define SBAR() __builtin_amdgcn_sched_barrier(0)
__device__ __forceinline__ int v_st(int k, int c) { const int kk = (k & ~0xC) | ((k & 4) << 1) | ((k & 8) >> 1); return ((kk >> 3) * 4 + (c >> 5)) * 512 + ((kk & 7) * 32 + (c & 31)) * 2; }
__device__ __forceinline__ int v_rd_base(int lane) { return ((lane & 3) << 3) | (((lane >> 2) & 3) << 6) | (((lane >> 4) & 1) << 5) | (((lane >> 5) & 1) << 8); }
constexpr int v_rd_off(int d0, int ks, int half) { return d0 * 512 + ks * 4096 + half * 2048; }
__device__ __forceinline__ int crow(int r, int hi) { return (r & 3) + 8 * (r >> 2) + 4 * hi; }
__device__ __forceinline__ unsigned cvtpk(float lo, float hi) { unsigned r; asm volatile("v_cvt_pk_bf16_f32 %0, %1, %2" : "=v"(r) : "v"(lo), "v"(hi)); return r; }
__device__ __forceinline__ bf16x8 load8(const bf16* p) { return *reinterpret_cast<const bf16x8*>(p); }
__device__ __forceinline__ void mask_tile(f32x16& p0, f32x16& p1, int dq, unsigned W) {
    const float NEG = -__builtin_inff();
#pragma unroll
    for (int r = 0; r < 16; ++r) {
        const int c = (r & 3) + 8 * (r >> 2);
        if ((unsigned)(dq - c) >= W) p0[r] = NEG;
        if ((unsigned)(dq - c - 32) >= W) p1[r] = NEG;
    }
}
__device__ __forceinline__ void partialSM(f32x16& p0, f32x16& p1, float& m_reg, float& mn, float& alpha) {
    float pmax = p0[0];
#pragma unroll
    for (int r = 1; r < 16; ++r) pmax = fmaxf(pmax, p0[r]);
#pragma unroll
    for (int r = 0; r < 16; ++r) pmax = fmaxf(pmax, p1[r]);
    { auto rr = __builtin_amdgcn_permlane32_swap(__float_as_uint(pmax), __float_as_uint(pmax), false, false);
      pmax = fmaxf(__uint_as_float(rr[0]), __uint_as_float(rr[1])); }
    constexpr float C2 = 1.4426950408889634f * SCALE;
    if (__builtin_expect(__all((pmax - m_reg) * SCALE <= THR), 1)) { mn = m_reg; alpha = 1.f; }
    else { mn = fmaxf(m_reg, pmax); alpha = __builtin_amdgcn_exp2f((m_reg - mn) * C2); m_reg = mn; }
    const float mnL = -mn * C2;
#pragma unroll
    for (int r = 0; r < 16; ++r) p0[r] = fmaf(p0[r], C2, mnL);
#pragma unroll
    for (int r = 0; r < 16; ++r) p1[r] = fmaf(p1[r], C2, mnL);
#pragma unroll
    for (int r = 0; r < 16; ++r) p0[r] = __builtin_amdgcn_exp2f(p0[r]);
}
__device__ __forceinline__ void finishSM(f32x16& p0, f32x16& p1, float alpha, float& l_reg, bf16x8& pa0, bf16x8& pa1, bf16x8& pa2, bf16x8& pa3) {
#pragma unroll
    for (int r = 0; r < 16; ++r) p1[r] = __builtin_amdgcn_exp2f(p1[r]);
    float ps = 0;
#pragma unroll
    for (int r = 0; r < 16; ++r) ps += p0[r];
#pragma unroll
    for (int r = 0; r < 16; ++r) ps += p1[r];
    { auto rr = __builtin_amdgcn_permlane32_swap(__float_as_uint(ps), __float_as_uint(ps), false, false);
      ps = __uint_as_float(rr[0]) + __uint_as_float(rr[1]); }
    l_reg = l_reg * alpha + ps;
#define PK4(P, B_, OUT) do { unsigned a0 = cvtpk(P[B_+0], P[B_+1]), a1 = cvtpk(P[B_+2], P[B_+3]);                          \
        unsigned b0 = cvtpk(P[B_+4], P[B_+5]), b1 = cvtpk(P[B_+6], P[B_+7]);                                             \
        auto r0 = __builtin_amdgcn_permlane32_swap(a0, b0, false, false); auto r1 = __builtin_amdgcn_permlane32_swap(a1, b1, false, false); \
        u32x4 w = {r0[0], r1[0], r0[1], r1[1]}; OUT = *reinterpret_cast<bf16x8*>(&w); } while (0)
    PK4(p0, 0, pa0); PK4(p0, 8, pa1); PK4(p1, 0, pa2); PK4(p1, 8, pa3);
#undef PK4
}
template <int KB>
__device__ __forceinline__ void qkt(f32x16& p0, f32x16& p1, const LAS char* K_lds, int r32, int hi, const bf16x8* qr, const LAS float* tb) {
    { const f32x4 a0 = *(const LAS f32x4*)(tb), a1 = *(const LAS f32x4*)(tb + 8), a2 = *(const LAS f32x4*)(tb + 16), a3 = *(const LAS f32x4*)(tb + 24);
      const f32x4 b0 = *(const LAS f32x4*)(tb + 32), b1 = *(const LAS f32x4*)(tb + 40), b2 = *(const LAS f32x4*)(tb + 48), b3 = *(const LAS f32x4*)(tb + 56);
      p0 = (f32x16){a0[0], a0[1], a0[2], a0[3], a1[0], a1[1], a1[2], a1[3], a2[0], a2[1], a2[2], a2[3], a3[0], a3[1], a3[2], a3[3]};
      p1 = (f32x16){b0[0], b0[1], b0[2], b0[3], b1[0], b1[1], b1[2], b1[3], b2[0], b2[1], b2[2], b2[3], b3[0], b3[1], b3[2], b3[3]}; }
    int kx = ((r32 >> 1) & 3) << 5; const int kb0 = r32 * 256 + ((hi * 16) ^ ((r32 & 1) << 4)); asm volatile("" : "+v"(kx));
#pragma unroll
    for (int d0 = 0; d0 < 8; ++d0) { const LAS char* a = K_lds + KB * SHM_K + (d0 >> 2) * 128 + kb0 + (((d0 & 3) * 32) ^ kx);
        bf16x8 b0 = *reinterpret_cast<const LAS bf16x8*>(a);
        bf16x8 b1 = *reinterpret_cast<const LAS bf16x8*>(a + 32 * 256);
        p0 = __builtin_amdgcn_mfma_f32_32x32x16_bf16(b0, qr[d0], p0, 0, 0, 0);
        p1 = __builtin_amdgcn_mfma_f32_32x32x16_bf16(b1, qr[d0], p1, 0, 0, 0); }
}
template <int VB>
__device__ __forceinline__ void pv_tile(f32x16* o, int vb0, bf16x8 pa0, bf16x8 pa1, bf16x8 pa2, bf16x8 pa3) {
#define TRRD(dst, off) asm volatile("ds_read_b64_tr_b16 %0, %1 offset:%2" : "=&v"(dst) : "v"(vb0), "i"(off) : "memory")
#define PV_D0(d0) do { s16x4 l0, l1, l2, l3, h0, h1, h2, h3; constexpr int b_ = VB * SHM_V + v_rd_off(d0, 0, 0);     \
        TRRD(l0, b_); TRRD(h0, b_ + 2048); TRRD(l1, b_ + 4096); TRRD(h1, b_ + 6144); TRRD(l2, b_ + 8192); TRRD(h2, b_ + 10240); TRRD(l3, b_ + 12288); TRRD(h3, b_ + 14336); \
        asm volatile("s_waitcnt lgkmcnt(0)" ::: "memory"); SBAR();                                                         \
        o[d0] = __builtin_amdgcn_mfma_f32_32x32x16_bf16(pa0, (bf16x8){l0[0], l0[1], l0[2], l0[3], h0[0], h0[1], h0[2], h0[3]}, o[d0], 0, 0, 0);   \
        o[d0] = __builtin_amdgcn_mfma_f32_32x32x16_bf16(pa1, (bf16x8){l1[0], l1[1], l1[2], l1[3], h1[0], h1[1], h1[2], h1[3]}, o[d0], 0, 0, 0);   \
        o[d0] = __builtin_amdgcn_mfma_f32_32x32x16_bf16(pa2, (bf16x8){l2[0], l2[1], l2[2], l2[3], h2[0], h2[1], h2[2], h2[3]}, o[d0], 0, 0, 0);   \
        o[d0] = __builtin_amdgcn_mfma_f32_32x32x16_bf16(pa3, (bf16x8){l3[0], l3[1], l3[2], l3[3], h3[0], h3[1], h3[2], h3[3]}, o[d0], 0, 0, 0); } while (0)
    PV_D0(0); PV_D0(1); PV_D0(2); PV_D0(3);
#undef PV_D0
#undef TRRD
}

struct BlockRef { const bf16* Q; const bf16* K; const bf16* V; bf16* O; float* part; int P0, j_lo, j_hi; };
constexpr int PART_FLOATS = 256 * 128 + 512;
struct Seam { bf16x8 qr[8]; bf16x8 st_v0, st_v1, st_k0, st_k1; };
__device__ __forceinline__ bf16x8 ld16(const bf16* base, unsigned off) { return *reinterpret_cast<const bf16x8*>((const char*)base + off); }
#define VMW() asm volatile("s_waitcnt vmcnt(0)" ::: "memory")
#define VMWN(n) asm volatile("s_waitcnt vmcnt(%0)" :: "i"(n) : "memory")
#define SLOAD_H(Kp, Vp, k0) do { S.st_v0 = ld16((Vp) + (size_t)(k0) * PQ, lo_kv); S.st_v1 = ld16((Vp) + (size_t)((k0) + 32) * PQ, lo_kv);              \
                         S.st_k0 = ld16((Kp) + (size_t)(k0) * PQ, lo_kv); S.st_k1 = ld16((Kp) + (size_t)((k0) + 32) * PQ, lo_kv); } while (0)
#define SWRITE_HK(bf) do { *(LAS bf16x8*)(K_lds + (bf) * SHM_K + kws) = S.st_k0; *(LAS bf16x8*)(K_lds + (bf) * SHM_K + kws + 32 * 256) = S.st_k1; } while (0)
#define SWRITE_HV(bf) do { *(LAS bf16x8*)(V_lds + (bf) * SHM_V + vst0) = S.st_v0; *(LAS bf16x8*)(V_lds + (bf) * SHM_V + vst0 + 8192) = S.st_v1; } while (0)
#define SWRITE_H(bf) do { SWRITE_HV(bf); SWRITE_HK(bf); } while (0)
__device__ __forceinline__ void prime(const BlockRef& cur, LAS char* lds, Seam& S, int tid) {
    const int wid = __builtin_amdgcn_readfirstlane(tid >> 6), lane = tid & 63, r32 = lane & 31, hi = lane >> 5;
    const int sr = tid >> 4, sc = (tid & 15) * 8, kws = KSWZ(sr, sc * 2); LAS char* K_lds = lds + 2 * SHM_V;
    const unsigned lo_kv = (unsigned)((sr * PQ + sc) * 2), lo_q = (unsigned)(((wid * QBLK + r32) * PQ + hi * 8) * 2);
    const int kb0 = cur.j_lo * KVBLK;
#pragma unroll
    for (int d0 = 0; d0 < 8; ++d0) S.qr[d0] = ld16(cur.Q + d0 * 16, lo_q);
    SLOAD_H(cur.K, cur.V, kb0); VMW(); SWRITE_HK(0);
    __syncthreads();
}
__device__ __forceinline__ void block(const BlockRef& cur, const BlockRef& nxt, LAS char* lds, Seam& S, const float* gout, int tid) {
    const int wid = __builtin_amdgcn_readfirstlane(tid >> 6), lane = tid & 63, r32 = lane & 31, hi = lane >> 5;
    const int j_lo = cur.j_lo, NT = cur.j_hi - cur.j_lo;
    const int kbn = nxt.j_lo * KVBLK;
    const int qlo = cur.P0 + wid * QBLK;
    LAS char* V_lds = lds; LAS char* K_lds = lds + 2 * SHM_V;
    LAS float* ws = (LAS float*)(lds + OFF_WS) + wid * 64; LAS float* li_l = ws; LAS float* al_l = ws + 32;
    const LAS float* tab = (const LAS float*)(lds + OFF_TAB) + 4 * hi;
    float m_reg = -1e30f, l_reg = 0; f32x16 o[4] = {};
    const int sr = tid >> 4, sc = (tid & 15) * 8, vst0 = v_st(sr, sc), kws = KSWZ(sr, sc * 2);
    const int vb0 = (int)(uintptr_t)V_lds + v_rd_base(lane);
    const unsigned lo_kv = (unsigned)((sr * PQ + sc) * 2);
    const bf16* Kh = cur.K; const bf16* Vh = cur.V;
#define RESC(a) do { if (__any((a) < 1.f)) { if (hi == 0) al_l[r32] = (a); asm volatile("s_waitcnt lgkmcnt(0)" ::: "memory");              \
                     for (int d_ = 0; d_ < 4; ++d_) for (int r = 0; r < 16; ++r) o[d_][r] *= al_l[crow(r, hi)]; } } while (0)
#define KBASE(t) ((j_lo + (t)) * KVBLK)
#define MASKT(P0_, P1_, t) do { const int kb_ = KBASE(t); if (kb_ + KVBLK - 1 > qlo) { const int t_ = otid(); mask_tile(P0_, P1_, qlo + (t_ & 31) - 4 * ((t_ >> 5) & 1) - kb_, WBIG); } } while (0)
    constexpr int NQL = 8;
#define SEAM_K0() do { VMWN(NQL); SWRITE_HK(0); SBAR(); } while (0)
    f32x16 pA0, pA1, pB0, pB1; float mnA, mnB, alA, alB; bf16x8 pa0, pa1, pa2, pa3;
    SWRITE_HV(0); SBAR();
    if (NT > 1) { SLOAD_H(Kh, Vh, KBASE(1)); }
    SBAR(); qkt<0>(pA0, pA1, K_lds, r32, hi, S.qr, tab + KBASE(0));
    MASKT(pA0, pA1, 0); partialSM(pA0, pA1, m_reg, mnA, alA);
    if (NT > 1) { VMW(); SWRITE_H(1); }
    __syncthreads();
#define HALF_STEP(PX0, PX1, mnX, alX, PY0, PY1, alY, t, KB, VB, SB) do {                                                      \
        SBAR(); qkt<KB>(PX0, PX1, K_lds, r32, hi, S.qr, tab + KBASE(t));                                                      \
        finishSM(PY0, PY1, alY, l_reg, pa0, pa1, pa2, pa3); SBAR();                                                           \
        if ((t) + 1 < NT) { SLOAD_H(Kh, Vh, KBASE((t) + 1)); SBAR(); }                                                        \
        pv_tile<VB>(o, vb0, pa0, pa1, pa2, pa3); MASKT(PX0, PX1, (t)); partialSM(PX0, PX1, m_reg, mnX, alX);                  \
        __syncthreads();                                                                                                      \
        if ((t) + 1 < NT) { VMW(); SWRITE_H(SB); }                                                                            \
        RESC(alX); __syncthreads(); } while (0)
    for (int t = 1; t + 1 < NT; t += 2) {
        HALF_STEP(pB0, pB1, mnB, alB, pA0, pA1, alA, t, 1, 0, 0);
        HALF_STEP(pA0, pA1, mnA, alA, pB0, pB1, alB, t + 1, 0, 1, 1);
    }
    const bool even = (NT & 1) == 0;
    if (even) { SBAR(); qkt<1>(pB0, pB1, K_lds, r32, hi, S.qr, tab + KBASE(NT - 1)); SBAR(); }
    SLOAD_H(nxt.K, nxt.V, kbn); SBAR();
    { const int t_ = otid(); const unsigned lo_q = (unsigned)((((t_ >> 6) * QBLK + (t_ & 31)) * PQ + ((t_ >> 5) & 1) * 8) * 2);
#pragma unroll
      for (int d0 = 0; d0 < 8; ++d0) S.qr[d0] = ld16(nxt.Q + d0 * 16, lo_q); }
    SBAR();
    finishSM(pA0, pA1, alA, l_reg, pa0, pa1, pa2, pa3); SBAR();
    pv_tile<0>(o, vb0, pa0, pa1, pa2, pa3);
    if (even) { MASKT(pB0, pB1, NT - 1); partialSM(pB0, pB1, m_reg, mnB, alB); __syncthreads(); RESC(alB);
        finishSM(pB0, pB1, alB, l_reg, pa0, pa1, pa2, pa3); SBAR(); pv_tile<1>(o, vb0, pa0, pa1, pa2, pa3); }
    SBAR(); SEAM_K0();
    const int te = otid(), r32e = te & 31, hie = (te >> 5) & 1;
    if (cur.part) {
        float* pb = cur.part; const unsigned lo_p = (unsigned)((((te >> 6) * QBLK + 4 * hie) * 128 + r32e) * 4);
#pragma unroll
        for (int r = 0; r < 16; ++r) { const float* prow = pb + ((r & 3) + 8 * (r >> 2)) * 128;
#pragma unroll
            for (int d0 = 0; d0 < 4; ++d0) *(float*)((char*)prow + d0 * 128 + lo_p) = o[d0][r]; }
        if (hie == 0) { pb[256 * 128 + (te >> 6) * QBLK + r32e] = m_reg; pb[256 * 128 + 256 + (te >> 6) * QBLK + r32e] = l_reg; }
    } else {
    LAS float* li_e = (LAS float*)(lds + OFF_WS) + (te >> 6) * 64;
    if (hie == 0) li_e[r32e] = l_reg; asm volatile("s_waitcnt lgkmcnt(0)" ::: "memory");
    float gv[4];
#pragma unroll
    for (int d0 = 0; d0 < 4; ++d0) gv[d0] = gout[d0 * 32 + r32e];
    const unsigned lo_o = (unsigned)((((te >> 6) * QBLK + 4 * hie) * PO + r32e) * 2);
#pragma unroll
    for (int r = 0; r < 16; ++r) { const float rl = __builtin_amdgcn_rcpf(li_e[crow(r, hie)]); float s = 0.f; float v[4];
#pragma unroll
        for (int d0 = 0; d0 < 4; ++d0) { v[d0] = o[d0][r] * rl; s += v[d0] * v[d0]; }
        s += __shfl_xor(s, 1); s += __shfl_xor(s, 2); s += __shfl_xor(s, 4); s += __shfl_xor(s, 8); s += __shfl_xor(s, 16);
        const float rn = rsqrtf(s * (1.f / 128.f) + EPS);
        const bf16* orow = cur.O + (size_t)((r & 3) + 8 * (r >> 2)) * PO;
#pragma unroll
        for (int d0 = 0; d0 < 4; ++d0) { const float y = v[d0] * rn * gv[d0]; const float yn = __shfl_xor(y, 1);
            if ((r32e & 1) == 0) *(unsigned*)((char*)orow + d0 * 64 + lo_o) = cvtpk(y, yn); } }
    }
    __syncthreads();
#undef RESC
#undef KBASE
#undef MASKT
#undef SEAM_K0
#undef HALF_STEP
}
#undef VMW
#undef VMWN
#undef SLOAD_H
#undef SWRITE_HK
#undef SWRITE_HV
#undef SWRITE_H
}
__device__ __forceinline__ fa::BlockRef fa_ref(const bf16* QB, const bf16* KB, const bf16* VB, bf16* MRG, int h, int qb) {
    fa::BlockRef r; const int P0 = qb * 256;
    r.Q = QB + (size_t)P0 * 1024 + h * 128; r.K = KB + h * 128; r.V = VB + h * 128; r.O = MRG + (size_t)P0 * DM + 1024 + h * 128; r.part = nullptr;
    r.P0 = P0; r.j_lo = 0; r.j_hi = P0 / 64 + 4; return r;
}
constexpr int FA_SPLIT = 70;
__device__ __forceinline__ void phase_fox_prompt_split(const Ctx& c, int l, LAS unsigned char* lds, int bid, int nb) {
    OPQ_PTRS; (void)out_;
    const int tid = otid();
    const bf16* QB = (const bf16*)(ws_ + WS_QB); const bf16* KB = (const bf16*)(ws_ + WS_KB); const bf16* VB = (const bf16*)(ws_ + WS_VB); bf16* MRG = (bf16*)(ws_ + WS_MRG);
    const float* CKP = (const float*)(ws_ + WS_CKP); const float* gout = kc_->in[I_GFO] + l * 128; float* FP = (float*)(ws_ + WS_FPART);
    LAS float* tabw = (LAS float*)(lds + fa::OFF_TAB);
    for (int w = bid; w < 256; w += nb) {
        const int h = w >> 5, x = (w >> 1) & 15, role = w & 1, hb = h * 16 + x;
        __syncthreads();
        for (int j = tid; j < TP; j += 512) tabw[j] = CKP[(size_t)h * TP + j] * (-1.f / fa::SCALE);
        const int full = (31 - x) * 4 + 4, cut = FA_SPLIT < full - 2 ? FA_SPLIT : full - 2;
        int qb_c = 31 - x, jl_c = role ? cut : 0, jh_c = role ? full : cut; float* pt_c = FP + (size_t)(hb * 2 + role) * fa::PART_FLOATS;
        fa::Seam S;
        { fa::BlockRef cur = fa_ref(QB, KB, VB, MRG, h, qb_c); cur.j_lo = jl_c; cur.j_hi = jh_c; cur.part = pt_c; fa::prime(cur, (LAS char*)lds, S, tid); }
        for (int i = 0; ; ++i) {
            const bool last = (role == 0) || (i == 1);
            const int qb_n = last ? qb_c : x, jl_n = last ? jl_c : 0, jh_n = last ? jh_c : x * 4 + 4; float* pt_n = last ? pt_c : nullptr;
            fa::BlockRef cur = fa_ref(QB, KB, VB, MRG, h, qb_c); cur.j_lo = jl_c; cur.j_hi = jh_c; cur.part = pt_c;
            fa::BlockRef nxt = fa_ref(QB, KB, VB, MRG, h, qb_n); nxt.j_lo = jl_n; nxt.j_hi = jh_n; nxt.part = pt_n;
            fa::block(cur, nxt, (LAS char*)lds, S, gout, tid);
            if (last) break;
            qb_c = qb_n; jl_c = jl_n; jh_c = jh_n; pt_c = pt_n;
        }
    }
}
__device__ __forceinline__ void phase_fox_merge(const Ctx& c, int l, int bid, int nb) {
    OPQ_PTRS; (void)out_;
    const int tid = otid(), lane = tid & 63;
    const float* FP = (const float*)(ws_ + WS_FPART); bf16* MRG = (bf16*)(ws_ + WS_MRG); const float* gout = kc_->in[I_GFO] + l * 128;
    constexpr float C2 = 1.4426950408889634f * fa::SCALE;
    const float g0 = gout[2 * lane], g1 = gout[2 * lane + 1];
    const int gw = bid * 8 + (tid >> 6), ngw = nb * 8;
    for (int R = gw; R < 128 * 256; R += ngw) {
        const int hb = R >> 8, row = R & 255, h = hb >> 4, x = hb & 15, tok = (31 - x) * 256 + row;
        const float* pa = FP + (size_t)(hb * 2) * fa::PART_FLOATS; const float* pb = pa + fa::PART_FLOATS;
        const float ma = pa[32768 + row], la = pa[32768 + 256 + row], mb = pb[32768 + row], lb = pb[32768 + 256 + row];
        const float M = fmaxf(ma, mb), fa_ = __builtin_amdgcn_exp2f((ma - M) * C2), fb_ = __builtin_amdgcn_exp2f((mb - M) * C2), il = 1.f / (fa_ * la + fb_ * lb);
        const float a0 = pa[row * 128 + 2 * lane], a1 = pa[row * 128 + 2 * lane + 1], b0 = pb[row * 128 + 2 * lane], b1 = pb[row * 128 + 2 * lane + 1];
        const float y0 = (fa_ * a0 + fb_ * b0) * il, y1 = (fa_ * a1 + fb_ * b1) * il;
        const float rn = rsqrtf(wave_sum(y0 * y0 + y1 * y1) * (1.f / 128.f) + EPS);
        *(unsigned*)(MRG + (size_t)tok * DM + 1024 + h * 128 + 2 * lane) = pk2(y0 * rn * g0, y1 * rn * g1);
    }
}
__device__ __forceinline__ fa::bf16x8 pack8f(const f32x4 a, const f32x4 b) { fa::u32x4 w = {mx::cvtpk(a[0], a[1]), mx::cvtpk(a[2], a[3]), mx::cvtpk(b[0], b[1]), mx::cvtpk(b[2], b[3])}; return *reinterpret_cast<fa::bf16x8*>(&w); }
__device__ __forceinline__ float ldf(const float* ubase, unsigned off) { return *(const float*)((const char*)ubase + off); }
__device__ __forceinline__ f32x4 ldf4(const float* ubase, unsigned off) { return *(const f32x4*)((const char*)ubase + off); }
constexpr int SPART_FLOATS = 32 * 128 + 64;
__device__ __forceinline__ void phase_fox_sample_half(const Ctx& c, int l, LAS unsigned char* lds, int bid, int nb) {
    OPQ_PTRS;
    using fa::f32x16; using fa::bf16x8;
    const int tid = otid(), lane = tid & 63, wid = __builtin_amdgcn_readfirstlane(tid >> 6), r32 = lane & 31, hi = lane >> 5;
    const bf16* QB = (const bf16*)(ws_ + WS_QB); const float* CKS = (const float*)(ws_ + WS_CKS); float* SP = (float*)(ws_ + WS_SPART);
    constexpr float C2 = 1.4426950408889634f * fa::SCALE;
    LAS float* Ol = (LAS float*)lds;
    LAS float* ml = (LAS float*)(lds + 131072);
    LAS float* al = (LAS float*)(lds + 131072 + 2048) + wid * 32;
    const unsigned kvo = (unsigned)((r32 * 1024 + hi * 8) * 4), vvo = (unsigned)((hi * 8 * 1024 + r32) * 4), cko = (unsigned)(hi * 16);
    for (int u2 = bid; u2 < NSB * 8 * 2; u2 += nb) {
        const int u = u2 >> 1, half = u2 & 1, b = u >> 3, h = u & 7, tok0 = TP + b * TS, tlo = half ? 17 : 0, thi = half ? 33 : 17;
        const float* Kc = kc_->in[I_CK] + ((size_t)l * NSB + b) * PAST * 1024 + h * 128; const float* Vc = kc_->in[I_CV] + ((size_t)l * NSB + b) * PAST * 1024 + h * 128;
        const float* Kn = out_ + O_FKS + ((size_t)l * MS + b * TS) * 1024 + h * 128; const float* Vn = out_ + O_FVS + ((size_t)l * MS + b * TS) * 1024 + h * 128;
        const float* ck = CKS + (size_t)u * (PAST + TS);
        const bf16* qrow = QB + (size_t)(tok0 + r32) * 1024 + h * 128 + hi * 8;
        float m_reg = -1e30f, l_reg = 0.f; f32x16 o[4] = {};
        __syncthreads();
        for (int t = tlo + wid; t < thi; t += 8) {
            const int j0 = t * 32;
            const float* Kt = t < 32 ? Kc + (size_t)j0 * 1024 : Kn; const float* Vt = t < 32 ? Vc + (size_t)j0 * 1024 : Vn; const float* ckt = ck + j0;
            f32x16 p = {};
            { f32x4 kraw[16]; bf16x8 qr[8];
#pragma unroll
              for (int d0 = 0; d0 < 8; ++d0) { kraw[2 * d0] = ldf4(Kt + d0 * 16, kvo); kraw[2 * d0 + 1] = ldf4(Kt + d0 * 16 + 4, kvo); qr[d0] = *(const bf16x8*)(qrow + d0 * 16); }
              asm volatile("" ::: "memory");
#pragma unroll
              for (int d0 = 0; d0 < 8; ++d0) p = __builtin_amdgcn_mfma_f32_32x32x16_bf16(pack8f(kraw[2 * d0], kraw[2 * d0 + 1]), qr[d0], p, 0, 0, 0); }
            f32x4 cb[4]; float v0[32], v1[32];
#pragma unroll
            for (int g = 0; g < 4; ++g) cb[g] = ldf4(ckt + 8 * g, cko);
#pragma unroll
            for (int d0 = 0; d0 < 4; ++d0)
#pragma unroll
                for (int jj = 0; jj < 8; ++jj) { v0[d0 * 8 + jj] = ldf(Vt + (size_t)jj * 1024 + d0 * 32, vvo); v1[d0 * 8 + jj] = ldf(Vt + (size_t)(16 + jj) * 1024 + d0 * 32, vvo); }
            asm volatile("" ::: "memory");
            { const float ns = -1.f / fa::SCALE;
#pragma unroll
              for (int r = 0; r < 16; ++r) p[r] += cb[r >> 2][r & 3] * ns; }
            if (t == 32) {
#pragma unroll
                for (int r = 0; r < 16; ++r) if (fa::crow(r, hi) > r32) p[r] = -__builtin_inff(); }
            float pmax = p[0];
#pragma unroll
            for (int r = 1; r < 16; ++r) pmax = fmaxf(pmax, p[r]);
            pmax = fmaxf(pmax, __shfl_xor(pmax, 32));
            const float mn = fmaxf(m_reg, pmax), alpha = __builtin_amdgcn_exp2f((m_reg - mn) * C2); m_reg = mn;
            float ps = 0.f;
#pragma unroll
            for (int r = 0; r < 16; ++r) { p[r] = __builtin_amdgcn_exp2f((p[r] - mn) * C2); ps += p[r]; }
            ps += __shfl_xor(ps, 32);
            l_reg = l_reg * alpha + ps;
            if (hi == 0) al[r32] = alpha; asm volatile("s_waitcnt lgkmcnt(0)" ::: "memory");
#pragma unroll
            for (int d = 0; d < 4; ++d)
#pragma unroll
                for (int r = 0; r < 16; ++r) o[d][r] *= al[fa::crow(r, hi)];
            bf16x8 pa0, pa1;
#define PK4(P, B_, OUT) do { unsigned a0 = mx::cvtpk(P[B_+0], P[B_+1]), a1 = mx::cvtpk(P[B_+2], P[B_+3]); unsigned b0 = mx::cvtpk(P[B_+4], P[B_+5]), b1 = mx::cvtpk(P[B_+6], P[B_+7]); \
        auto r0 = __builtin_amdgcn_permlane32_swap(a0, b0, false, false); auto r1 = __builtin_amdgcn_permlane32_swap(a1, b1, false, false); \
        fa::u32x4 w = {r0[0], r1[0], r0[1], r1[1]}; OUT = *reinterpret_cast<bf16x8*>(&w); } while (0)
            PK4(p, 0, pa0); PK4(p, 8, pa1);
#undef PK4
#pragma unroll
            for (int d0 = 0; d0 < 4; ++d0) o[d0] = __builtin_amdgcn_mfma_f32_32x32x16_bf16(pa0, pack8f((f32x4){v0[d0 * 8], v0[d0 * 8 + 1], v0[d0 * 8 + 2], v0[d0 * 8 + 3]}, (f32x4){v0[d0 * 8 + 4], v0[d0 * 8 + 5], v0[d0 * 8 + 6], v0[d0 * 8 + 7]}), o[d0], 0, 0, 0);
#pragma unroll
            for (int d0 = 0; d0 < 4; ++d0) o[d0] = __builtin_amdgcn_mfma_f32_32x32x16_bf16(pa1, pack8f((f32x4){v1[d0 * 8], v1[d0 * 8 + 1], v1[d0 * 8 + 2], v1[d0 * 8 + 3]}, (f32x4){v1[d0 * 8 + 4], v1[d0 * 8 + 5], v1[d0 * 8 + 6], v1[d0 * 8 + 7]}), o[d0], 0, 0, 0);
        }
        if (hi == 0) { ml[wid * 32 + r32] = m_reg; ml[256 + wid * 32 + r32] = l_reg; }
#pragma unroll
        for (int d0 = 0; d0 < 4; ++d0)
#pragma unroll
            for (int r = 0; r < 16; ++r) Ol[(wid * 32 + fa::crow(r, hi)) * 128 + d0 * 32 + r32] = o[d0][r];
        __syncthreads();
        { const int row = tid >> 4, c0 = (tid & 15) * 8; float M = -1e30f;
#pragma unroll
          for (int w = 0; w < 8; ++w) M = fmaxf(M, ml[w * 32 + row]);
          float L = 0.f, acc[8];
#pragma unroll
          for (int i = 0; i < 8; ++i) acc[i] = 0.f;
#pragma unroll
          for (int w = 0; w < 8; ++w) { const float f = __builtin_amdgcn_exp2f((ml[w * 32 + row] - M) * C2); L += f * ml[256 + w * 32 + row];
              const f32x4 x0 = *(const LAS f32x4*)(Ol + (w * 32 + row) * 128 + c0), x1 = *(const LAS f32x4*)(Ol + (w * 32 + row) * 128 + c0 + 4);
              acc[0] += f * x0[0]; acc[1] += f * x0[1]; acc[2] += f * x0[2]; acc[3] += f * x0[3]; acc[4] += f * x1[0]; acc[5] += f * x1[1]; acc[6] += f * x1[2]; acc[7] += f * x1[3]; }
          float* pp = SP + (size_t)u2 * SPART_FLOATS;
          *(f32x4*)(pp + row * 128 + c0) = (f32x4){acc[0], acc[1], acc[2], acc[3]}; *(f32x4*)(pp + row * 128 + c0 + 4) = (f32x4){acc[4], acc[5], acc[6], acc[7]};
          if ((tid & 15) == 0) { pp[32 * 128 + row] = M; pp[32 * 128 + 32 + row] = L; } }
    }
}
__device__ __forceinline__ void phase_fox_sample_merge(const Ctx& c, int l, int bid, int nb) {
    OPQ_PTRS; (void)out_;
    const int tid = otid(), lane = tid & 63, gw = bid * 8 + (tid >> 6), ngw = nb * 8;
    const float* SP = (const float*)(ws_ + WS_SPART); bf16* MRG = (bf16*)(ws_ + WS_MRG); const float* gout = kc_->in[I_GFO] + l * 128;
    constexpr float C2 = 1.4426950408889634f * fa::SCALE;
    const float g0 = gout[2 * lane], g1 = gout[2 * lane + 1];
    for (int R = gw; R < NSB * 8 * 32; R += ngw) {
        const int u = R >> 5, row = R & 31, b = u >> 3, h = u & 7, tok = TP + b * TS + row;
        const float* pa = SP + (size_t)(2 * u) * SPART_FLOATS; const float* pb = pa + SPART_FLOATS;
        const float ma = pa[4096 + row], la = pa[4096 + 32 + row], mb = pb[4096 + row], lb = pb[4096 + 32 + row];
        const float M = fmaxf(ma, mb), fa_ = __builtin_amdgcn_exp2f((ma - M) * C2), fb_ = __builtin_amdgcn_exp2f((mb - M) * C2), il = 1.f / (fa_ * la + fb_ * lb);
        const float a0 = pa[row * 128 + 2 * lane], a1 = pa[row * 128 + 2 * lane + 1], b0 = pb[row * 128 + 2 * lane], b1 = pb[row * 128 + 2 * lane + 1];
        const float y0 = (fa_ * a0 + fb_ * b0) * il, y1 = (fa_ * a1 + fb_ * b1) * il;
        const float rn = rsqrtf(wave_sum(y0 * y0 + y1 * y1) * (1.f / 128.f) + EPS);
        *(unsigned*)(MRG + (size_t)tok * DM + 1024 + h * 128 + 2 * lane) = pk2(y0 * rn * g0, y1 * rn * g1);
    }
}
#define XB_TMO      128
#define XB_XCNT(j)  (256  + 64 * (j))
#define XB_XSUB(j)  (1280 + 64 * (j))
#define XB_XGEN(j)  (2304 + 64 * (j))
#define XB_TOP      3328
#define XB_TOPGEN   3392
#define XCD_BAR_WORDS 3456
#define XB_SPIN_CAP (1u << 18)

__device__ __forceinline__ unsigned xb_ld(unsigned* p)              { return __hip_atomic_load(p, __ATOMIC_RELAXED, __HIP_MEMORY_SCOPE_AGENT); }
__device__ __forceinline__ unsigned xb_add(unsigned* p, unsigned v) { return __hip_atomic_fetch_add(p, v, __ATOMIC_RELAXED, __HIP_MEMORY_SCOPE_AGENT); }
__device__ __forceinline__ unsigned xb_xcc_id() { return (unsigned)__builtin_amdgcn_s_getreg((3 << 11) | 20) & 0xFu; }
#define XB_SPIN(cond, bar) do { unsigned _sp = 0; while (cond) { __builtin_amdgcn_s_sleep(1); \
    if ((++_sp & 255u) == 0u) { if (xb_ld(&(bar)[XB_TMO])) break; if (_sp > XB_SPIN_CAP) { atomicAdd(&(bar)[XB_TMO], 1u); break; } } } } while (0)

struct XcdBarrier {
    unsigned* bar; unsigned x;
    volatile LAS unsigned* st;
};

__device__ __forceinline__ XcdBarrier xcd_barrier_post(unsigned* bar, volatile LAS unsigned* st) {
    XcdBarrier b; b.bar = bar; b.x = xb_xcc_id(); b.st = st;
    if (threadIdx.x == 0) (void)xb_add(&bar[XB_XCNT(b.x)], 1u);
    return b;
}
__device__ __forceinline__ void xcd_barrier_complete(unsigned* bar, unsigned x, unsigned& nloc, unsigned& nx) {
    const unsigned G = gridDim.x * gridDim.y * gridDim.z;
    unsigned sum, cnt, mine, sp = 0u;
    for (;;) {
        sum = 0u; cnt = 0u; mine = 0u;
#pragma unroll
        for (unsigned j = 0; j < 16; ++j) { const unsigned c = xb_ld(&bar[XB_XCNT(j)]); sum += c; cnt += (c > 0u) ? 1u : 0u; mine = (j == x) ? c : mine; }
        if (sum == G) break;
        __builtin_amdgcn_s_sleep(1);
        if ((++sp & 255u) == 0u) { if (xb_ld(&bar[XB_TMO])) break; if (sp > XB_SPIN_CAP) { atomicAdd(&bar[XB_TMO], 1u); break; } }
    }
    nloc = mine > 0u ? mine : 1u; nx = cnt > 0u ? cnt : 1u;
}

__device__ __forceinline__ void xcd_barrier(const XcdBarrier& b) {
    asm volatile("s_waitcnt vmcnt(0)" ::: "memory");
    __syncthreads();
    if (threadIdx.x == 0) {
        unsigned* bar = b.bar;
        __builtin_amdgcn_s_waitcnt(0);
        unsigned nloc = b.st[0], nx = b.st[1];
        if (nloc == 0u) { xcd_barrier_complete(bar, b.x, nloc, nx); b.st[0] = nloc; b.st[1] = nx; }
        const unsigned old = xb_add(&bar[XB_XSUB(b.x)], 1u);
        const unsigned gen = old / nloc;
        if (old + 1u == (gen + 1u) * nloc) {
            __builtin_amdgcn_fence(__ATOMIC_RELEASE, "agent");
            asm volatile("s_waitcnt vmcnt(0)" ::: "memory");
            const unsigned og = xb_add(&bar[XB_TOP], 1u);
            const unsigned tg = og / nx;
            if (og + 1u == (tg + 1u) * nx) xb_add(&bar[XB_TOPGEN], 1u);
            else XB_SPIN(xb_ld(&bar[XB_TOPGEN]) == tg, bar);
            __builtin_amdgcn_fence(__ATOMIC_ACQUIRE, "agent");
            xb_add(&bar[XB_XGEN(b.x)], 1u);
            asm volatile("s_waitcnt vmcnt(0)" ::: "memory");
        } else {
            XB_SPIN(xb_ld(&bar[XB_XGEN(b.x)]) == gen, bar);
            __builtin_amdgcn_fence(__ATOMIC_ACQUIRE, "agent");
            asm volatile("s_waitcnt vmcnt(0)" ::: "memory");
        }
    }
    __syncthreads();
}

constexpr int LDS_BYTES = 147456;
constexpr int MISC_OFF = LDS_BYTES - 256;
constexpr int CW_BAR = 4096;
constexpr size_t CTL_ZERO_BYTES = 1u << 20;

template <int l>
__device__ __forceinline__ void layer_body(const Ctx& c, LAS unsigned char* lds, const XcdBarrier& bar, int bid, int nb) {
    OPQ_PTRS; bf16* XN = (bf16*)(ws_ + WS_XN);
        { pg8::Gemm g{XN, (const bf16*)(ws_ + WS_WIN + l * SZ_WIN), MT, DINP, DM, DM}; pg8::StaticOrder S; S.init(MT, DINP, nb, bid); S.mix27 = true;
          pg8::EpiIn E{(bf16*)(ws_ + WS_PROJ), PBP, (float*)(ws_ + WS_SIDE), (bf16*)(ws_ + WS_QB), (bf16*)(ws_ + WS_KB), (bf16*)(ws_ + WS_VB),
                       out_ + O_FKP + (size_t)l * TP * 1024, out_ + O_FKS + (size_t)l * MS * 1024, out_ + O_FVP + (size_t)l * TP * 1024, out_ + O_FVS + (size_t)l * MS * 1024,
                       kc_->in[I_GFQ] + l * 128, kc_->in[I_GFK] + l * 128, (PG8_LAS float*)(lds + 131072), TP, EPS,
                       pg8::RowScale{(const float*)(ws_ + WS_SSP) + (size_t)(2 * l) * MT * 8, 1.f / DM, EPS, (PG8_LAS float*)(lds + 143360)}};
          pg8::gemm_phase<pg8::EpiIn, pg8::StaticOrder, true, true, false, true>(lds, g, S, E); }
        constexpr int NU_IN = (MT / 256) * (DINP / 256);
        constexpr int I_P1 = (DM / 64) * (DM / 32) + (DM / 64) * (2 * DFF / 32) + (DFF / 64) * (DM / 32);
        const int f_idle = NU_IN % nb, n_idle = f_idle ? nb - f_idle : 0, x_head = n_idle * 80 < I_P1 ? n_idle * 80 : I_P1;
        if (n_idle && bid >= f_idle) { __syncthreads(); phase_convert(c, l, lds, bid - f_idle, n_idle, 1, 0, x_head); __syncthreads(); }
        xcd_barrier(bar);
        phase_fox_cumsum2(c, l, lds, bid, nb); phase_mix_u(c, l, bid, nb);
        xcd_barrier(bar);
        phase_scans(c, l, bid, nb);
        if (bid & 1) { __syncthreads(); phase_convert(c, l, lds, bid, nb, 1, x_head); if (l + 1 < NL) phase_convert(c, l + 1, lds, bid, nb, 0); __syncthreads(); phase_fox_sample_half(c, l, lds, bid, nb); }
        phase_fox_prompt_split(c, l, lds, bid, nb);
        if (!(bid & 1)) { phase_fox_sample_half(c, l, lds, bid, nb); __syncthreads(); phase_convert(c, l, lds, bid, nb, 1, x_head); if (l + 1 < NL) phase_convert(c, l + 1, lds, bid, nb, 0); __syncthreads(); }
        xcd_barrier(bar);
        phase_fox_sample_merge(c, l, bid, nb); phase_fox_merge(c, l, bid, nb); phase_mix_o(c, l, lds, bid, nb);
        xcd_barrier(bar);
        { pg8::Gemm g{(const bf16*)(ws_ + WS_MRG), (const bf16*)(ws_ + WS_WOUT + l * SZ_WOUT), TP, DM, DM, DM, (const bf16*)(ws_ + WS_MRG) + (size_t)TP * DM}; pg8::StaticOrder S; S.init(TP, DM, nb, bid);
          typedef pg8::EpiResT<(l > 0), false> ER;
          ER E{kc_->in[I_XP], kc_->in[I_XS], TP, nullptr, DM, XN, (float*)(ws_ + WS_SSP) + (size_t)(2 * l + 1) * MT * 8, (PG8_LAS float*)(lds + 131072), XN}; pg8::gemm_phase<ER, pg8::StaticOrder, true, true, true>(lds, g, S, E); }
        xcd_barrier(bar);
        { pg8::Gemm g{XN, (const bf16*)(ws_ + WS_WGU + l * SZ_WGU), MT, 2 * DFF, DM, DM}; pg8::StaticOrder S; S.init(MT, 2 * DFF, nb, bid);
          pg8::EpiSwiGLU E{(bf16*)(ws_ + WS_ACT), DFF, pg8::RowScale{(const float*)(ws_ + WS_SSP) + (size_t)(2 * l + 1) * MT * 8, 1.f / DM, EPS, (PG8_LAS float*)(lds + 143360)}}; pg8::gemm_phase<pg8::EpiSwiGLU, pg8::StaticOrder, true, true, false, true>(lds, g, S, E); }
        xcd_barrier(bar);
        { float* dst = l == NL - 1 ? out_ + O_YP : nullptr;
          pg8::Gemm g{(const bf16*)(ws_ + WS_ACT), (const bf16*)(ws_ + WS_WDN + l * SZ_WDN), TP, DM, DFF, DFF, (const bf16*)(ws_ + WS_ACT) + (size_t)TP * DFF}; pg8::StaticOrder S; S.init(TP, DM, nb, bid);
          typedef pg8::EpiResT<true, (l == NL - 1)> ER;
          ER E{nullptr, nullptr, TP, dst, DM, l == NL - 1 ? nullptr : XN, (float*)(ws_ + WS_SSP) + (size_t)(2 * l + 2) * MT * 8, (PG8_LAS float*)(lds + 131072), XN}; pg8::gemm_phase<ER, pg8::StaticOrder, true, true, true>(lds, g, S, E); }
        if (l + 1 < NL) xcd_barrier(bar);
}

__global__ void __launch_bounds__(512, 2) fwd_mega(const Ctx c) {
    extern __shared__ __attribute__((aligned(16))) unsigned char shm[];
    LAS unsigned char* lds = (LAS unsigned char*)shm;
    const int bid = blockIdx.x, nb = gridDim.x;
    for (int u = threadIdx.x; u < (LDS_BYTES - MISC_OFF) / 4; u += 512) ((LAS unsigned*)(lds + MISC_OFF))[u] = 0u;
    __syncthreads();
    XcdBarrier bar = xcd_barrier_post((unsigned*)(kctx()->ws + WS_CTL) + CW_BAR, (volatile LAS unsigned*)(lds + MISC_OFF) + 8);
    phase_convert(c, 0, lds, bid, nb, 0);
    { OPQ_PTRS; (void)out_; phase_rope_tables((float*)(ws_ + WS_TABC), (float*)(ws_ + WS_TABS), bid, nb); }
    { OPQ_PTRS; phase_x_to_bf16(kc_->in[I_XP], kc_->in[I_XS], (bf16*)(ws_ + WS_XN), (float*)(ws_ + WS_SSP), bid, nb); (void)out_; }
    xcd_barrier(bar);
    layer_body<0>(c, lds, bar, bid, nb); layer_body<1>(c, lds, bar, bid, nb); layer_body<2>(c, lds, bar, bid, nb); layer_body<3>(c, lds, bar, bid, nb);
}

extern "C" void kernel_launch(void* const* d_in, const int* in_sizes, int n_in, void* d_out, int out_size, void* d_ws, size_t ws_size, hipStream_t stream) {
    if (n_in != N_IN || (size_t)out_size != O_END || ws_size < WS_END) { fprintf(stderr, "kernel_launch: unexpected shapes (n_in %d out %d ws %zu, need %zu)\n", n_in, out_size, ws_size, (size_t)WS_END); return; }
    Ctx c{}; for (int i = 0; i < N_IN; ++i) c.in[i] = (const float*)d_in[i]; c.out = (float*)d_out; c.ws = (unsigned char*)d_ws;
    int dev = 0, cus = 0, per_cu = 0;
    if (hipGetDevice(&dev) != hipSuccess || hipDeviceGetAttribute(&cus, hipDeviceAttributeMultiprocessorCount, dev) != hipSuccess || cus <= 0) { fprintf(stderr, "kernel_launch: device query failed\n"); return; }
    if (hipFuncSetAttribute((const void*)fwd_mega, hipFuncAttributeMaxDynamicSharedMemorySize, LDS_BYTES) != hipSuccess) { fprintf(stderr, "kernel_launch: hipFuncSetAttribute failed\n"); return; }
    if (hipOccupancyMaxActiveBlocksPerMultiprocessor(&per_cu, (const void*)fwd_mega, 512, LDS_BYTES) != hipSuccess || per_cu < 1) { fprintf(stderr, "kernel_launch: occupancy query says %d blocks per CU\n", per_cu); (void)hipGetLastError(); per_cu = 1; }
    const int grid = cus;
    (void)hipMemsetAsync((char*)d_ws + WS_CTL, 0, CTL_ZERO_BYTES, stream);
    hipLaunchKernelGGL(fwd_mega, dim3(grid), dim3(512), LDS_BYTES, stream, c);
}
```

```cpp
#include <hip/hip_runtime.h>
#include <cstdio>
#include <cstdint>
namespace pg8 {
#define PG8_LAS __attribute__((address_space(3)))
typedef unsigned short bf16_t;
typedef short bf16x8 __attribute__((ext_vector_type(8)));
typedef float f32x4 __attribute__((ext_vector_type(4)));
typedef unsigned u32x4 __attribute__((ext_vector_type(4)));
constexpr int BM = 256, BK = 64, HALF = 128, HTB = HALF * BK * 2  , STAGE_BYTES = 8 * HTB, NXCD = 8, WGM = 4;

__host__ __device__ __forceinline__ int lds_byte(int r, int c) { const int st = (r >> 4) * 2 + (c >> 5), rr = r & 15, cc = c & 31, ob = rr * 64 + cc * 2; return st * 1024 + (ob ^ (((ob >> 9) & 1) << 5)); }
__host__ __device__ __forceinline__ void stage_rc(int b, int& R, int& C) { const int st = b / 1024, sb = b % 1024, swz = sb ^ (((sb >> 9) & 1) << 5); R = (st >> 1) * 16 + swz / 64; C = (st & 1) * 32 + (swz % 64) / 2; }
__host__ __device__ __forceinline__ int perm32(int rho) { const int n = rho >> 4, i = rho & 15; return 8 * (i >> 2) + 4 * n + (i & 3); }

struct Unit { int pm, pn, ko; };
struct Gemm { const bf16_t* A; const bf16_t* Bt; int M, N, K, KL; const bf16_t* As = nullptr; };

struct StaticOrder {
    int nM, nN, nwg, G, c; bool mix27 = false;
    __host__ __device__ void init(int M, int N, int G_, int c_) { nM = M / BM; nN = N / BM; nwg = nM * nN; G = G_; c = c_; }
    __host__ __device__ bool next(int i, Unit& u) const {
        const long L = (long)i * G + c; if (L >= nwg) return false;
        int wgid = (int)L; { const int q = nwg / NXCD, r = nwg % NXCD, xcd = wgid % NXCD, off = wgid / NXCD; wgid = (xcd < r ? xcd * (q + 1) : r * (q + 1) + (xcd - r) * q) + off; }
        const int nig = WGM * nN, gid = wgid / nig, fm = gid * WGM, gsz = (nM - fm) < WGM ? (nM - fm) : WGM;
        u.pm = fm + ((wgid % nig) % gsz); u.pn = (wgid % nig) / gsz; u.ko = 0;
        if (mix27) { const unsigned long long lo = 0x110310020f010e00ull, mi = 0x0814071306120504ull, hi = 0x180c170b160a0915ull, tp = 0x1a190dull;
            const int q = u.pn >> 3, s = (u.pn & 7) * 8; u.pn = (int)(((q == 0 ? lo : q == 1 ? mi : q == 2 ? hi : tp) >> s) & 0xff); }
        return true;
    }
    __device__ __forceinline__ void a_ready(const Unit&) const {}
    __device__ __forceinline__ void done(const Unit&) const {}
};

__device__ __forceinline__ unsigned cvt_pk_bf16(float lo, float hi) { unsigned r; asm volatile("v_cvt_pk_bf16_f32 %0, %1, %2" : "=v"(r) : "v"(lo), "v"(hi)); return r; }
typedef float f32x2 __attribute__((ext_vector_type(2)));
template <bool RB, bool OF>
struct EpiResT {
    static constexpr bool PERM = false, AFTER_DRAIN = false;
    typedef unsigned u32x2 __attribute__((ext_vector_type(2)));
    const float* base0; const float* base1; int split; float* out; int ldc; bf16_t* hb; float* ssp; PG8_LAS float* X; const bf16_t* rb;
    static __device__ __forceinline__ f32x4 unpack(const u32x2 w) { f32x4 r; r[0] = __uint_as_float(w.x << 16); r[1] = __uint_as_float(w.x & 0xffff0000u); r[2] = __uint_as_float(w.y << 16); r[3] = __uint_as_float(w.y & 0xffff0000u); return r; }
    __device__ __forceinline__ void operator()(const f32x4 (&acc)[2][2][4][2], const Unit& u, int wr, int wc, int fr_in, int fq_in) const {
        int fr = fr_in, fq = fq_in; asm volatile("" : "+v"(fr), "+v"(fq));
        const int row0 = u.pm * BM + wr * 64 + fr, col0 = u.pn * BM + wc * 32 + 4 * fq;
#pragma unroll
        for (int ai = 0; ai < 2; ++ai) {
            f32x4 bs[4][2][2]; u32x2 bw[4][2][2];
#pragma unroll
            for (int m = 0; m < 4; ++m) { const int row = row0 + ai * HALF + m * 16;
                if constexpr (RB) { const bf16_t* bp = rb + (size_t)row * ldc + col0;
#pragma unroll
                    for (int bj = 0; bj < 2; ++bj)
#pragma unroll
                        for (int n = 0; n < 2; ++n) bw[m][bj][n] = *(const u32x2*)(bp + bj * HALF + n * 16);
                } else { const float* bp = (row < split ? base0 + (size_t)row * ldc : base1 + (size_t)(row - split) * ldc) + col0;
#pragma unroll
                    for (int bj = 0; bj < 2; ++bj)
#pragma unroll
                        for (int n = 0; n < 2; ++n) bs[m][bj][n] = *(const f32x4*)(bp + bj * HALF + n * 16); } }
            asm volatile("" ::: "memory");
#pragma unroll
            for (int m = 0; m < 4; ++m) { const int row = row0 + ai * HALF + m * 16; float s = 0.f;
#pragma unroll
                for (int bj = 0; bj < 2; ++bj)
#pragma unroll
                    for (int n = 0; n < 2; ++n) { f32x4 r; if constexpr (RB) r = unpack(bw[m][bj][n]); else r = bs[m][bj][n];
                        const f32x4 v = acc[ai][bj][m][n] + r;
                        if constexpr (OF) *(f32x4*)(out + (size_t)row * ldc + col0 + bj * HALF + n * 16) = v;
                        if (hb) { u32x2 w; w.x = cvt_pk_bf16(v[0], v[1]); w.y = cvt_pk_bf16(v[2], v[3]);
                            *(u32x2*)(hb + (size_t)row * ldc + col0 + bj * HALF + n * 16) = w; s += (v[0] * v[0] + v[1] * v[1]) + (v[2] * v[2] + v[3] * v[3]); } }
                if (hb) { s += __shfl_xor(s, 16); s += __shfl_xor(s, 32); if (fq == 0) X[(ai * HALF + wr * 64 + m * 16 + fr) * 4 + wc] = s; } }
            asm volatile("" ::: "memory");
        }
    }
    __device__ __forceinline__ void strip(const f32x4 (&accS)[2], const Unit& u, int wr, int wc, int fr_in, int fq_in) const {
        int fr = fr_in, fq = fq_in; asm volatile("" : "+v"(fr), "+v"(fq));
        const int rs = u.pm * 16 + fr, col0 = u.pn * BM + wr * HALF + wc * 32 + 4 * fq; float s = 0.f;
        f32x4 r[2];
        if constexpr (RB) { u32x2 bw[2];
#pragma unroll
            for (int n = 0; n < 2; ++n) bw[n] = *(const u32x2*)(rb + (size_t)(split + rs) * ldc + col0 + n * 16);
            asm volatile("" ::: "memory");
            r[0] = unpack(bw[0]); r[1] = unpack(bw[1]);
        } else {
#pragma unroll
            for (int n = 0; n < 2; ++n) r[n] = *(const f32x4*)(base1 + (size_t)rs * ldc + col0 + n * 16);
            asm volatile("" ::: "memory"); }
#pragma unroll
        for (int n = 0; n < 2; ++n) { const f32x4 v = accS[n] + r[n];
            if constexpr (OF) *(f32x4*)(out + (size_t)(split + rs) * ldc + col0 + n * 16) = v;
            if (hb) { u32x2 w; w.x = cvt_pk_bf16(v[0], v[1]); w.y = cvt_pk_bf16(v[2], v[3]);
                *(u32x2*)(hb + (size_t)(split + rs) * ldc + col0 + n * 16) = w; s += (v[0] * v[0] + v[1] * v[1]) + (v[2] * v[2] + v[3] * v[3]); } }
        if (hb) {
            s += __shfl_xor(s, 16); s += __shfl_xor(s, 32); if (fq == 0) X[1024 + fr * 8 + wr * 4 + wc] = s;
            asm volatile("s_waitcnt lgkmcnt(0)" ::: "memory"); __builtin_amdgcn_s_barrier(); asm volatile("" ::: "memory");
            const int t = (wr * 4 + wc) * 64 + fq * 16 + fr;
            if (t < 256) { const f32x4 a = *(const PG8_LAS f32x4*)(X + t * 4); ssp[(size_t)(u.pm * BM + t) * 8 + u.pn] = (a[0] + a[1]) + (a[2] + a[3]); }
            else if (t < 272) { const int r2 = t - 256; const f32x4 a = *(const PG8_LAS f32x4*)(X + 1024 + r2 * 8), b = *(const PG8_LAS f32x4*)(X + 1024 + r2 * 8 + 4);
                ssp[(size_t)(split + u.pm * 16 + r2) * 8 + u.pn] = ((a[0] + a[1]) + (a[2] + a[3])) + ((b[0] + b[1]) + (b[2] + b[3])); }
        }
    }
};
__device__ __forceinline__ float silu_mul(float g, float u) { return g * u * __builtin_amdgcn_rcpf(1.0f + __builtin_amdgcn_exp2f(-1.4426950408889634f * g)); }

struct RowScale {
    const float* ssp; float inv_n, eps; PG8_LAS float* RT;
    __device__ __forceinline__ void load(const Unit& u, int tid, f32x4& a, f32x4& b) const { if (tid < 256) { const float* sp = ssp + (size_t)(u.pm * BM + tid) * 8; a = *(const f32x4*)sp; b = *(const f32x4*)(sp + 4); } }
    __device__ __forceinline__ void publish(int tid, const f32x4& a, const f32x4& b) const {
        if (tid < 256) RT[tid] = rsqrtf((((a[0] + a[1]) + (a[2] + a[3])) + ((b[0] + b[1]) + (b[2] + b[3]))) * inv_n + eps);
        asm volatile("s_waitcnt lgkmcnt(0)" ::: "memory"); __builtin_amdgcn_s_barrier(); asm volatile("" ::: "memory"); }
};
struct EpiSwiGLU {
    static constexpr bool PERM = true, AFTER_DRAIN = false;
    bf16_t* O; int ldc; RowScale rs;
    __device__ __forceinline__ void operator()(const f32x4 (&acc)[2][2][4][2], const Unit& u, int wr, int wc, int fr_in, int fq_in) const {
        int fr = fr_in, fq = fq_in; asm volatile("" : "+v"(fr), "+v"(fq));
        const int row0 = u.pm * BM + wr * 64 + fr, col0 = u.pn * HALF + wc * 32 + 8 * fq;
#pragma unroll
        for (int ai = 0; ai < 2; ++ai)
#pragma unroll
            for (int m = 0; m < 4; ++m) { const int row = row0 + ai * HALF + m * 16; const float r = rs.RT[ai * HALF + wr * 64 + m * 16 + fr]; bf16_t* rowp = O + (size_t)row * ldc + col0;
                const f32x4 g0 = acc[ai][0][m][0] * r, g1 = acc[ai][0][m][1] * r, u0 = acc[ai][1][m][0] * r, u1 = acc[ai][1][m][1] * r;
                u32x4 w; w.x = cvt_pk_bf16(silu_mul(g0[0], u0[0]), silu_mul(g0[1], u0[1])); w.y = cvt_pk_bf16(silu_mul(g0[2], u0[2]), silu_mul(g0[3], u0[3]));
                w.z = cvt_pk_bf16(silu_mul(g1[0], u1[0]), silu_mul(g1[1], u1[1])); w.w = cvt_pk_bf16(silu_mul(g1[2], u1[2]), silu_mul(g1[3], u1[3]));
                *(u32x4*)rowp = w; }
    }
};


struct EpiIn {
    static constexpr bool PERM = true, AFTER_DRAIN = false;
    bf16_t* P; int ldp; float* side; bf16_t* QB; bf16_t* KB; bf16_t* VB; float* fk_p; float* fk_s; float* fv_p; float* fv_s; const float* gq; const float* gk; PG8_LAS float* X; int split; float eps; RowScale rs;
    __device__ __forceinline__ void operator()(const f32x4 (&acc_in)[2][2][4][2], const Unit& u, int wr, int wc, int fr_in, int fq_in) const {
        int fr = fr_in, fq = fq_in; asm volatile("" : "+v"(fr), "+v"(fq));
        f32x4 (&acc)[2][2][4][2] = const_cast<f32x4 (&)[2][2][4][2]>(acc_in);
#pragma unroll
        for (int ai = 0; ai < 2; ++ai)
#pragma unroll
            for (int m = 0; m < 4; ++m) { const float r = rs.RT[ai * HALF + wr * 64 + m * 16 + fr];
#pragma unroll
                for (int bj = 0; bj < 2; ++bj)
#pragma unroll
                    for (int n = 0; n < 2; ++n) acc[ai][bj][m][n] *= r; }
        const int row0 = u.pm * BM + wr * 64 + fr, pn = u.pn;
        if (pn < 14) { const int col0 = pn * BM + wc * 32 + 8 * fq;
#pragma unroll
            for (int ai = 0; ai < 2; ++ai)
#pragma unroll
                for (int m = 0; m < 4; ++m) { bf16_t* rowp = P + (size_t)(row0 + ai * HALF + m * 16) * ldp + col0;
#pragma unroll
                    for (int bj = 0; bj < 2; ++bj) { const f32x4 v0 = acc[ai][bj][m][0], v1 = acc[ai][bj][m][1];
                        u32x4 w; w.x = cvt_pk_bf16(v0[0], v0[1]); w.y = cvt_pk_bf16(v0[2], v0[3]); w.z = cvt_pk_bf16(v1[0], v1[1]); w.w = cvt_pk_bf16(v1[2], v1[3]);
                        *(u32x4*)(rowp + bj * HALF) = w; } }
        } else if (pn < 22) { const bool isk = pn >= 18; const int hd0 = (pn - (isk ? 18 : 14)) * 2;
#pragma unroll
            for (int ai = 0; ai < 2; ++ai)
#pragma unroll
                for (int m = 0; m < 4; ++m)
#pragma unroll
                    for (int bj = 0; bj < 2; ++bj) { const f32x4 v0 = acc[ai][bj][m][0], v1 = acc[ai][bj][m][1];
                        float s = (v0[0] * v0[0] + v0[1] * v0[1]) + (v0[2] * v0[2] + v0[3] * v0[3]) + (v1[0] * v1[0] + v1[1] * v1[1]) + (v1[2] * v1[2] + v1[3] * v1[3]);
                        s += __shfl_xor(s, 16); s += __shfl_xor(s, 32);
                        if (fq == 0) X[(ai * HALF + wr * 64 + m * 16 + fr) * 8 + bj * 4 + wc] = s; }
            asm volatile("s_waitcnt lgkmcnt(0)" ::: "memory"); __builtin_amdgcn_s_barrier(); asm volatile("" ::: "memory");
            const float* gain = isk ? gk : gq; const f32x4 g0 = *(const f32x4*)(gain + wc * 32 + 8 * fq), g1 = *(const f32x4*)(gain + wc * 32 + 8 * fq + 4);
            bf16_t* Ob = isk ? KB : QB;
#pragma unroll
            for (int ai = 0; ai < 2; ++ai)
#pragma unroll
                for (int m = 0; m < 4; ++m) { const int rl = ai * HALF + wr * 64 + m * 16 + fr, row = u.pm * BM + rl;
#pragma unroll
                    for (int bj = 0; bj < 2; ++bj) { const f32x4 t = *(const PG8_LAS f32x4*)(X + rl * 8 + bj * 4); const float r = rsqrtf(((t[0] + t[1]) + (t[2] + t[3])) * (1.f / 128.f) + eps);
                        const f32x4 y0 = acc[ai][bj][m][0] * r * g0, y1 = acc[ai][bj][m][1] * r * g1; const int col = (hd0 + bj) * 128 + wc * 32 + 8 * fq;
                        u32x4 w; w.x = cvt_pk_bf16(y0[0], y0[1]); w.y = cvt_pk_bf16(y0[2], y0[3]); w.z = cvt_pk_bf16(y1[0], y1[1]); w.w = cvt_pk_bf16(y1[2], y1[3]);
                        *(u32x4*)(Ob + (size_t)row * 1024 + col) = w;
                        if (isk) { float* d = (row < split ? fk_p + (size_t)row * 1024 : fk_s + (size_t)(row - split) * 1024) + col; *(f32x4*)d = y0; *(f32x4*)(d + 4) = y1; } } }
        } else if (pn < 26) { const int hd0 = (pn - 22) * 2;
#pragma unroll
            for (int ai = 0; ai < 2; ++ai)
#pragma unroll
                for (int m = 0; m < 4; ++m) { const int row = row0 + ai * HALF + m * 16;
#pragma unroll
                    for (int bj = 0; bj < 2; ++bj) { const f32x4 v0 = acc[ai][bj][m][0], v1 = acc[ai][bj][m][1]; const int col = (hd0 + bj) * 128 + wc * 32 + 8 * fq;
                        u32x4 w; w.x = cvt_pk_bf16(v0[0], v0[1]); w.y = cvt_pk_bf16(v0[2], v0[3]); w.z = cvt_pk_bf16(v1[0], v1[1]); w.w = cvt_pk_bf16(v1[2], v1[3]);
                        *(u32x4*)(VB + (size_t)row * 1024 + col) = w;
                        float* d = (row < split ? fv_p + (size_t)row * 1024 : fv_s + (size_t)(row - split) * 1024) + col; *(f32x4*)d = v0; *(f32x4*)(d + 4) = v1; } }
        } else if (wc == 0) {
#pragma unroll
            for (int ai = 0; ai < 2; ++ai)
#pragma unroll
                for (int m = 0; m < 4; ++m) { float* sp = side + (size_t)(row0 + ai * HALF + m * 16) * 32 + 8 * fq; *(f32x4*)sp = acc[ai][0][m][0]; *(f32x4*)(sp + 4) = acc[ai][0][m][1]; }
        }
    }
};
template <class Epi, class Sched, bool ALIGN_EPI = false, bool SP2 = false, bool STRIP = false, bool ROWSCALE = false>
__device__ __forceinline__ void gemm_phase(PG8_LAS unsigned char* lds, const Gemm g, const Sched& S, const Epi& E) {
    int tid_ = threadIdx.x; asm volatile("" : "+v"(tid_));
    const int tid = tid_, wid = __builtin_amdgcn_readfirstlane(tid >> 6), lane = tid & 63, wr = wid >> 2, wc = wid & 3, fr = lane & 15, fq = lane >> 4;
    const int K = g.K, nt = g.KL / BK;
    unsigned voffA[2], voffB[2];
#pragma unroll
    for (int i = 0; i < 2; ++i) { int R, C; stage_rc(tid * 16 + i * 8192, R, C); const int Rb = Epi::PERM ? ((R & ~31) + perm32(R & 31)) : R;
        voffA[i] = (unsigned)(R * K + C) * 2u; voffB[i] = (unsigned)(Rb * K + C) * 2u; }
    const size_t kstep = (size_t)(BK * 2);
    const size_t hstep = (size_t)HALF * K * 2;
    const size_t tstep = 2 * hstep;
    const unsigned ldsw = (unsigned)wid * 1024u;
    const int aoff = lds_byte(wr * 64 + fr, fq * 8), boff = lds_byte(wc * 32 + fr, fq * 8);
    static_assert(!STRIP || SP2, "STRIP needs the SP2 loop");
    constexpr int SOFF = STAGE_BYTES + 8192;
    const unsigned voffS = (unsigned)(((2 * wid + (lane >> 5)) * K + (lane & 31) * 2) * 2);
    const int soff = fr * 128 + fq * 16;
#define PG8_SA(b, h) (((b) * 2 + (h)) * HTB)
#define PG8_SB(b, h) ((4 + (b) * 2 + (h)) * HTB)
#define PG8_STAGE(bufoff, gbase, voff) do { _Pragma("unroll") for (int _i = 0; _i < 2; ++_i) \
        __builtin_amdgcn_global_load_lds((const unsigned*)((const char*)(gbase) + (voff)[_i]), (PG8_LAS unsigned*)(lds + (bufoff) + ldsw + _i * 8192), 16, 0, 0); } while (0)
#define PG8_LDA(dst, b, h) do { _Pragma("unroll") for (int m = 0; m < 4; ++m) _Pragma("unroll") for (int k = 0; k < 2; ++k) dst[m][k] = *(const PG8_LAS bf16x8*)(lds + PG8_SA(b, h) + aoff + m * 2048 + k * 1024); } while (0)
#define PG8_LDB(dst, b, h) do { _Pragma("unroll") for (int n = 0; n < 2; ++n) _Pragma("unroll") for (int k = 0; k < 2; ++k) dst[n][k] = *(const PG8_LAS bf16x8*)(lds + PG8_SB(b, h) + boff + n * 2048 + k * 1024); } while (0)
#define PG8_MMA(ai, bj, At, Bt) do { __builtin_amdgcn_s_setprio(1); _Pragma("unroll") for (int m = 0; m < 4; ++m) _Pragma("unroll") for (int n = 0; n < 2; ++n) _Pragma("unroll") for (int k = 0; k < 2; ++k) \
        acc[ai][bj][m][n] = __builtin_amdgcn_mfma_f32_16x16x32_bf16(Bt[n][k], At[m][k], acc[ai][bj][m][n], 0, 0, 0); __builtin_amdgcn_s_setprio(0); } while (0)
#define PG8_WAIT_V(n) asm volatile("s_waitcnt vmcnt(" #n ")" ::: "memory")
#define PG8_SSTAGE(sb, gptr) do { if constexpr (STRIP) __builtin_amdgcn_global_load_lds((const unsigned*)((const char*)(gptr) + voffS), (PG8_LAS unsigned*)(lds + SOFF + (sb) * 2048 + wid * 256), 4, 0, 0); } while (0)
#define PG8_SLD(sb) do { if constexpr (STRIP) { Sf[0] = *(const PG8_LAS bf16x8*)(lds + SOFF + (sb) * 2048 + soff); Sf[1] = *(const PG8_LAS bf16x8*)(lds + SOFF + (sb) * 2048 + soff + 64); } } while (0)
#define PG8_SMMA() do { if constexpr (STRIP) { if (wr == 0) { _Pragma("unroll") for (int n = 0; n < 2; ++n) _Pragma("unroll") for (int k = 0; k < 2; ++k) accS[n] = __builtin_amdgcn_mfma_f32_16x16x32_bf16(B0[n][k], Sf[k], accS[n], 0, 0, 0); } \
        else { _Pragma("unroll") for (int n = 0; n < 2; ++n) _Pragma("unroll") for (int k = 0; k < 2; ++k) accS[n] = __builtin_amdgcn_mfma_f32_16x16x32_bf16(B1[n][k], Sf[k], accS[n], 0, 0, 0); } } } while (0)
#define PG8_WAIT_VL() do { if constexpr (STRIP) PG8_WAIT_V(9); else PG8_WAIT_V(8); } while (0)
#define PG8_WAIT_L(n) asm volatile("s_waitcnt lgkmcnt(" #n ")" ::: "memory")
#define PG8_BAR __builtin_amdgcn_s_barrier()
#define PG8_SCHED __builtin_amdgcn_sched_barrier(0)
    Unit cur, nxt; int ui = 0;
    if (!S.next(0, cur)) return;
    f32x4 acc[2][2][4][2];
#pragma unroll
    for (int a = 0; a < 2; ++a)
#pragma unroll
        for (int b = 0; b < 2; ++b)
#pragma unroll
            for (int m = 0; m < 4; ++m)
#pragma unroll
                for (int n = 0; n < 2; ++n) acc[a][b][m][n] = (f32x4){0.f, 0.f, 0.f, 0.f};
    bf16x8 At[4][2], B0[2][2], B1[2][2]; bf16x8 Sf[2]; f32x4 accS[2] = {(f32x4){0.f, 0.f, 0.f, 0.f}, (f32x4){0.f, 0.f, 0.f, 0.f}};
    const char* cA = (const char*)g.A + (size_t)cur.pm * tstep + (size_t)cur.ko * 2; const char* cB = (const char*)g.Bt + (size_t)cur.pn * tstep + (size_t)cur.ko * 2;
    const char* cS = STRIP ? (const char*)g.As + (size_t)cur.pm * 16 * K * 2 + (size_t)cur.ko * 2 : nullptr;
    S.a_ready(cur);
    f32x4 rsa = {0.f, 0.f, 0.f, 0.f}, rsb = rsa, rna = rsa, rnb = rsa; if constexpr (ROWSCALE) { static_assert(ALIGN_EPI, "ROWSCALE publishes behind a workgroup barrier inside the epilogue"); E.rs.load(cur, tid, rsa, rsb); }
    if constexpr (SP2) {
        PG8_STAGE(PG8_SB(0, 0), cB, voffB); PG8_STAGE(PG8_SB(0, 1), cB + hstep, voffB); PG8_STAGE(PG8_SA(0, 0), cA, voffA); PG8_STAGE(PG8_SA(0, 1), cA + hstep, voffA); PG8_SSTAGE(0, cS);
        if (wr == 1) PG8_BAR;
        if constexpr (STRIP) PG8_WAIT_V(3); else PG8_WAIT_V(2); PG8_BAR;
        PG8_STAGE(PG8_SB(1, 0), cB + kstep, voffB); PG8_STAGE(PG8_SA(1, 0), cA + kstep, voffA); PG8_STAGE(PG8_SB(1, 1), cB + hstep + kstep, voffB);
        PG8_WAIT_V(6); PG8_BAR;
    } else {
        PG8_STAGE(PG8_SB(0, 0), cB, voffB); PG8_STAGE(PG8_SA(0, 0), cA, voffA); PG8_STAGE(PG8_SB(0, 1), cB + hstep, voffB); PG8_STAGE(PG8_SA(0, 1), cA + hstep, voffA);
        if (wr == 1) PG8_BAR;
        PG8_WAIT_V(4); PG8_BAR;
        PG8_STAGE(PG8_SB(1, 0), cB + kstep, voffB); PG8_STAGE(PG8_SA(1, 0), cA + kstep, voffA); PG8_STAGE(PG8_SB(1, 1), cB + hstep + kstep, voffB);
        PG8_WAIT_V(6); PG8_BAR;
    }
    for (;;) {
        const bool has_next = S.next(ui + 1, nxt);
        const char* nS = (STRIP && has_next) ? (const char*)g.As + (size_t)nxt.pm * 16 * K * 2 + (size_t)nxt.ko * 2 : cS;
        const char* nA = has_next ? (const char*)g.A + (size_t)nxt.pm * tstep + (size_t)nxt.ko * 2 : cA; const char* nB = has_next ? (const char*)g.Bt + (size_t)nxt.pn * tstep + (size_t)nxt.ko * 2 : cB;
        for (int t = 0; t < nt; t += 2) {
            const bool last = (t == nt - 2);
            const char* a1 = cA + (size_t)(t + 1) * kstep;
            const char* a2 = last ? nA : cA + (size_t)(t + 2) * kstep; const char* b2 = last ? nB : cB + (size_t)(t + 2) * kstep;
            const char* a3 = a2 + kstep; const char* b3 = b2 + kstep;
            const char* s1 = STRIP ? cS + (size_t)(t + 1) * kstep : nullptr; const char* s2 = STRIP ? (last ? nS : cS + (size_t)(t + 2) * kstep) : nullptr;
            if (last && has_next) { S.a_ready(nxt); if constexpr (ROWSCALE) E.rs.load(nxt, tid, rna, rnb); }
            if constexpr (SP2) {
            PG8_LDB(B0, 0, 0); PG8_LDB(B1, 0, 1); PG8_SCHED; PG8_LDA(At, 0, 0); PG8_STAGE(PG8_SA(1, 1), a1 + hstep, voffA); PG8_SSTAGE(1, s1);
            PG8_WAIT_VL(); PG8_WAIT_L(0); PG8_BAR; PG8_MMA(0, 0, At, B0); PG8_MMA(0, 1, At, B1); PG8_BAR; PG8_SCHED;
            PG8_LDA(At, 0, 1); PG8_SLD(0); PG8_STAGE(PG8_SB(0, 0), b2, voffB); PG8_STAGE(PG8_SB(0, 1), b2 + hstep, voffB); PG8_STAGE(PG8_SA(0, 0), a2, voffA);
            PG8_WAIT_VL(); PG8_WAIT_L(0); PG8_BAR; PG8_MMA(1, 0, At, B0); PG8_MMA(1, 1, At, B1); PG8_SMMA(); PG8_BAR; PG8_SCHED;
            PG8_LDB(B0, 1, 0); PG8_LDB(B1, 1, 1); PG8_SCHED; PG8_LDA(At, 1, 0); PG8_STAGE(PG8_SA(0, 1), a2 + hstep, voffA); PG8_SSTAGE(0, s2);
            PG8_WAIT_VL(); PG8_WAIT_L(0); PG8_BAR; PG8_MMA(0, 0, At, B0); PG8_MMA(0, 1, At, B1); PG8_BAR; PG8_SCHED;
            PG8_LDA(At, 1, 1); PG8_SLD(1); PG8_STAGE(PG8_SB(1, 0), b3, voffB); PG8_STAGE(PG8_SB(1, 1), b3 + hstep, voffB); PG8_STAGE(PG8_SA(1, 0), a3, voffA);
            PG8_WAIT_VL(); PG8_WAIT_L(0); PG8_BAR; PG8_MMA(1, 0, At, B0); PG8_MMA(1, 1, At, B1); PG8_SMMA(); PG8_BAR; PG8_SCHED;
            } else {
            PG8_LDB(B0, 0, 0); PG8_SCHED; PG8_LDA(At, 0, 0); PG8_STAGE(PG8_SA(1, 1), a1 + hstep, voffA);
            PG8_WAIT_L(8); PG8_BAR; PG8_WAIT_L(0); PG8_MMA(0, 0, At, B0); PG8_BAR; PG8_SCHED;
            PG8_LDB(B1, 0, 1); PG8_STAGE(PG8_SB(0, 0), b2, voffB);
            PG8_BAR; PG8_WAIT_L(0); PG8_MMA(0, 1, At, B1); PG8_BAR;
            PG8_LDA(At, 0, 1); PG8_STAGE(PG8_SA(0, 0), a2, voffA);
            PG8_BAR; PG8_WAIT_L(0); PG8_MMA(1, 0, At, B0); PG8_BAR; PG8_SCHED;
            PG8_STAGE(PG8_SB(0, 1), b2 + hstep, voffB);
            PG8_WAIT_V(6); PG8_BAR; PG8_MMA(1, 1, At, B1); PG8_BAR;
            PG8_LDB(B0, 1, 0); PG8_SCHED; PG8_LDA(At, 1, 0); PG8_STAGE(PG8_SA(0, 1), a2 + hstep, voffA);
            PG8_WAIT_L(8); PG8_BAR; PG8_WAIT_L(0); PG8_MMA(0, 0, At, B0); PG8_BAR; PG8_SCHED;
            PG8_LDB(B1, 1, 1); PG8_STAGE(PG8_SB(1, 0), b3, voffB);
            PG8_BAR; PG8_WAIT_L(0); PG8_MMA(0, 1, At, B1); PG8_BAR;
            PG8_LDA(At, 1, 1); PG8_STAGE(PG8_SA(1, 0), a3, voffA);
            PG8_BAR; PG8_WAIT_L(0); PG8_MMA(1, 0, At, B0); PG8_BAR; PG8_SCHED;
            PG8_STAGE(PG8_SB(1, 1), b3 + hstep, voffB);
            PG8_WAIT_V(6); PG8_BAR; PG8_MMA(1, 1, At, B1); PG8_BAR;
            }
        }
        if constexpr (ALIGN_EPI) { if (wr == 0) PG8_BAR; }
        if constexpr (ROWSCALE) { E.rs.publish(tid, rsa, rsb); rsa = rna; rsb = rnb; }
        if constexpr (!Epi::AFTER_DRAIN) { E(acc, cur, wr, wc, fr, fq); if constexpr (STRIP) { E.strip(accS, cur, wr, wc, fr, fq); accS[0] = (f32x4){0.f, 0.f, 0.f, 0.f}; accS[1] = (f32x4){0.f, 0.f, 0.f, 0.f}; } S.done(cur); }
        if (!has_next) break;
#pragma unroll
        for (int a = 0; a < 2; ++a)
#pragma unroll
            for (int b = 0; b < 2; ++b)
#pragma unroll
                for (int m = 0; m < 4; ++m)
#pragma unroll
                    for (int n = 0; n < 2; ++n) acc[a][b][m][n] = (f32x4){0.f, 0.f, 0.f, 0.f};
        cur = nxt; cA = nA; cB = nB; cS = nS; ++ui;
        if constexpr (ALIGN_EPI) { if (wr == 1) PG8_BAR; }
    }
    PG8_WAIT_V(0);
    if constexpr (!ALIGN_EPI) { if (wr == 0) PG8_BAR; }
    PG8_BAR;
    if constexpr (Epi::AFTER_DRAIN) { E.fused(acc, cur, wr, wc, fr, fq, lds, wid, lane); S.done(cur); }
#undef PG8_SA
#undef PG8_SB
#undef PG8_STAGE
#undef PG8_SSTAGE
#undef PG8_SLD
#undef PG8_SMMA
#undef PG8_WAIT_VL
#undef PG8_LDA
#undef PG8_LDB
#undef PG8_MMA
#undef PG8_WAIT_V
#undef PG8_WAIT_L
#undef PG8_BAR
#undef PG8_SCHED
}
}

#define LAS __attribute__((address_space(3)))
typedef unsigned short bf16;
typedef float f32x4 __attribute__((ext_vector_type(4)));
typedef unsigned u32x4v __attribute__((ext_vector_type(4)));
typedef unsigned u32x2v __attribute__((ext_vector_type(2)));

constexpr int DM = 2048, TP = 8192, NSB = 16, TS = 32, MS = NSB * TS, MT = TP + MS, NL = 4, PAST = 1024;
constexpr int DIN = 6680, DINP = 6912, DFF = 5632;
constexpr int C_GQ = 0, C_GK = 256, C_GV = 512, C_GG = 1024, C_GA = 1536, C_RQ = 1552, C_RK = 2064, C_RV = 2576, C_RG = 3088, C_FQ = 3600, C_FK = 4624, C_FV = 5648, C_FF = 6672;
constexpr float EPS = 1e-6f;
constexpr int PBP = 3584, PB_GQ = 0, PB_GK = 256, PB_GV = 512, PB_GG = 1024, PB_RQ = 1536, PB_RK = 2048, PB_RV = 2560, PB_RG = 3072;
constexpr int NSLOT = 128 + NSB;
enum { I_XP = 0, I_XS, I_SGLA, I_SRET, I_CK, I_CV, I_CLF, I_NMIX, I_WIN, I_WGG, I_BGG, I_GGLA, I_GRET, I_GFQ, I_GFK, I_BFF, I_GFO, I_WOUT, I_NFFN, I_WG, I_WU, I_WD, N_IN };
constexpr size_t O_YP = 0, O_YS = O_YP + (size_t)TP * DM, O_GLAP = O_YS + (size_t)MS * DM, O_RETP = O_GLAP + (size_t)NL * 4 * 64 * 128,
                 O_FKP = O_RETP + (size_t)NL * 4 * 128 * 128, O_FVP = O_FKP + (size_t)NL * TP * 1024, O_LFP = O_FVP + (size_t)NL * TP * 1024,
                 O_GLAS = O_LFP + (size_t)NL * TP * 8, O_RETS = O_GLAS + (size_t)NL * NSB * 4 * 64 * 128, O_FKS = O_RETS + (size_t)NL * NSB * 4 * 128 * 128,
                 O_FVS = O_FKS + (size_t)NL * MS * 1024, O_LFS = O_FVS + (size_t)NL * MS * 1024, O_END = O_LFS + (size_t)NL * MS * 8;
static_assert(O_END == 96092160, "output size");
constexpr size_t al256(size_t x) { return (x + 255) & ~(size_t)255; }
constexpr size_t SZ_WIN = (size_t)DINP * DM * 2, SZ_WOUT = (size_t)DM * DM * 2, SZ_WGU = (size_t)2 * DFF * DM * 2, SZ_WDN = (size_t)DM * DFF * 2;
constexpr size_t WS_CTL = 0, WS_WIN = 1u << 20, WS_WOUT = WS_WIN + NL * SZ_WIN, WS_WGU = WS_WOUT + NL * SZ_WOUT, WS_WDN = WS_WGU + NL * SZ_WGU,
                 WS_H = WS_WDN + NL * SZ_WDN, WS_XN = WS_H + (size_t)MT * DM * 4, WS_PROJ = WS_XN + (size_t)MT * DM * 2,
                 WS_GQ = WS_PROJ + (size_t)MT * DINP * 4, WS_GK = WS_GQ + (size_t)MT * 256 * 4, WS_LA = WS_GK + (size_t)MT * 256 * 4,
                 WS_RQ = WS_LA + (size_t)MT * 256 * 4, WS_RK = WS_RQ + (size_t)MT * 512 * 4, WS_FQ = WS_RK + (size_t)MT * 512 * 4,
                 WS_LOGF = WS_FQ + (size_t)MT * 1024 * 4, WS_CKP = WS_LOGF + (size_t)MT * 8 * 4, WS_CKS = WS_CKP + (size_t)8 * TP * 4,
                 WS_GU = al256(WS_CKS + (size_t)NSB * 8 * (PAST + TS) * 4), WS_GDEC = WS_GU + (size_t)NSLOT * 4 * 64 * 128 * 4, WS_GS = WS_GDEC + (size_t)NSLOT * 4 * 64 * 4,
                 WS_RU = WS_GS + (size_t)NSLOT * 4 * 64 * 128 * 4, WS_RSP = WS_RU + (size_t)NSLOT * 4 * 128 * 128 * 4,
                 WS_MRG = WS_RSP + (size_t)NSLOT * 4 * 128 * 128 * 4, WS_ACT = WS_MRG + (size_t)MT * DM * 2, WS_QB = WS_ACT + (size_t)MT * DFF * 2,
                 WS_KB = WS_QB + (size_t)MT * 1024 * 2, WS_VB = WS_KB + (size_t)MT * 1024 * 2, WS_PART = WS_VB + (size_t)MT * 1024 * 2, WS_TABC = WS_PART + (size_t)8 * MS * DM * 4, WS_TABS = WS_TABC + (size_t)MT * 64 * 4, WS_RVT = WS_TABS + (size_t)MT * 64 * 4,
                 WS_FPART = WS_RVT + (size_t)NSLOT * 4 * 16 * 64 * 16, WS_SIDE = WS_FPART + (size_t)256 * (256 * 128 + 512) * 4, WS_SSP = WS_SIDE + (size_t)MT * 32 * 4, WS_SPART = WS_SSP + (size_t)8 * MT * 8 * 4, WS_END = WS_SPART + (size_t)256 * (32 * 128 + 64) * 4;

struct Ctx { const float* in[N_IN]; float* out; unsigned char* ws; };

typedef const __attribute__((address_space(4))) Ctx* KCtxP;
__device__ __forceinline__ KCtxP kctx() { KCtxP p = (KCtxP)__builtin_amdgcn_kernarg_segment_ptr(); asm volatile("" : "+s"(p)); return p; }
#define OPQ_PTRS const KCtxP kc_ = kctx(); unsigned char* const ws_ = kc_->ws; float* const out_ = kc_->out
__device__ __forceinline__ int otid() { int t = threadIdx.x; asm volatile("" : "+v"(t)); return t; }
__device__ __forceinline__ unsigned f2bf(float f) { unsigned u = __builtin_bit_cast(unsigned, f); return (u + 0x7fffu + ((u >> 16) & 1u)) >> 16; }
__device__ __forceinline__ unsigned pk2(float lo, float hi) { return f2bf(lo) | (f2bf(hi) << 16); }
__device__ __forceinline__ float wave_sum(float v) {
#pragma unroll
    for (int o = 1; o < 64; o <<= 1) v += __shfl_xor(v, o);
    return v;
}
__device__ __forceinline__ float grp8_sum(float v) { v += __shfl_xor(v, 1); v += __shfl_xor(v, 2); v += __shfl_xor(v, 4); return v; }
__device__ __forceinline__ float grp8_max(float v) { v = fmaxf(v, __shfl_xor(v, 1)); v = fmaxf(v, __shfl_xor(v, 2)); v = fmaxf(v, __shfl_xor(v, 4)); return v; }
__device__ __forceinline__ float logsigmoid_f(float x) { return fminf(x, 0.f) - log1pf(expf(-fabsf(x))); }
__device__ __forceinline__ float silu_f(float x) { return x / (1.0f + expf(-x)); }
__device__ __forceinline__ float ret_logg(int h) { return log1pf(-exp2f(-5.0f - (float)h)); }
__device__ __forceinline__ int slot_len(int slot) { return slot < 128 ? 64 : 32; }
__device__ __forceinline__ int slot_tok0(int slot) { return slot < 128 ? 64 * slot : TP + 32 * (slot - 128); }

__device__ __forceinline__ void cvt_item(const float* W, int ldw, int src_col0, int valid, bf16* out, int out_row0, int K, int k0, LAS float* scr, int lane, float scale = 1.f, bool gaff = false, const float* kgain = nullptr) {
    if (!gaff && valid == 32) {
        const int c4 = lane & 7;
#pragma unroll
        for (int i = 0; i < 8; ++i) { const int kk = 8 * i + (lane >> 3); const f32x4 v = *(const f32x4*)(W + (size_t)(k0 + kk) * ldw + src_col0 + 4 * c4); const float sk = kgain ? scale * kgain[k0 + kk] : scale;
            LAS float* d = scr + kk * 33 + 4 * c4; d[0] = v.x * sk; d[1] = v.y * sk; d[2] = v.z * sk; d[3] = v.w * sk; }
    } else {
    const int c = lane & 31;
    int sc = src_col0 + c; bool ok = c < valid;
    if (gaff) { ok = c < 24; sc = c < 16 ? C_GA + c : C_FF + (c - 16); }
#pragma unroll 8
    for (int i = 0; i < 32; ++i) { const int kk = 2 * i + (lane >> 5); scr[kk * 33 + c] = ok ? W[(size_t)(k0 + kk) * ldw + sc] * (kgain ? scale * kgain[k0 + kk] : scale) : 0.f; }
    }
    __builtin_amdgcn_s_waitcnt(0); asm volatile("" ::: "memory");
    const int ch = lane & 7;
#pragma unroll
    for (int j = 0; j < 4; ++j) { const int n = (lane >> 3) + 8 * j; const LAS float* s = scr + (8 * ch) * 33 + n;
        u32x4v o; o.x = pk2(s[0 * 33], s[1 * 33]); o.y = pk2(s[2 * 33], s[3 * 33]); o.z = pk2(s[4 * 33], s[5 * 33]); o.w = pk2(s[6 * 33], s[7 * 33]);
        *(u32x4v*)(out + (size_t)(out_row0 + n) * K + k0 + 8 * ch) = o; }
    __builtin_amdgcn_s_waitcnt(0); asm volatile("" ::: "memory");
}
__device__ __forceinline__ void cvt_decode(KCtxP kc_, unsigned char* ws_, int l, int part, int idx, const float*& W, int& ldw, int& col, bf16*& out, int& orow, int& K, int& k0, float& scale, bool& hasg) {
    constexpr int NB_OUT = DM / 32, NB_GU = 2 * DFF / 32, NB_DN = DM / 32, NBF = 6656 / 32;
    constexpr int I_OUT = (DM / 64) * NB_OUT, I_GU = (DM / 64) * NB_GU;
    int r = idx; scale = 1.f; hasg = false;
    if (part == 0) { const int kb = r / NBF, n0 = (r % NBF) * 32;
        W = kc_->in[I_WIN] + (size_t)l * DM * DIN; ldw = DIN; out = (bf16*)(ws_ + WS_WIN + l * SZ_WIN); orow = n0; K = DM; k0 = kb * 64; hasg = true;
        if (n0 < 1536) { col = n0; scale = n0 < 256 ? 0.125f : 1.f; } else { col = n0 + 16; scale = n0 < 2048 ? 0.08838834764831845f : 1.f; }
        return; }
    if (r < I_OUT) { const int kb = r / NB_OUT, nbk = r % NB_OUT; W = kc_->in[I_WOUT] + (size_t)l * DM * DM; ldw = DM; col = nbk * 32; out = (bf16*)(ws_ + WS_WOUT + l * SZ_WOUT); orow = nbk * 32; K = DM; k0 = kb * 64; return; }
    r -= I_OUT;
    if (r < I_GU) { const int kb = r / NB_GU, n0 = (r % NB_GU) * 32, tile = n0 >> 8, rr = n0 & 255;
        W = (rr < 128 ? kc_->in[I_WG] : kc_->in[I_WU]) + (size_t)l * DM * DFF; ldw = DFF; col = tile * 128 + (rr & 127); out = (bf16*)(ws_ + WS_WGU + l * SZ_WGU); orow = n0; K = DM; k0 = kb * 64; hasg = true; return; }
    r -= I_GU;
    { const int kb = r / NB_DN, nbk = r % NB_DN; W = kc_->in[I_WD] + (size_t)l * DFF * DM; ldw = DM; col = nbk * 32; out = (bf16*)(ws_ + WS_WDN + l * SZ_WDN); orow = nbk * 32; K = DFF; k0 = kb * 64; }
}
__device__ __forceinline__ void cvt_dma(KCtxP kc_, unsigned char* ws_, int l, int part, int idx, LAS float* buf, int lane) {
    const float* W; int ldw, col; bf16* out; int orow, K, k0; float scale; bool hasg;
    cvt_decode(kc_, ws_, l, part, idx, W, ldw, col, out, orow, K, k0, scale, hasg);
    const float* p0 = W + (size_t)(k0 + (lane >> 3)) * ldw + col; const int c = lane & 7;
#pragma unroll
    for (int i = 0; i < 8; ++i) __builtin_amdgcn_global_load_lds((const unsigned*)(p0 + (size_t)(8 * i) * ldw + 4 * (c ^ i)), (LAS unsigned*)(buf + i * 256), 16, 0, 0);
}
__device__ __forceinline__ void phase_convert(const Ctx& c, int l, LAS unsigned char* lds, int bid, int nb, int part, int lo = 0, int hi_ = -1) {
    OPQ_PTRS; (void)out_;
    const int tid_ = otid(), lane = tid_ & 63, wave = __builtin_amdgcn_readfirstlane(tid_ >> 6);
    LAS float* B0 = (LAS float*)(lds + wave * 16384);
    LAS float* G = (LAS float*)(lds + 131072);
    const int gw = bid * 8 + wave, ngw = nb * 8;
    constexpr int NB_OUT = DM / 32, NB_GU = 2 * DFF / 32, NB_DN = DM / 32;
    constexpr int I_OUT = (DM / 64) * NB_OUT, I_GU = (DM / 64) * NB_GU, I_DN = (DFF / 64) * NB_DN;
    __syncthreads();
    { const float* gsrc = (part == 0 ? kc_->in[I_NMIX] : kc_->in[I_NFFN]) + (size_t)l * DM; *(LAS f32x4*)(G + 4 * tid_) = *(const f32x4*)(gsrc + 4 * tid_); }
    if (part == 0) {
        for (int s = gw; s < 256; s += ngw) { const int kb = s >> 3, n0 = 6656 + (s & 7) * 32;
            cvt_item(kc_->in[I_WIN] + (size_t)l * DM * DIN, DIN, 0, n0 == 6656 ? 32 : 0, (bf16*)(ws_ + WS_WIN + l * SZ_WIN), n0, DM, kb * 64, B0, lane, 1.f, n0 == 6656, kc_->in[I_NMIX] + (size_t)l * DM); } }
    __syncthreads();
    const int hi = hi_ >= 0 ? hi_ : (part == 0 ? 32 * 208 : I_OUT + I_GU + I_DN);
    const int c4 = lane & 7, kq = lane >> 3;
    int it = lo + gw;
    if (it < hi) {
        cvt_dma(kc_, ws_, l, part, it, B0, lane);
        if (it + ngw < hi) { cvt_dma(kc_, ws_, l, part, it + ngw, B0 + 2048, lane); asm volatile("s_waitcnt vmcnt(8)" ::: "memory"); } else asm volatile("s_waitcnt vmcnt(0)" ::: "memory");
        int cur = 0;
        while (true) {
            const float* W; int ldw, col; bf16* out; int orow, K, k0; float scale; bool hasg;
            cvt_decode(kc_, ws_, l, part, it, W, ldw, col, out, orow, K, k0, scale, hasg);
            LAS float* B = B0 + cur * 2048;
            float x[4][8]; f32x4 ga = {1.f, 1.f, 1.f, 1.f}, gb = ga;
            if (hasg) { ga = *(const LAS f32x4*)(G + k0 + 8 * c4); gb = *(const LAS f32x4*)(G + k0 + 8 * c4 + 4); }
#pragma unroll
            for (int j = 0; j < 4; ++j) { const int n = kq + 8 * j; const LAS float* s = B + (8 * c4) * 32 + (((n >> 2) ^ c4) * 4) + (n & 3);
#pragma unroll
                for (int r = 0; r < 8; ++r) x[j][r] = s[r * 32]; }
            asm volatile("s_waitcnt lgkmcnt(0)" ::: "memory");
            const int nx2 = it + 2 * ngw; const bool issued = nx2 < hi;
            if (issued) cvt_dma(kc_, ws_, l, part, nx2, B, lane);
            const float s0 = scale * ga[0], s1 = scale * ga[1], s2 = scale * ga[2], s3 = scale * ga[3], s4 = scale * gb[0], s5 = scale * gb[1], s6 = scale * gb[2], s7 = scale * gb[3];
#pragma unroll
            for (int j = 0; j < 4; ++j) { const int n = kq + 8 * j;
                u32x4v o; o.x = pg8::cvt_pk_bf16(x[j][0] * s0, x[j][1] * s1); o.y = pg8::cvt_pk_bf16(x[j][2] * s2, x[j][3] * s3); o.z = pg8::cvt_pk_bf16(x[j][4] * s4, x[j][5] * s5); o.w = pg8::cvt_pk_bf16(x[j][6] * s6, x[j][7] * s7);
                *(u32x4v*)(out + (size_t)(orow + n) * K + k0 + 8 * c4) = o; }
            asm volatile("" ::: "memory");
            it += ngw; if (it >= hi) break;
            cur ^= 1;
            if (issued) asm volatile("s_waitcnt vmcnt(12)" ::: "memory"); else asm volatile("s_waitcnt vmcnt(4)" ::: "memory");
        }
    }
    asm volatile("s_waitcnt vmcnt(0) lgkmcnt(0)" ::: "memory");
}

__device__ __forceinline__ float block_excl_offset(float run, int tid, LAS float* tot) {
    const int lane = tid & 63, wv = tid >> 6; float inc = run;
#pragma unroll
    for (int o = 1; o < 64; o <<= 1) { const float t = __shfl_up(inc, o); if (lane >= o) inc += t; }
    if (lane == 63) tot[wv] = inc;
    __syncthreads();
    float base = 0.f;
#pragma unroll
    for (int w = 0; w < 8; ++w) base += (w < wv) ? tot[w] : 0.f;
    return base + (inc - run);
}
__device__ __forceinline__ void phase_fox_cumsum2(const Ctx& c, int l, LAS unsigned char* lds, int bid, int nb) {
    OPQ_PTRS;
    const int tid = otid(); LAS float* tot = (LAS float*)lds;
    const float* SIDE = (const float*)(ws_ + WS_SIDE); float* CKP = (float*)(ws_ + WS_CKP); float* CKS = (float*)(ws_ + WS_CKS); const float* bff = kc_->in[I_BFF] + l * 8;
    for (int u = bid; u < 8 + NSB * 8; u += nb) {
        __syncthreads();
        if (u < 8) { const int h = u; const float bb = bff[h]; float v[16]; float run = 0.f;
#pragma unroll
            for (int i = 0; i < 16; ++i) { const int t = tid * 16 + i; const float x = logsigmoid_f(SIDE[(size_t)t * 32 + 16 + h] + bb); out_[O_LFP + ((size_t)l * TP + t) * 8 + h] = x; run += x; v[i] = run; }
            const float off = block_excl_offset(run, tid, tot);
#pragma unroll
            for (int i = 0; i < 16; ++i) CKP[(size_t)h * TP + tid * 16 + i] = v[i] + off;
        } else { const int bh = u - 8, b = bh >> 3, h = bh & 7; const float bb = bff[h]; float v[3]; float run = 0.f;
#pragma unroll
            for (int i = 0; i < 3; ++i) { const int j = tid * 3 + i; float x = 0.f;
                if (j < PAST) x = kc_->in[I_CLF][(((size_t)l * NSB + b) * PAST + j) * 8 + h];
                else if (j < PAST + TS) { const int s = b * TS + (j - PAST); x = logsigmoid_f(SIDE[(size_t)(TP + s) * 32 + 16 + h] + bb); out_[O_LFS + ((size_t)l * MS + s) * 8 + h] = x; }
                run += x; v[i] = run; }
            const float off = block_excl_offset(run, tid, tot);
#pragma unroll
            for (int i = 0; i < 3; ++i) { const int j = tid * 3 + i; if (j < PAST + TS) CKS[(size_t)bh * (PAST + TS) + j] = v[i] + off; }
        }
    }
}

__device__ __forceinline__ void phase_x_to_bf16(const float* src0, const float* src1, bf16* hb, float* ss, int bid, int nb) {
    const int tid_ = otid(), lane = tid_ & 63, wave = tid_ >> 6;
    for (int m = bid * 8 + wave; m < MT; m += nb * 8) {
        const float* xr = m < TP ? src0 + (size_t)m * DM : src1 + (size_t)(m - TP) * DM; float s = 0.f;
#pragma unroll
        for (int j = 0; j < 8; ++j) { const f32x4 v = *(const f32x4*)(xr + 4 * (lane + 64 * j)); s += (v.x * v.x + v.y * v.y) + (v.z * v.z + v.w * v.w);
            u32x2v o; o.x = pk2(v.x, v.y); o.y = pk2(v.z, v.w); *(u32x2v*)(hb + (size_t)m * DM + 4 * (lane + 64 * j)) = o; }
        s = wave_sum(s); if (lane < 8) ss[(size_t)m * 8 + lane] = lane == 0 ? s : 0.f;
    }
}

namespace mx {
typedef short bf16x8 __attribute__((ext_vector_type(8)));
typedef float f32x16 __attribute__((ext_vector_type(16)));
typedef unsigned u32x4 __attribute__((ext_vector_type(4)));
__device__ __forceinline__ unsigned cvtpk(float lo, float hi) { unsigned r; asm("v_cvt_pk_bf16_f32 %0, %1, %2" : "=v"(r) : "v"(lo), "v"(hi)); return r; }
__device__ __forceinline__ bf16x8 pack8(const f32x4 a, const f32x4 b) { u32x4 w = {cvtpk(a[0], a[1]), cvtpk(a[2], a[3]), cvtpk(b[0], b[1]), cvtpk(b[2], b[3])}; return *reinterpret_cast<bf16x8*>(&w); }
__device__ __forceinline__ int crow(int r, int hi) { return (r & 3) + 8 * (r >> 2) + 4 * hi; }
__device__ __forceinline__ float ldf(const float* ubase, unsigned off) { return *(const float*)((const char*)ubase + off); }
__device__ __forceinline__ f32x4 ldf4(const float* ubase, unsigned off) { return *(const f32x4*)((const char*)ubase + off); }
__device__ __forceinline__ float logsig_fast(float x) { return fminf(x, 0.f) - __logf(1.f + __expf(-fabsf(x))); }
__device__ __forceinline__ float silu_fast(float x) { return x * __builtin_amdgcn_rcpf(1.f + __builtin_amdgcn_exp2f(-1.4426950408889634f * x)); }
#define MX_MFMA(a, b, c) __builtin_amdgcn_mfma_f32_32x32x16_bf16(a, b, c, 0, 0, 0)
__device__ __forceinline__ void ld_slab8(float (&x)[8], const float* rowbase, int pitch, unsigned voff) {
#pragma unroll
    for (int j = 0; j < 8; ++j) x[j] = ldf(rowbase + (size_t)(8 * (j >> 2) + (j & 3)) * pitch, voff);
}
__device__ __forceinline__ float bf2f(unsigned short v) { return __uint_as_float((unsigned)v << 16); }
__device__ __forceinline__ f32x4 ld4bf(const bf16* p) { const u32x2v w = *(const u32x2v*)p; return (f32x4){__uint_as_float(w.x << 16), __uint_as_float(w.x & 0xffff0000u), __uint_as_float(w.y << 16), __uint_as_float(w.y & 0xffff0000u)}; }
__device__ __forceinline__ bf16x8 ld8slot(const bf16* p) { const u32x2v a = *(const u32x2v*)p, b = *(const u32x2v*)(p + 8); u32x4 w = {a.x, a.y, b.x, b.y}; return *reinterpret_cast<bf16x8*>(&w); }
__device__ __forceinline__ unsigned short ldh(const bf16* ubase, unsigned off) { return *(const unsigned short*)((const char*)ubase + off); }
__device__ __forceinline__ void ld_slab8h(unsigned short (&x)[8], const bf16* rowbase, int pitch, unsigned voff) {
#pragma unroll
    for (int j = 0; j < 8; ++j) x[j] = ldh(rowbase + (size_t)(8 * (j >> 2) + (j & 3)) * pitch, voff);
}
__device__ __forceinline__ bf16x8 frag8h(const unsigned short (&x)[8]) { u32x4 w = {(unsigned)x[0] | ((unsigned)x[1] << 16), (unsigned)x[2] | ((unsigned)x[3] << 16), (unsigned)x[4] | ((unsigned)x[5] << 16), (unsigned)x[6] | ((unsigned)x[7] << 16)}; return *reinterpret_cast<bf16x8*>(&w); }
}

__device__ __forceinline__ int q_next(unsigned* q, int lane) { unsigned v = 0u; if (lane == 0) v = __hip_atomic_fetch_add(q, 1u, __ATOMIC_RELAXED, __HIP_MEMORY_SCOPE_AGENT); return (int)__builtin_amdgcn_readfirstlane(v); }
constexpr int CW_Q = 8192;
constexpr size_t SZ_TAB = (size_t)MT * 64 * 4;
__device__ __forceinline__ void phase_rope_tables(float* TABC, float* TABS, int bid, int nb) {
    const int tid = otid();
    for (int i = bid * 512 + tid; i < MT * 64; i += nb * 512) { const int m = i >> 6, j = i & 63; const int pos = m < TP ? m : PAST + ((m - TP) & 31);
        const float inv = powf(10000.f, -(float)j * (1.f / 64.f)); float sn, cs; sincosf((float)pos * inv, &sn, &cs); TABC[i] = cs; TABS[i] = sn; }
}
__device__ __forceinline__ void item_gla_u(KCtxP kc_, unsigned char* ws_, int l, int ug, int kb, int lane) {
    using namespace mx;
    const int slot = ug >> 2, h = ug & 3, L = slot_len(slot), tok0 = slot_tok0(slot), r32 = lane & 31, hi = lane >> 5, nlb = L >> 5;
    const bf16* PB = (const bf16*)(ws_ + WS_PROJ); const float* SIDE = (const float*)(ws_ + WS_SIDE);
    const int k = kb * 32 + r32, hk = h * 64 + k;
    const float* Wgg = kc_->in[I_WGG] + (size_t)l * 16 * 256; const float bg = kc_->in[I_BGG][l * 256 + hk];
    bf16x8 wf; { float w[8];
#pragma unroll
        for (int j = 0; j < 8; ++j) w[j] = Wgg[(8 * hi + j) * 256 + hk];
        wf = pack8((f32x4){w[0], w[1], w[2], w[3]}, (f32x4){w[4], w[5], w[6], w[7]}); }
    float la[2][16];
#pragma unroll
    for (int lb = 0; lb < 2; ++lb) {
        if (lb < nlb) { const float* gp = SIDE + (size_t)(tok0 + lb * 32 + r32) * 32 + 8 * hi;
            const bf16x8 af = pack8(*(const f32x4*)gp, *(const f32x4*)(gp + 4)); f32x16 sp = {}; sp = MX_MFMA(af, wf, sp);
#pragma unroll
            for (int r = 0; r < 16; ++r) la[lb][r] = logsig_fast(sp[r] + bg) * (1.f / 16.f); }
        else {
#pragma unroll
            for (int r = 0; r < 16; ++r) la[lb][r] = 0.f; }
    }
    float run = 0.f;
#pragma unroll
    for (int lb = 0; lb < 2; ++lb)
#pragma unroll
        for (int g = 0; g < 4; ++g) { float* v = &la[lb][4 * g]; v[1] += v[0]; v[2] += v[1]; v[3] += v[2]; const float gs = v[3], pg = __shfl_xor(gs, 32);
            const float off = run + (hi ? pg : 0.f); v[0] += off; v[1] += off; v[2] += off; v[3] += off; run += gs + pg; }
    const float tot = run;
    bf16x8 kf[4];
#pragma unroll
    for (int lb = 0; lb < 2; ++lb) {
        float kp[16];
#pragma unroll
        for (int r = 0; r < 16; ++r) kp[r] = 0.f;
        if (lb < nlb) {
#pragma unroll
            for (int r = 0; r < 16; ++r) kp[r] = bf2f(PB[(size_t)(tok0 + lb * 32 + crow(r, hi)) * PBP + PB_GK + hk]) * __expf(tot - la[lb][r]); }
        kf[2 * lb] = pack8((f32x4){kp[0], kp[1], kp[2], kp[3]}, (f32x4){kp[4], kp[5], kp[6], kp[7]});
        kf[2 * lb + 1] = pack8((f32x4){kp[8], kp[9], kp[10], kp[11]}, (f32x4){kp[12], kp[13], kp[14], kp[15]});
    }
    const unsigned voff = (unsigned)((4 * hi * PBP + r32) * 2);
    float* U = (float*)(ws_ + WS_GU);
    f32x16 acc[4];
#pragma unroll
    for (int vb = 0; vb < 4; ++vb) { acc[vb] = (f32x16){};
#pragma unroll
        for (int t = 0; t < 4; ++t) if (t < 2 * nlb) { unsigned short x[8]; ld_slab8h(x, PB + (size_t)(tok0 + 16 * t) * PBP + PB_GV + h * 128 + vb * 32, PBP, voff);
            acc[vb] = MX_MFMA(kf[t], frag8h(x), acc[vb]); }
        asm volatile("" ::: "memory"); }
    if (hi == 0) ((float*)(ws_ + WS_GDEC))[(size_t)ug * 64 + k] = __expf(tot);
    if (slot < 128) {
#pragma unroll
        for (int vb = 0; vb < 4; ++vb) { float* up = U + ((((size_t)ug * 2 + kb) * 4 + vb) * 64 + lane) * 16;
#pragma unroll
            for (int g = 0; g < 4; ++g) *(f32x4*)(up + 4 * g) = (f32x4){acc[vb][4 * g], acc[vb][4 * g + 1], acc[vb][4 * g + 2], acc[vb][4 * g + 3]}; }
    } else {
        const int b = slot - 128; float dk[16];
#pragma unroll
        for (int r = 0; r < 16; ++r) dk[r] = __expf(__shfl(tot, crow(r, hi)));
#pragma unroll
        for (int vb = 0; vb < 4; ++vb) { const float* s0p = kc_->in[I_SGLA] + (((size_t)l * NSB + b) * 4 + h) * 8192 + (size_t)(vb * 32 + r32); float s0v[16];
#pragma unroll
            for (int r = 0; r < 16; ++r) s0v[r] = s0p[(size_t)(kb * 32 + crow(r, hi)) * 128];
            float* so = kc_->out + O_GLAS + (((size_t)l * NSB + b) * 4 + h) * 8192 + (size_t)(vb * 32 + r32); unsigned short sh[16];
#pragma unroll
            for (int r = 0; r < 16; ++r) { const float S = dk[r] * s0v[r] + acc[vb][r]; so[(size_t)(kb * 32 + crow(r, hi)) * 128] = S; sh[r] = (unsigned short)f2bf(S); }
            bf16* gp = (bf16*)(ws_ + WS_GS) + ((((size_t)ug * 2 + kb) * 4 + vb) * 64 + lane) * 16;
            *(u32x4*)gp = (u32x4){(unsigned)sh[0] | ((unsigned)sh[1] << 16), (unsigned)sh[2] | ((unsigned)sh[3] << 16), (unsigned)sh[4] | ((unsigned)sh[5] << 16), (unsigned)sh[6] | ((unsigned)sh[7] << 16)};
            *(u32x4*)(gp + 8) = (u32x4){(unsigned)sh[8] | ((unsigned)sh[9] << 16), (unsigned)sh[10] | ((unsigned)sh[11] << 16), (unsigned)sh[12] | ((unsigned)sh[13] << 16), (unsigned)sh[14] | ((unsigned)sh[15] << 16)}; }
    }
}
__device__ __forceinline__ void item_ret_u(KCtxP kc_, unsigned char* ws_, int l, int ug, int kb, int lane) {
    using namespace mx;
    const int slot = ug >> 2, h = ug & 3, L = slot_len(slot), tok0 = slot_tok0(slot), r32 = lane & 31, hi = lane >> 5, nt = L >> 4;
    const bf16* PB = (const bf16*)(ws_ + WS_PROJ); const float* TABC = (const float*)(ws_ + WS_TABC); const float* TABS = (const float*)(ws_ + WS_TABS);
    const int k = kb * 32 + r32, jf = k & 63; const bool low = kb < 2; const float lg = ret_logg(h);
    const unsigned koff = (unsigned)((4 * hi * PBP + k) * 2), poff = (unsigned)((4 * hi * PBP + (k ^ 64)) * 2), toff = (unsigned)((4 * hi * 64 + jf) * 4);
    bf16x8 kf[4];
#pragma unroll
    for (int t = 0; t < 4; ++t) { float y[8];
#pragma unroll
        for (int j = 0; j < 8; ++j) y[j] = 0.f;
        if (t < nt) { unsigned short xsh[8], xph[8]; float xs[8], xp[8], cs[8], sn[8];
            ld_slab8h(xsh, PB + (size_t)(tok0 + 16 * t) * PBP + PB_RK + h * 128, PBP, koff); ld_slab8h(xph, PB + (size_t)(tok0 + 16 * t) * PBP + PB_RK + h * 128, PBP, poff);
#pragma unroll
            for (int j = 0; j < 8; ++j) { xs[j] = bf2f(xsh[j]); xp[j] = bf2f(xph[j]); }
            ld_slab8(cs, TABC + (size_t)(tok0 + 16 * t) * 64, 64, toff); ld_slab8(sn, TABS + (size_t)(tok0 + 16 * t) * 64, 64, toff);
#pragma unroll
            for (int j = 0; j < 8; ++j) { const int ll = 16 * t + 8 * (j >> 2) + 4 * hi + (j & 3); const float rot = low ? xs[j] * cs[j] - xp[j] * sn[j] : xp[j] * sn[j] + xs[j] * cs[j];
                y[j] = rot * __expf(lg * (float)(L - 1 - ll)); } }
        kf[t] = pack8((f32x4){y[0], y[1], y[2], y[3]}, (f32x4){y[4], y[5], y[6], y[7]}); }
    const unsigned voff = (unsigned)((4 * hi * PBP + r32) * 2);
    float* U = (float*)(ws_ + WS_RU); bf16x8* VT = (bf16x8*)(ws_ + WS_RVT);
    f32x16 acc[4];
#pragma unroll
    for (int vb = 0; vb < 4; ++vb) { acc[vb] = (f32x16){};
#pragma unroll
        for (int t = 0; t < 4; ++t) if (t < nt) { unsigned short x[8]; ld_slab8h(x, PB + (size_t)(tok0 + 16 * t) * PBP + PB_RV + h * 128 + vb * 32, PBP, voff);
            const bf16x8 vf = frag8h(x); if (kb == 0) VT[(((size_t)ug * 4 + vb) * 4 + t) * 64 + lane] = vf;
            acc[vb] = MX_MFMA(kf[t], vf, acc[vb]); }
        asm volatile("" ::: "memory"); }
    if (slot < 128) {
#pragma unroll
        for (int vb = 0; vb < 4; ++vb) { float* up = U + ((((size_t)ug * 4 + kb) * 4 + vb) * 64 + lane) * 16;
#pragma unroll
            for (int g = 0; g < 4; ++g) *(f32x4*)(up + 4 * g) = (f32x4){acc[vb][4 * g], acc[vb][4 * g + 1], acc[vb][4 * g + 2], acc[vb][4 * g + 3]}; }
    } else {
        const int b = slot - 128; const float dec = __expf(lg * 32.f);
#pragma unroll
        for (int vb = 0; vb < 4; ++vb) { const float* s0p = kc_->in[I_SRET] + (((size_t)l * NSB + b) * 4 + h) * 16384 + (size_t)(vb * 32 + r32); float s0v[16];
#pragma unroll
            for (int r = 0; r < 16; ++r) s0v[r] = s0p[(size_t)(kb * 32 + crow(r, hi)) * 128];
            float* so = kc_->out + O_RETS + (((size_t)l * NSB + b) * 4 + h) * 16384 + (size_t)(vb * 32 + r32); unsigned short sh[16];
#pragma unroll
            for (int r = 0; r < 16; ++r) { so[(size_t)(kb * 32 + crow(r, hi)) * 128] = dec * s0v[r] + acc[vb][r]; sh[r] = (unsigned short)f2bf(s0v[r]); }
            bf16* gp = (bf16*)(ws_ + WS_RSP) + ((((size_t)ug * 4 + kb) * 4 + vb) * 64 + lane) * 16;
            *(u32x4*)gp = (u32x4){(unsigned)sh[0] | ((unsigned)sh[1] << 16), (unsigned)sh[2] | ((unsigned)sh[3] << 16), (unsigned)sh[4] | ((unsigned)sh[5] << 16), (unsigned)sh[6] | ((unsigned)sh[7] << 16)};
            *(u32x4*)(gp + 8) = (u32x4){(unsigned)sh[8] | ((unsigned)sh[9] << 16), (unsigned)sh[10] | ((unsigned)sh[11] << 16), (unsigned)sh[12] | ((unsigned)sh[13] << 16), (unsigned)sh[14] | ((unsigned)sh[15] << 16)}; }
    }
}
__device__ __forceinline__ void phase_mix_u(const Ctx& c, int l, int bid, int nb) {
    OPQ_PTRS; (void)out_;
    const int tid = otid(), lane = tid & 63, skip = nb > 16 ? 8 : 0;
    const int gw = (bid - skip) * 8 + __builtin_amdgcn_readfirstlane(tid >> 6), ngw = (nb - skip) * 8;
    constexpr int N_G = NSLOT * 4 * 2, N_R = NSLOT * 4 * 4;
    if (bid >= skip)
    for (int it = gw; it < N_G + N_R; it += ngw) {
        if (it < N_R) item_ret_u(kc_, ws_, l, it >> 2, it & 3, lane);
        else { const int r = it - N_R; item_gla_u(kc_, ws_, l, r >> 1, r & 1, lane); }
    }
}
__device__ __forceinline__ void phase_scans(const Ctx& c, int l, int bid, int nb) {
    OPQ_PTRS;
    const int tid = otid();
    const float* GU = (const float*)(ws_ + WS_GU); const float* GDEC = (const float*)(ws_ + WS_GDEC); bf16* GS = (bf16*)(ws_ + WS_GS);
    const float* RU = (const float*)(ws_ + WS_RU); bf16* RS = (bf16*)(ws_ + WS_RSP);
    constexpr int EG = 4 * 64 * 128, ER = 4 * 128 * 128, WG = EG / 512, WR = ER / 512;
    for (int w = bid; w < WG + WR; w += nb) {
        if (w < WG) { const int e = w * 512 + tid, h = e >> 13, ee = e & 8191;
            const int r = ee & 15, ln = (ee >> 4) & 63, vb = (ee >> 10) & 3, kb = ee >> 12, k = kb * 32 + mx::crow(r, ln >> 5), v = vb * 32 + (ln & 31), hk = h * 64 + k;
            float S = 0.f;
            for (int c0 = 0; c0 < 128; c0 += 32) { float uu[32], dd[32];
#pragma unroll
                for (int i = 0; i < 32; ++i) { uu[i] = GU[(size_t)(c0 + i) * EG + e]; dd[i] = GDEC[(size_t)(c0 + i) * 256 + hk]; }
#pragma unroll
                for (int i = 0; i < 32; ++i) { S = dd[i] * S + uu[i]; GS[(size_t)(c0 + i) * EG + e] = (bf16)f2bf(S); } }
            out_[O_GLAP + (size_t)l * EG + h * 8192 + k * 128 + v] = S;
        } else { const int e = (w - WG) * 512 + tid, h = e >> 14, ee = e & 16383;
            const int r = ee & 15, ln = (ee >> 4) & 63, vb = (ee >> 10) & 3, kb = ee >> 12, k = kb * 32 + mx::crow(r, ln >> 5), v = vb * 32 + (ln & 31); const float lg = ret_logg(h);
            const float dec = __expf(lg * 64.f); float S = 0.f;
            for (int c0 = 0; c0 < 128; c0 += 32) { float uu[32];
#pragma unroll
                for (int i = 0; i < 32; ++i) uu[i] = RU[(size_t)(c0 + i) * ER + e];
#pragma unroll
                for (int i = 0; i < 32; ++i) { RS[(size_t)(c0 + i) * ER + e] = (bf16)f2bf(S); S = dec * S + uu[i]; } }
            out_[O_RETP + (size_t)l * ER + h * 16384 + k * 128 + v] = S;
        }
    }
}
__device__ __forceinline__ void item_gla_o(KCtxP kc_, unsigned char* ws_, int l, int ug, int lh, int lane, const LAS float* gains) {
    using namespace mx;
    const int slot = ug >> 2, h = ug & 3, tok = slot_tok0(slot) + lh * 32 + (lane & 31), hi = lane >> 5;
    const bf16* PB = (const bf16*)(ws_ + WS_PROJ); const bf16* GS = (const bf16*)(ws_ + WS_GS);
    const bf16* qp = PB + (size_t)tok * PBP + PB_GQ + h * 64 + 4 * hi;
    u32x2v graw[16];
    { const bf16* gate = PB + (size_t)tok * PBP + PB_GG + h * 128 + 4 * hi;
#pragma unroll
      for (int i = 0; i < 16; ++i) graw[i] = *(const u32x2v*)(gate + (i >> 2) * 32 + 8 * (i & 3)); }
    bf16x8 qf[4];
#pragma unroll
    for (int s = 0; s < 4; ++s) qf[s] = ld8slot(qp + 16 * s);
    f32x16 acc[4];
#pragma unroll
    for (int vb = 0; vb < 4; ++vb) { acc[vb] = (f32x16){};
#pragma unroll
        for (int kb = 0; kb < 2; ++kb)
#pragma unroll
            for (int t = 0; t < 2; ++t) acc[vb] = MX_MFMA(*(const bf16x8*)(GS + ((((size_t)ug * 2 + kb) * 4 + vb) * 64 + lane) * 16 + 8 * t), qf[2 * kb + t], acc[vb]); }
    float ss = 0.f;
#pragma unroll
    for (int vb = 0; vb < 4; ++vb)
#pragma unroll
        for (int r = 0; r < 16; ++r) ss += acc[vb][r] * acc[vb][r];
    ss += __shfl_xor(ss, 32);
    const float rn = rsqrtf(ss * (1.f / 128.f) + EPS);
    bf16* op = (bf16*)(ws_ + WS_MRG) + (size_t)tok * DM + h * 128 + 4 * hi; const LAS float* gl = gains + 4 * hi;
    u32x2v w[16];
#pragma unroll
    for (int vb = 0; vb < 4; ++vb)
#pragma unroll
        for (int g = 0; g < 4; ++g) { const u32x2v gr = graw[vb * 4 + g]; const f32x4 gt = {__uint_as_float(gr.x << 16), __uint_as_float(gr.x & 0xffff0000u), __uint_as_float(gr.y << 16), __uint_as_float(gr.y & 0xffff0000u)};
            const f32x4 gn = *(const LAS f32x4*)(gl + vb * 32 + 8 * g);
            w[vb * 4 + g].x = cvtpk(acc[vb][4 * g] * rn * gn[0] * silu_fast(gt[0]), acc[vb][4 * g + 1] * rn * gn[1] * silu_fast(gt[1]));
            w[vb * 4 + g].y = cvtpk(acc[vb][4 * g + 2] * rn * gn[2] * silu_fast(gt[2]), acc[vb][4 * g + 3] * rn * gn[3] * silu_fast(gt[3])); }
#pragma unroll
    for (int vb = 0; vb < 4; ++vb)
#pragma unroll
        for (int g = 0; g < 4; ++g) *(u32x2v*)(op + vb * 32 + 8 * g) = w[vb * 4 + g];
}
__device__ __forceinline__ void rope_frags(mx::bf16x8 (&f)[8], const bf16* xr, const float* tc, const float* ts) {
    using namespace mx;
#pragma unroll
    for (int kb = 0; kb < 2; ++kb)
#pragma unroll
        for (int t = 0; t < 2; ++t) { const int o = kb * 32 + 16 * t;
            const f32x4 a0 = ld4bf(xr + o), a1 = ld4bf(xr + o + 8), b0 = ld4bf(xr + 64 + o), b1 = ld4bf(xr + 64 + o + 8);
            const f32x4 c0 = *(const f32x4*)(tc + o), c1 = *(const f32x4*)(tc + o + 8), s0 = *(const f32x4*)(ts + o), s1 = *(const f32x4*)(ts + o + 8);
            f[2 * kb + t] = pack8(a0 * c0 - b0 * s0, a1 * c1 - b1 * s1); f[2 * (kb + 2) + t] = pack8(a0 * s0 + b0 * c0, a1 * s1 + b1 * c1); }
}
__device__ __forceinline__ void item_ret_o(KCtxP kc_, unsigned char* ws_, int l, int ug, int lh, int lane, const LAS float* gains) {
    using namespace mx;
    const int slot = ug >> 2, h = ug & 3, L = slot_len(slot), tok0 = slot_tok0(slot), r32 = lane & 31, hi = lane >> 5, lq = lh * 32 + r32, tok = tok0 + lq, nsb = L >> 5;
    const bf16* PB = (const bf16*)(ws_ + WS_PROJ); const float* TABC = (const float*)(ws_ + WS_TABC); const float* TABS = (const float*)(ws_ + WS_TABS);
    const bf16* RS = (const bf16*)(ws_ + WS_RSP); const bf16x8* VT = (const bf16x8*)(ws_ + WS_RVT);
    const float lg2 = ret_logg(h) * 1.4426950408889634f;
    u32x2v graw[16];
    { const bf16* gate = PB + (size_t)tok * PBP + PB_RG + h * 128 + 4 * hi;
#pragma unroll
      for (int i = 0; i < 16; ++i) graw[i] = *(const u32x2v*)(gate + (i >> 2) * 32 + 8 * (i & 3)); }
    bf16x8 qf[8];
    rope_frags(qf, PB + (size_t)tok * PBP + PB_RQ + h * 128 + 4 * hi, TABC + (size_t)tok * 64 + 4 * hi, TABS + (size_t)tok * 64 + 4 * hi);
    f32x16 acc[4];
#pragma unroll
    for (int vb = 0; vb < 4; ++vb) { acc[vb] = (f32x16){};
#pragma unroll
        for (int kb = 0; kb < 4; ++kb)
#pragma unroll
            for (int t = 0; t < 2; ++t) acc[vb] = MX_MFMA(*(const bf16x8*)(RS + ((((size_t)ug * 4 + kb) * 4 + vb) * 64 + lane) * 16 + 8 * t), qf[2 * kb + t], acc[vb]); }
    { const float qi = __builtin_amdgcn_exp2f(lg2 * (float)(lq + 1));
#pragma unroll
      for (int vb = 0; vb < 4; ++vb)
#pragma unroll
          for (int r = 0; r < 16; ++r) acc[vb][r] *= qi; }
#pragma unroll
    for (int sb = 0; sb < 2; ++sb) if (sb < nsb) {
        const int ts = tok0 + sb * 32 + r32; bf16x8 kf[8];
        rope_frags(kf, PB + (size_t)ts * PBP + PB_RK + h * 128 + 4 * hi, TABC + (size_t)ts * 64 + 4 * hi, TABS + (size_t)ts * 64 + 4 * hi);
        f32x16 sc = {};
#pragma unroll
        for (int s = 0; s < 8; ++s) sc = MX_MFMA(kf[s], qf[s], sc);
#pragma unroll
        for (int r = 0; r < 16; ++r) { const int sd = lq - (sb * 32 + crow(r, hi)); sc[r] *= __builtin_amdgcn_exp2f(lg2 * (float)(sd < 0 ? -sd : sd)); }
        const bf16x8 p0 = pack8((f32x4){sc[0], sc[1], sc[2], sc[3]}, (f32x4){sc[4], sc[5], sc[6], sc[7]}), p1 = pack8((f32x4){sc[8], sc[9], sc[10], sc[11]}, (f32x4){sc[12], sc[13], sc[14], sc[15]});
#pragma unroll
        for (int vb = 0; vb < 4; ++vb) { acc[vb] = MX_MFMA(VT[(((size_t)ug * 4 + vb) * 4 + 2 * sb) * 64 + lane], p0, acc[vb]); acc[vb] = MX_MFMA(VT[(((size_t)ug * 4 + vb) * 4 + 2 * sb + 1) * 64 + lane], p1, acc[vb]); }
    }
    float sm = 0.f;
#pragma unroll
    for (int vb = 0; vb < 4; ++vb)
#pragma unroll
        for (int r = 0; r < 16; ++r) sm += acc[vb][r];
    sm += __shfl_xor(sm, 32); const float mean = sm * (1.f / 128.f); float sq = 0.f;
#pragma unroll
    for (int vb = 0; vb < 4; ++vb)
#pragma unroll
        for (int r = 0; r < 16; ++r) { acc[vb][r] -= mean; sq += acc[vb][r] * acc[vb][r]; }
    sq += __shfl_xor(sq, 32);
    const float rn = rsqrtf(sq * (1.f / 128.f) + EPS);
    bf16* op = (bf16*)(ws_ + WS_MRG) + (size_t)tok * DM + 512 + h * 128 + 4 * hi; const LAS float* gl = gains + 128 + 4 * hi;
    u32x2v w[16];
#pragma unroll
    for (int vb = 0; vb < 4; ++vb)
#pragma unroll
        for (int g = 0; g < 4; ++g) { const u32x2v gr = graw[vb * 4 + g]; const f32x4 gt = {__uint_as_float(gr.x << 16), __uint_as_float(gr.x & 0xffff0000u), __uint_as_float(gr.y << 16), __uint_as_float(gr.y & 0xffff0000u)};
            const f32x4 gn = *(const LAS f32x4*)(gl + vb * 32 + 8 * g);
            w[vb * 4 + g].x = cvtpk(acc[vb][4 * g] * rn * gn[0] * silu_fast(gt[0]), acc[vb][4 * g + 1] * rn * gn[1] * silu_fast(gt[1]));
            w[vb * 4 + g].y = cvtpk(acc[vb][4 * g + 2] * rn * gn[2] * silu_fast(gt[2]), acc[vb][4 * g + 3] * rn * gn[3] * silu_fast(gt[3])); }
#pragma unroll
    for (int vb = 0; vb < 4; ++vb)
#pragma unroll
        for (int g = 0; g < 4; ++g) *(u32x2v*)(op + vb * 32 + 8 * g) = w[vb * 4 + g];
}
__device__ __forceinline__ void phase_mix_o(const Ctx& c, int l, LAS unsigned char* lds, int bid, int nb) {
    OPQ_PTRS; (void)out_;
    LAS float* gains = (LAS float*)(lds + 135168);
    __syncthreads();
    if (threadIdx.x < 256) gains[threadIdx.x] = threadIdx.x < 128 ? kc_->in[I_GGLA][l * 128 + threadIdx.x] : kc_->in[I_GRET][l * 128 + threadIdx.x - 128];
    __syncthreads();
    const int tid = otid(), lane = tid & 63, wv = __builtin_amdgcn_readfirstlane(tid >> 6);
    constexpr int N_H = 128 * 4 * 2 + NSB * 4;
    const int nslots = nb * 8, s0 = bid * 8 + wv, ns = 1;
    for (int j = 0; ; ++j) { const int it = s0 + (ns == 2 ? (j & 1) + (j >> 1) * nslots : j * nslots); if (it >= 2 * N_H) break;
        const int r = it < N_H ? it : it - N_H; int ug, lh;
        if (r < 128 * 4 * 2) { ug = r >> 1; lh = r & 1; } else { ug = 128 * 4 + (r - 128 * 4 * 2); lh = 0; }
        if (it < N_H) item_ret_o(kc_, ws_, l, ug, lh, lane, gains); else item_gla_o(kc_, ws_, l, ug, lh, lane, gains);
    }
}

namespace fa {
typedef short bf16x8 __attribute__((ext_vector_type(8)));
typedef short s16x4 __attribute__((ext_vector_type(4)));
typedef float f32x16 __attribute__((ext_vector_type(16)));
typedef float f32x4 __attribute__((ext_vector_type(4)));
typedef unsigned u32x4 __attribute__((ext_vector_type(4)));
constexpr int D = 128, NW = 8, QBLK = 32, KVBLK = 64, QB = NW * QBLK;
constexpr int PQ = 1024;
constexpr int PO = 2048;
constexpr int SHM_V = KVBLK * D * 2, SHM_K = KVBLK * D * 2;
constexpr int OFF_WS = 2 * SHM_V + 2 * SHM_K;
constexpr int OFF_TAB = OFF_WS + NW * 64 * 4;
constexpr int LDS_NEED = OFF_TAB + 8192 * 4;
constexpr float SCALE = 0.08838834764831845f, THR = 16.f;
constexpr unsigned WBIG = 0x40000000u;

#define KSWZ(row, colB) ((row) * 256 + ((colB) ^ (((row) & 7) << 4)))
#define SBAR() __builtin_amdgcn_sched_barrier(0)
__device__ __forceinline__ int v_st(int k, int c) { const int kk = (k & ~0xC) | ((k & 4) << 1) | ((k & 8) >> 1); return ((kk >> 3) * 4 + (c >> 5)) * 512 + ((kk & 7) * 32 + (c & 31)) * 2; }
__device__ __forceinline__ int v_rd_base(int lane) { return ((lane & 3) << 3) | (((lane >> 2) & 3) << 6) | (((lane >> 4) & 1) << 5) | (((lane >> 5) & 1) << 8); }
constexpr int v_rd_off(int d0, int ks, int half) { return d0 * 512 + ks * 4096 + half * 2048; }
__device__ __forceinline__ int crow(int r, int hi) { return (r & 3) + 8 * (r >> 2) + 4 * hi; }
__device__ __forceinline__ unsigned cvtpk(float lo, float hi) { unsigned r; asm volatile("v_cvt_pk_bf16_f32 %0, %1, %2" : "=v"(r) : "v"(lo), "v"(hi)); return r; }
__device__ __forceinline__ bf16x8 load8(const bf16* p) { return *reinterpret_cast<const bf16x8*>(p); }
__device__ __forceinline__ void mask_tile(f32x16& p0, f32x16& p1, int dq, unsigned W) {
    const float NEG = -__builtin_inff();
#pragma unroll
    for (int r = 0; r < 16; ++r) {
        const int c = (r & 3) + 8 * (r >> 2);
        if ((unsigned)(dq - c) >= W) p0[r] = NEG;
        if ((unsigned)(dq - c - 32) >= W) p1[r] = NEG;
    }
}
__device__ __forceinline__ void partialSM(f32x16& p0, f32x16& p1, float& m_reg, float& mn, float& alpha) {
    float pmax = p0[0];
#pragma unroll
    for (int r = 1; r < 16; ++r) pmax = fmaxf(pmax, p0[r]);
#pragma unroll
    for (int r = 0; r < 16; ++r) pmax = fmaxf(pmax, p1[r]);
    { auto rr = __builtin_amdgcn_permlane32_swap(__float_as_uint(pmax), __float_as_uint(pmax), false, false);
      pmax = fmaxf(__uint_as_float(rr[0]), __uint_as_float(rr[1])); }
    constexpr float C2 = 1.4426950408889634f * SCALE;
    if (__builtin_expect(__all((pmax - m_reg) * SCALE <= THR), 1)) { mn = m_reg; alpha = 1.f; }
    else { mn = fmaxf(m_reg, pmax); alpha = __builtin_amdgcn_exp2f((m_reg - mn) * C2); m_reg = mn; }
    const float mnL = -mn * C2;
#pragma unroll
    for (int r = 0; r < 16; ++r) p0[r] = fmaf(p0[r], C2, mnL);
#pragma unroll
    for (int r = 0; r < 16; ++r) p1[r] = fmaf(p1[r], C2, mnL);
#pragma unroll
    for (int r = 0; r < 16; ++r) p0[r] = __builtin_amdgcn_exp2f(p0[r]);
}
__device__ __forceinline__ void finishSM(f32x16& p0, f32x16& p1, float alpha, float& l_reg, bf16x8& pa0, bf16x8& pa1, bf16x8& pa2, bf16x8& pa3) {
#pragma unroll
    for (int r = 0; r < 16; ++r) p1[r] = __builtin_amdgcn_exp2f(p1[r]);
    float ps = 0;
#pragma unroll
    for (int r = 0; r < 16; ++r) ps += p0[r];
#pragma unroll
    for (int r = 0; r < 16; ++r) ps += p1[r];
    { auto rr = __builtin_amdgcn_permlane32_swap(__float_as_uint(ps), __float_as_uint(ps), false, false);
      ps = __uint_as_float(rr[0]) + __uint_as_float(rr[1]); }
    l_reg = l_reg * alpha + ps;
#define PK4(P, B_, OUT) do { unsigned a0 = cvtpk(P[B_+0], P[B_+1]), a1 = cvtpk(P[B_+2], P[B_+3]);                          \
        unsigned b0 = cvtpk(P[B_+4], P[B_+5]), b1 = cvtpk(P[B_+6], P[B_+7]);                                             \
        auto r0 = __builtin_amdgcn_permlane32_swap(a0, b0, false, false); auto r1 = __builtin_amdgcn_permlane32_swap(a1, b1, false, false); \
        u32x4 w = {r0[0], r1[0], r0[1], r1[1]}; OUT = *reinterpret_cast<bf16x8*>(&w); } while (0)
    PK4(p0, 0, pa0); PK4(p0, 8, pa1); PK4(p1, 0, pa2); PK4(p1, 8, pa3);
#undef PK4
}
template <int KB>
__device__ __forceinline__ void qkt(f32x16& p0, f32x16& p1, const LAS char* K_lds, int r32, int hi, const bf16x8* qr, const LAS float* tb) {
    { const f32x4 a0 = *(const LAS f32x4*)(tb), a1 = *(const LAS f32x4*)(tb + 8), a2 = *(const LAS f32x4*)(tb + 16), a3 = *(const LAS f32x4*)(tb + 24);
      const f32x4 b0 = *(const LAS f32x4*)(tb + 32), b1 = *(const LAS f32x4*)(tb + 40), b2 = *(const LAS f32x4*)(tb + 48), b3 = *(const LAS f32x4*)(tb + 56);
      p0 = (f32x16){a0[0], a0[1], a0[2], a0[3], a1[0], a1[1], a1[2], a1[3], a2[0], a2[1], a2[2], a2[3], a3[0], a3[1], a3[2], a3[3]};
      p1 = (f32x16){b0[0], b0[1], b0[2], b0[3], b1[0], b1[1], b1[2], b1[3], b2[0], b2[1], b2[2], b2[3], b3[0], b3[1], b3[2], b3[3]}; }
    int kx = ((r32 >> 1) & 3) << 5; const int kb0 = r32 * 256 + ((hi * 16) ^ ((r32 & 1) << 4)); asm volatile("" : "+v"(kx));
#pragma unroll
    for (int d0 = 0; d0 < 8; ++d0) { const LAS char* a = K_lds + KB * SHM_K + (d0 >> 2) * 128 + kb0 + (((d0 & 3) * 32) ^ kx);
        bf16x8 b0 = *reinterpret_cast<const LAS bf16x8*>(a);
        bf16x8 b1 = *reinterpret_cast<const LAS bf16x8*>(a + 32 * 256);
        p0 = __builtin_amdgcn_mfma_f32_32x32x16_bf16(b0, qr[d0], p0, 0, 0, 0);
        p1 = __builtin_amdgcn_mfma_f32_32x32x16_bf16(b1, qr[d0], p1, 0, 0, 0); }
}
template <int VB>
__device__ __forceinline__ void pv_tile(f32x16* o, int vb0, bf16x8 pa0, bf16x8 pa1, bf16x8 pa2, bf16x8 pa3) {
#define TRRD(dst, off) asm volatile("ds_read_b64_tr_b16 %0, %1 offset:%2" : "=&v"(dst) : "v"(vb0), "i"(off) : "memory")
#define PV_D0(d0) do { s16x4 l0, l1, l2, l3, h0, h1, h2, h3; constexpr int b_ = VB * SHM_V + v_rd_off(d0, 0, 0);     \
        TRRD(l0, b_); TRRD(h0, b_ + 2048); TRRD(l1, b_ + 4096); TRRD(h1, b_ + 6144); TRRD(l2, b_ + 8192); TRRD(h2, b_ + 10240); TRRD(l3, b_ + 12288); TRRD(h3, b_ + 14336); \
        asm volatile("s_waitcnt lgkmcnt(0)" ::: "memory"); SBAR();                                                         \
        o[d0] = __builtin_amdgcn_mfma_f32_32x32x16_bf16(pa0, (bf16x8){l0[0], l0[1], l0[2], l0[3], h0[0], h0[1], h0[2], h0[3]}, o[d0], 0, 0, 0);   \
        o[d0] = __builtin_amdgcn_mfma_f32_32x32x16_bf16(pa1, (bf16x8){l1[0], l1[1], l1[2], l1[3], h1[0], h1[1], h1[2], h1[3]}, o[d0], 0, 0, 0);   \
        o[d0] = __builtin_amdgcn_mfma_f32_32x32x16_bf16(pa2, (bf16x8){l2[0], l2[1], l2[2], l2[3], h2[0], h2[1], h2[2], h2[3]}, o[d0], 0, 0, 0);   \
        o[d0] = __builtin_amdgcn_mfma_f32_32x32x16_bf16(pa3, (bf16x8){l3[0], l3[1], l3[2], l3[3], h3[0], h3[1], h3[2], h3[3]}, o[d0], 0, 0, 0); } while (0)
    PV_D0(0); PV_D0(1); PV_D0(2); PV_D0(3);
#undef PV_D0
#undef TRRD
}

struct BlockRef { const bf16* Q; const bf16* K; const bf16* V; bf16* O; float* part; int P0, j_lo, j_hi; };
constexpr int PART_FLOATS = 256 * 128 + 512;
struct Seam { bf16x8 qr[8]; bf16x8 st_v0, st_v1, st_k0, st_k1; };
__device__ __forceinline__ bf16x8 ld16(const bf16* base, unsigned off) { return *reinterpret_cast<const bf16x8*>((const char*)base + off); }
#define VMW() asm volatile("s_waitcnt vmcnt(0)" ::: "memory")
#define VMWN(n) asm volatile("s_waitcnt vmcnt(%0)" :: "i"(n) : "memory")
#define SLOAD_H(Kp, Vp, k0) do { S.st_v0 = ld16((Vp) + (size_t)(k0) * PQ, lo_kv); S.st_v1 = ld16((Vp) + (size_t)((k0) + 32) * PQ, lo_kv);              \
                         S.st_k0 = ld16((Kp) + (size_t)(k0) * PQ, lo_kv); S.st_k1 = ld16((Kp) + (size_t)((k0) + 32) * PQ, lo_kv); } while (0)
#define SWRITE_HK(bf) do { *(LAS bf16x8*)(K_lds + (bf) * SHM_K + kws) = S.st_k0; *(LAS bf16x8*)(K_lds + (bf) * SHM_K + kws + 32 * 256) = S.st_k1; } while (0)
#define SWRITE_HV(bf) do { *(LAS bf16x8*)(V_lds + (bf) * SHM_V + vst0) = S.st_v0; *(LAS bf16x8*)(V_lds + (bf) * SHM_V + vst0 + 8192) = S.st_v1; } while (0)
#define SWRITE_H(bf) do { SWRITE_HV(bf); SWRITE_HK(bf); } while (0)
__device__ __forceinline__ void prime(const BlockRef& cur, LAS char* lds, Seam& S, int tid) {
    const int wid = __builtin_amdgcn_readfirstlane(tid >> 6), lane = tid & 63, r32 = lane & 31, hi = lane >> 5;
    const int sr = tid >> 4, sc = (tid & 15) * 8, kws = KSWZ(sr, sc * 2); LAS char* K_lds = lds + 2 * SHM_V;
    const unsigned lo_kv = (unsigned)((sr * PQ + sc) * 2), lo_q = (unsigned)(((wid * QBLK + r32) * PQ + hi * 8) * 2);
    const int kb0 = cur.j_lo * KVBLK;
#pragma unroll
    for (int d0 = 0; d0 < 8; ++d0) S.qr[d0] = ld16(cur.Q + d0 * 16, lo_q);
    SLOAD_H(cur.K, cur.V, kb0); VMW(); SWRITE_HK(0);
    __syncthreads();
}
__device__ __forceinline__ void block(const BlockRef& cur, const BlockRef& nxt, LAS char* lds, Seam& S, const float* gout, int tid) {
    const int wid = __builtin_amdgcn_readfirstlane(tid >> 6), lane = tid & 63, r32 = lane & 31, hi = lane >> 5;
    const int j_lo = cur.j_lo, NT = cur.j_hi - cur.j_lo;
    const int kbn = nxt.j_lo * KVBLK;
    const int qlo = cur.P0 + wid * QBLK;
    LAS char* V_lds = lds; LAS char* K_lds = lds + 2 * SHM_V;
    LAS float* ws = (LAS float*)(lds + OFF_WS) + wid * 64; LAS float* li_l = ws; LAS float* al_l = ws + 32;
    const LAS float* tab = (const LAS float*)(lds + OFF_TAB) + 4 * hi;
    float m_reg = -1e30f, l_reg = 0; f32x16 o[4] = {};
    const int sr = tid >> 4, sc = (tid & 15) * 8, vst0 = v_st(sr, sc), kws = KSWZ(sr, sc * 2);
    const int vb0 = (int)(uintptr_t)V_lds + v_rd_base(lane);
    const unsigned lo_kv = (unsigned)((sr * PQ + sc) * 2);
    const bf16* Kh = cur.K; const bf16* Vh = cur.V;
#define RESC(a) do { if (__any((a) < 1.f)) { if (hi == 0) al_l[r32] = (a); asm volatile("s_waitcnt lgkmcnt(0)" ::: "memory");              \
                     for (int d_ = 0; d_ < 4; ++d_) for (int r = 0; r < 16; ++r) o[d_][r] *= al_l[crow(r, hi)]; } } while (0)
#define KBASE(t) ((j_lo + (t)) * KVBLK)
#define MASKT(P0_, P1_, t) do { const int kb_ = KBASE(t); if (kb_ + KVBLK - 1 > qlo) { const int t_ = otid(); mask_tile(P0_, P1_, qlo + (t_ & 31) - 4 * ((t_ >> 5) & 1) - kb_, WBIG); } } while (0)
    constexpr int NQL = 8;
#define SEAM_K0() do { VMWN(NQL); SWRITE_HK(0); SBAR(); } while (0)
    f32x16 pA0, pA1, pB0, pB1; float mnA, mnB, alA, alB; bf16x8 pa0, pa1, pa2, pa3;
    SWRITE_HV(0); SBAR();
    if (NT > 1) { SLOAD_H(Kh, Vh, KBASE(1)); }
    SBAR(); qkt<0>(pA0, pA1, K_lds, r32, hi, S.qr, tab + KBASE(0));
    MASKT(pA0, pA1, 0); partialSM(pA0, pA1, m_reg, mnA, alA);
    if (NT > 1) { VMW(); SWRITE_H(1); }
    __syncthreads();
#define HALF_STEP(PX0, PX1, mnX, alX, PY0, PY1, alY, t, KB, VB, SB) do {                                                      \
        SBAR(); qkt<KB>(PX0, PX1, K_lds, r32, hi, S.qr, tab + KBASE(t));                                                      \
        finishSM(PY0, PY1, alY, l_reg, pa0, pa1, pa2, pa3); SBAR();                                                           \
        if ((t) + 1 < NT) { SLOAD_H(Kh, Vh, KBASE((t) + 1)); SBAR(); }                                                        \
        pv_tile<VB>(o, vb0, pa0, pa1, pa2, pa3); MASKT(PX0, PX1, (t)); partialSM(PX0, PX1, m_reg, mnX, alX);                  \
        __syncthreads();                                                                                                      \
        if ((t) + 1 < NT) { VMW(); SWRITE_H(SB); }                                                                            \
        RESC(alX); __syncthreads(); } while (0)
    for (int t = 1; t + 1 < NT; t += 2) {
        HALF_STEP(pB0, pB1, mnB, alB, pA0, pA1, alA, t, 1, 0, 0);
        HALF_STEP(pA0, pA1, mnA, alA, pB0, pB1, alB, t + 1, 0, 1, 1);
    }
    const bool even = (NT & 1) == 0;
    if (even) { SBAR(); qkt<1>(pB0, pB1, K_lds, r32, hi, S.qr, tab + KBASE(NT - 1)); SBAR(); }
    SLOAD_H(nxt.K, nxt.V, kbn); SBAR();
    { const int t_ = otid(); const unsigned lo_q = (unsigned)((((t_ >> 6) * QBLK + (t_ & 31)) * PQ + ((t_ >> 5) & 1) * 8) * 2);
#pragma unroll
      for (int d0 = 0; d0 < 8; ++d0) S.qr[d0] = ld16(nxt.Q + d0 * 16, lo_q); }
    SBAR();
    finishSM(pA0, pA1, alA, l_reg, pa0, pa1, pa2, pa3); SBAR();
    pv_tile<0>(o, vb0, pa0, pa1, pa2, pa3);
    if (even) { MASKT(pB0, pB1, NT - 1); partialSM(pB0, pB1, m_reg, mnB, alB); __syncthreads(); RESC(alB);
        finishSM(pB0, pB1, alB, l_reg, pa0, pa1, pa2, pa3); SBAR(); pv_tile<1>(o, vb0, pa0, pa1, pa2, pa3); }
    SBAR(); SEAM_K0();
    const int te = otid(), r32e = te & 31, hie = (te >> 5) & 1;
    if (cur.part) {
        float* pb = cur.part; const unsigned lo_p = (unsigned)((((te >> 6) * QBLK + 4 * hie) * 128 + r32e) * 4);
#pragma unroll
        for (int r = 0; r < 16; ++r) { const float* prow = pb + ((r & 3) + 8 * (r >> 2)) * 128;
#pragma unroll
            for (int d0 = 0; d0 < 4; ++d0) *(float*)((char*)prow + d0 * 128 + lo_p) = o[d0][r]; }
        if (hie == 0) { pb[256 * 128 + (te >> 6) * QBLK + r32e] = m_reg; pb[256 * 128 + 256 + (te >> 6) * QBLK + r32e] = l_reg; }
    } else {
    LAS float* li_e = (LAS float*)(lds + OFF_WS) + (te >> 6) * 64;
    if (hie == 0) li_e[r32e] = l_reg; asm volatile("s_waitcnt lgkmcnt(0)" ::: "memory");
    float gv[4];
#pragma unroll
    for (int d0 = 0; d0 < 4; ++d0) gv[d0] = gout[d0 * 32 + r32e];
    const unsigned lo_o = (unsigned)((((te >> 6) * QBLK + 4 * hie) * PO + r32e) * 2);
#pragma unroll
    for (int r = 0; r < 16; ++r) { const float rl = __builtin_amdgcn_rcpf(li_e[crow(r, hie)]); float s = 0.f; float v[4];
#pragma unroll
        for (int d0 = 0; d0 < 4; ++d0) { v[d0] = o[d0][r] * rl; s += v[d0] * v[d0]; }
        s += __shfl_xor(s, 1); s += __shfl_xor(s, 2); s += __shfl_xor(s, 4); s += __shfl_xor(s, 8); s += __shfl_xor(s, 16);
        const float rn = rsqrtf(s * (1.f / 128.f) + EPS);
        const bf16* orow = cur.O + (size_t)((r & 3) + 8 * (r >> 2)) * PO;
#pragma unroll
        for (int d0 = 0; d0 < 4; ++d0) { const float y = v[d0] * rn * gv[d0]; const float yn = __shfl_xor(y, 1);
            if ((r32e & 1) == 0) *(unsigned*)((char*)orow + d0 * 64 + lo_o) = cvtpk(y, yn); } }
    }
    __syncthreads();
#undef RESC
#undef KBASE
#undef MASKT
#undef SEAM_K0
#undef HALF_STEP
}
#undef VMW
#undef VMWN
#undef SLOAD_H
#undef SWRITE_HK
#undef SWRITE_HV
#undef SWRITE_H
}
__device__ __forceinline__ fa::BlockRef fa_ref(const bf16* QB, const bf16* KB, const bf16* VB, bf16* MRG, int h, int qb) {
    fa::BlockRef r; const int P0 = qb * 256;
    r.Q = QB + (size_t)P0 * 1024 + h * 128; r.K = KB + h * 128; r.V = VB + h * 128; r.O = MRG + (size_t)P0 * DM + 1024 + h * 128; r.part = nullptr;
    r.P0 = P0; r.j_lo = 0; r.j_hi = P0 / 64 + 4; return r;
}
constexpr int FA_SPLIT = 70;
__device__ __forceinline__ void phase_fox_prompt_split(const Ctx& c, int l, LAS unsigned char* lds, int bid, int nb) {
    OPQ_PTRS; (void)out_;
    const int tid = otid();
    const bf16* QB = (const bf16*)(ws_ + WS_QB); const bf16* KB = (const bf16*)(ws_ + WS_KB); const bf16* VB = (const bf16*)(ws_ + WS_VB); bf16* MRG = (bf16*)(ws_ + WS_MRG);
    const float* CKP = (const float*)(ws_ + WS_CKP); const float* gout = kc_->in[I_GFO] + l * 128; float* FP = (float*)(ws_ + WS_FPART);
    LAS float* tabw = (LAS float*)(lds + fa::OFF_TAB);
    for (int w = bid; w < 256; w += nb) {
        const int h = w >> 5, x = (w >> 1) & 15, role = w & 1, hb = h * 16 + x;
        __syncthreads();
        for (int j = tid; j < TP; j += 512) tabw[j] = CKP[(size_t)h * TP + j] * (-1.f / fa::SCALE);
        const int full = (31 - x) * 4 + 4, cut = FA_SPLIT < full - 2 ? FA_SPLIT : full - 2;
        int qb_c = 31 - x, jl_c = role ? cut : 0, jh_c = role ? full : cut; float* pt_c = FP + (size_t)(hb * 2 + role) * fa::PART_FLOATS;
        fa::Seam S;
        { fa::BlockRef cur = fa_ref(QB, KB, VB, MRG, h, qb_c); cur.j_lo = jl_c; cur.j_hi = jh_c; cur.part = pt_c; fa::prime(cur, (LAS char*)lds, S, tid); }
        for (int i = 0; ; ++i) {
            const bool last = (role == 0) || (i == 1);
            const int qb_n = last ? qb_c : x, jl_n = last ? jl_c : 0, jh_n = last ? jh_c : x * 4 + 4; float* pt_n = last ? pt_c : nullptr;
            fa::BlockRef cur = fa_ref(QB, KB, VB, MRG, h, qb_c); cur.j_lo = jl_c; cur.j_hi = jh_c; cur.part = pt_c;
            fa::BlockRef nxt = fa_ref(QB, KB, VB, MRG, h, qb_n); nxt.j_lo = jl_n; nxt.j_hi = jh_n; nxt.part = pt_n;
            fa::block(cur, nxt, (LAS char*)lds, S, gout, tid);
            if (last) break;
            qb_c = qb_n; jl_c = jl_n; jh_c = jh_n; pt_c = pt_n;
        }
    }
}
__device__ __forceinline__ void phase_fox_merge(const Ctx& c, int l, int bid, int nb) {
    OPQ_PTRS; (void)out_;
    const int tid = otid(), lane = tid & 63;
    const float* FP = (const float*)(ws_ + WS_FPART); bf16* MRG = (bf16*)(ws_ + WS_MRG); const float* gout = kc_->in[I_GFO] + l * 128;
    constexpr float C2 = 1.4426950408889634f * fa::SCALE;
    const float g0 = gout[2 * lane], g1 = gout[2 * lane + 1];
    const int gw = bid * 8 + (tid >> 6), ngw = nb * 8;
    typedef float f32x2m __attribute__((ext_vector_type(2)));
    constexpr int NR = 128 * 256;
    for (int R0 = gw; R0 < NR; R0 += 8 * ngw) {
        float ma[8], la[8], mb[8], lb[8]; f32x2m av[8], bv[8];
#pragma unroll
        for (int i = 0; i < 8; ++i) { const int R = R0 + i * ngw, Rc = R < NR ? R : NR - 1, hb = Rc >> 8, row = Rc & 255;
            const float* pa = FP + (size_t)(hb * 2) * fa::PART_FLOATS; const float* pb = pa + fa::PART_FLOATS;
            ma[i] = pa[32768 + row]; la[i] = pa[32768 + 256 + row]; mb[i] = pb[32768 + row]; lb[i] = pb[32768 + 256 + row];
            av[i] = *(const f32x2m*)(pa + row * 128 + 2 * lane); bv[i] = *(const f32x2m*)(pb + row * 128 + 2 * lane); }
        asm volatile("" ::: "memory");
#pragma unroll
        for (int i = 0; i < 8; ++i) { const int R = R0 + i * ngw, hb = R >> 8, row = R & 255, h = hb >> 4, x = hb & 15, tok = (31 - x) * 256 + row;
            const float M = fmaxf(ma[i], mb[i]), fa_ = __builtin_amdgcn_exp2f((ma[i] - M) * C2), fb_ = __builtin_amdgcn_exp2f((mb[i] - M) * C2), il = 1.f / (fa_ * la[i] + fb_ * lb[i]);
            const float y0 = (fa_ * av[i][0] + fb_ * bv[i][0]) * il, y1 = (fa_ * av[i][1] + fb_ * bv[i][1]) * il;
            const float rn = rsqrtf(wave_sum(y0 * y0 + y1 * y1) * (1.f / 128.f) + EPS);
            if (R < NR) *(unsigned*)(MRG + (size_t)tok * DM + 1024 + h * 128 + 2 * lane) = pk2(y0 * rn * g0, y1 * rn * g1); }
    }
}
__device__ __forceinline__ fa::bf16x8 pack8f(const f32x4 a, const f32x4 b) { fa::u32x4 w = {mx::cvtpk(a[0], a[1]), mx::cvtpk(a[2], a[3]), mx::cvtpk(b[0], b[1]), mx::cvtpk(b[2], b[3])}; return *reinterpret_cast<fa::bf16x8*>(&w); }
__device__ __forceinline__ float ldf(const float* ubase, unsigned off) { return *(const float*)((const char*)ubase + off); }
__device__ __forceinline__ f32x4 ldf4(const float* ubase, unsigned off) { return *(const f32x4*)((const char*)ubase + off); }
constexpr int SPART_FLOATS = 32 * 128 + 64;
__device__ __forceinline__ void phase_fox_sample_half(const Ctx& c, int l, LAS unsigned char* lds, int bid, int nb) {
    OPQ_PTRS;
    using fa::f32x16; using fa::bf16x8;
    const int tid = otid(), lane = tid & 63, wid = __builtin_amdgcn_readfirstlane(tid >> 6), r32 = lane & 31, hi = lane >> 5;
    const bf16* QB = (const bf16*)(ws_ + WS_QB); const float* CKS = (const float*)(ws_ + WS_CKS); float* SP = (float*)(ws_ + WS_SPART);
    constexpr float C2 = 1.4426950408889634f * fa::SCALE;
    LAS float* Ol = (LAS float*)lds;
    LAS float* ml = (LAS float*)(lds + 131072);
    LAS float* al = (LAS float*)(lds + 131072 + 2048) + wid * 32;
    const unsigned kvo = (unsigned)((r32 * 1024 + hi * 8) * 4), vvo = (unsigned)((hi * 8 * 1024 + r32) * 4), cko = (unsigned)(hi * 16);
    for (int u2 = bid; u2 < NSB * 8 * 2; u2 += nb) {
        const int u = u2 >> 1, half = u2 & 1, b = u >> 3, h = u & 7, tok0 = TP + b * TS, tlo = half ? 17 : 0, thi = half ? 33 : 17;
        const float* Kc = kc_->in[I_CK] + ((size_t)l * NSB + b) * PAST * 1024 + h * 128; const float* Vc = kc_->in[I_CV] + ((size_t)l * NSB + b) * PAST * 1024 + h * 128;
        const float* Kn = out_ + O_FKS + ((size_t)l * MS + b * TS) * 1024 + h * 128; const float* Vn = out_ + O_FVS + ((size_t)l * MS + b * TS) * 1024 + h * 128;
        const float* ck = CKS + (size_t)u * (PAST + TS);
        const bf16* qrow = QB + (size_t)(tok0 + r32) * 1024 + h * 128 + hi * 8;
        float m_reg = -1e30f, l_reg = 0.f; f32x16 o[4] = {};
        __syncthreads();
        for (int t = tlo + wid; t < thi; t += 8) {
            const int j0 = t * 32;
            const float* Kt = t < 32 ? Kc + (size_t)j0 * 1024 : Kn; const float* Vt = t < 32 ? Vc + (size_t)j0 * 1024 : Vn; const float* ckt = ck + j0;
            f32x16 p = {};
            { f32x4 kraw[16]; bf16x8 qr[8];
#pragma unroll
              for (int d0 = 0; d0 < 8; ++d0) { kraw[2 * d0] = ldf4(Kt + d0 * 16, kvo); kraw[2 * d0 + 1] = ldf4(Kt + d0 * 16 + 4, kvo); qr[d0] = *(const bf16x8*)(qrow + d0 * 16); }
              asm volatile("" ::: "memory");
#pragma unroll
              for (int d0 = 0; d0 < 8; ++d0) p = __builtin_amdgcn_mfma_f32_32x32x16_bf16(pack8f(kraw[2 * d0], kraw[2 * d0 + 1]), qr[d0], p, 0, 0, 0); }
            f32x4 cb[4]; float v0[32], v1[32];
#pragma unroll
            for (int g = 0; g < 4; ++g) cb[g] = ldf4(ckt + 8 * g, cko);
#pragma unroll
            for (int d0 = 0; d0 < 4; ++d0)
#pragma unroll
                for (int jj = 0; jj < 8; ++jj) { v0[d0 * 8 + jj] = ldf(Vt + (size_t)jj * 1024 + d0 * 32, vvo); v1[d0 * 8 + jj] = ldf(Vt + (size_t)(16 + jj) * 1024 + d0 * 32, vvo); }
            asm volatile("" ::: "memory");
            { const float ns = -1.f / fa::SCALE;
#pragma unroll
              for (int r = 0; r < 16; ++r) p[r] += cb[r >> 2][r & 3] * ns; }
            if (t == 32) {
#pragma unroll
                for (int r = 0; r < 16; ++r) if (fa::crow(r, hi) > r32) p[r] = -__builtin_inff(); }
            float pmax = p[0];
#pragma unroll
            for (int r = 1; r < 16; ++r) pmax = fmaxf(pmax, p[r]);
            pmax = fmaxf(pmax, __shfl_xor(pmax, 32));
            const float mn = fmaxf(m_reg, pmax), alpha = __builtin_amdgcn_exp2f((m_reg - mn) * C2); m_reg = mn;
            float ps = 0.f;
#pragma unroll
            for (int r = 0; r < 16; ++r) { p[r] = __builtin_amdgcn_exp2f((p[r] - mn) * C2); ps += p[r]; }
            ps += __shfl_xor(ps, 32);
            l_reg = l_reg * alpha + ps;
            if (hi == 0) al[r32] = alpha; asm volatile("s_waitcnt lgkmcnt(0)" ::: "memory");
#pragma unroll
            for (int d = 0; d < 4; ++d)
#pragma unroll
                for (int r = 0; r < 16; ++r) o[d][r] *= al[fa::crow(r, hi)];
            bf16x8 pa0, pa1;
#define PK4(P, B_, OUT) do { unsigned a0 = mx::cvtpk(P[B_+0], P[B_+1]), a1 = mx::cvtpk(P[B_+2], P[B_+3]); unsigned b0 = mx::cvtpk(P[B_+4], P[B_+5]), b1 = mx::cvtpk(P[B_+6], P[B_+7]); \
        auto r0 = __builtin_amdgcn_permlane32_swap(a0, b0, false, false); auto r1 = __builtin_amdgcn_permlane32_swap(a1, b1, false, false); \
        fa::u32x4 w = {r0[0], r1[0], r0[1], r1[1]}; OUT = *reinterpret_cast<bf16x8*>(&w); } while (0)
            PK4(p, 0, pa0); PK4(p, 8, pa1);
#undef PK4
#pragma unroll
            for (int d0 = 0; d0 < 4; ++d0) o[d0] = __builtin_amdgcn_mfma_f32_32x32x16_bf16(pa0, pack8f((f32x4){v0[d0 * 8], v0[d0 * 8 + 1], v0[d0 * 8 + 2], v0[d0 * 8 + 3]}, (f32x4){v0[d0 * 8 + 4], v0[d0 * 8 + 5], v0[d0 * 8 + 6], v0[d0 * 8 + 7]}), o[d0], 0, 0, 0);
#pragma unroll
            for (int d0 = 0; d0 < 4; ++d0) o[d0] = __builtin_amdgcn_mfma_f32_32x32x16_bf16(pa1, pack8f((f32x4){v1[d0 * 8], v1[d0 * 8 + 1], v1[d0 * 8 + 2], v1[d0 * 8 + 3]}, (f32x4){v1[d0 * 8 + 4], v1[d0 * 8 + 5], v1[d0 * 8 + 6], v1[d0 * 8 + 7]}), o[d0], 0, 0, 0);
        }
        if (hi == 0) { ml[wid * 32 + r32] = m_reg; ml[256 + wid * 32 + r32] = l_reg; }
#pragma unroll
        for (int d0 = 0; d0 < 4; ++d0)
#pragma unroll
            for (int r = 0; r < 16; ++r) Ol[(wid * 32 + fa::crow(r, hi)) * 128 + d0 * 32 + r32] = o[d0][r];
        __syncthreads();
        { const int row = tid >> 4, c0 = (tid & 15) * 8; float M = -1e30f;
#pragma unroll
          for (int w = 0; w < 8; ++w) M = fmaxf(M, ml[w * 32 + row]);
          float L = 0.f, acc[8];
#pragma unroll
          for (int i = 0; i < 8; ++i) acc[i] = 0.f;
#pragma unroll
          for (int w = 0; w < 8; ++w) { const float f = __builtin_amdgcn_exp2f((ml[w * 32 + row] - M) * C2); L += f * ml[256 + w * 32 + row];
              const f32x4 x0 = *(const LAS f32x4*)(Ol + (w * 32 + row) * 128 + c0), x1 = *(const LAS f32x4*)(Ol + (w * 32 + row) * 128 + c0 + 4);
              acc[0] += f * x0[0]; acc[1] += f * x0[1]; acc[2] += f * x0[2]; acc[3] += f * x0[3]; acc[4] += f * x1[0]; acc[5] += f * x1[1]; acc[6] += f * x1[2]; acc[7] += f * x1[3]; }
          float* pp = SP + (size_t)u2 * SPART_FLOATS;
          *(f32x4*)(pp + row * 128 + c0) = (f32x4){acc[0], acc[1], acc[2], acc[3]}; *(f32x4*)(pp + row * 128 + c0 + 4) = (f32x4){acc[4], acc[5], acc[6], acc[7]};
          if ((tid & 15) == 0) { pp[32 * 128 + row] = M; pp[32 * 128 + 32 + row] = L; } }
    }
}
__device__ __forceinline__ void phase_fox_sample_merge(const Ctx& c, int l, int bid, int nb) {
    OPQ_PTRS; (void)out_;
    const int tid = otid(), lane = tid & 63, gw = bid * 8 + (tid >> 6), ngw = nb * 8;
    const float* SP = (const float*)(ws_ + WS_SPART); bf16* MRG = (bf16*)(ws_ + WS_MRG); const float* gout = kc_->in[I_GFO] + l * 128;
    constexpr float C2 = 1.4426950408889634f * fa::SCALE;
    const float g0 = gout[2 * lane], g1 = gout[2 * lane + 1];
    typedef float f32x2m __attribute__((ext_vector_type(2)));
    constexpr int NR = NSB * 8 * 32;
    for (int R0 = gw; R0 < NR; R0 += 2 * ngw) {
        float ma[2], la[2], mb[2], lb[2]; f32x2m av[2], bv[2];
#pragma unroll
        for (int i = 0; i < 2; ++i) { const int R = R0 + i * ngw, Rc = R < NR ? R : NR - 1, u = Rc >> 5, row = Rc & 31;
            const float* pa = SP + (size_t)(2 * u) * SPART_FLOATS; const float* pb = pa + SPART_FLOATS;
            ma[i] = pa[4096 + row]; la[i] = pa[4096 + 32 + row]; mb[i] = pb[4096 + row]; lb[i] = pb[4096 + 32 + row];
            av[i] = *(const f32x2m*)(pa + row * 128 + 2 * lane); bv[i] = *(const f32x2m*)(pb + row * 128 + 2 * lane); }
        asm volatile("" ::: "memory");
#pragma unroll
        for (int i = 0; i < 2; ++i) { const int R = R0 + i * ngw, u = R >> 5, row = R & 31, b = u >> 3, h = u & 7, tok = TP + b * TS + row;
            const float M = fmaxf(ma[i], mb[i]), fa_ = __builtin_amdgcn_exp2f((ma[i] - M) * C2), fb_ = __builtin_amdgcn_exp2f((mb[i] - M) * C2), il = 1.f / (fa_ * la[i] + fb_ * lb[i]);
            const float y0 = (fa_ * av[i][0] + fb_ * bv[i][0]) * il, y1 = (fa_ * av[i][1] + fb_ * bv[i][1]) * il;
            const float rn = rsqrtf(wave_sum(y0 * y0 + y1 * y1) * (1.f / 128.f) + EPS);
            if (R < NR) *(unsigned*)(MRG + (size_t)tok * DM + 1024 + h * 128 + 2 * lane) = pk2(y0 * rn * g0, y1 * rn * g1); }
    }
}
#define XB_TMO      128
#define XB_XCNT(j)  (256  + 64 * (j))
#define XB_XSUB(j)  (1280 + 64 * (j))
#define XB_XGEN(j)  (2304 + 64 * (j))
#define XB_TOP      3328
#define XB_TOPGEN   3392
#define XCD_BAR_WORDS 3456
#define XB_SPIN_CAP (1u << 18)

__device__ __forceinline__ unsigned xb_ld(unsigned* p)              { return __hip_atomic_load(p, __ATOMIC_RELAXED, __HIP_MEMORY_SCOPE_AGENT); }
__device__ __forceinline__ unsigned xb_add(unsigned* p, unsigned v) { return __hip_atomic_fetch_add(p, v, __ATOMIC_RELAXED, __HIP_MEMORY_SCOPE_AGENT); }
__device__ __forceinline__ unsigned xb_xcc_id() { return (unsigned)__builtin_amdgcn_s_getreg((3 << 11) | 20) & 0xFu; }
#define XB_SPIN(cond, bar) do { unsigned _sp = 0; while (cond) { __builtin_amdgcn_s_sleep(1); \
    if ((++_sp & 255u) == 0u) { if (xb_ld(&(bar)[XB_TMO])) break; if (_sp > XB_SPIN_CAP) { atomicAdd(&(bar)[XB_TMO], 1u); break; } } } } while (0)

struct XcdBarrier {
    unsigned* bar; unsigned x;
    volatile LAS unsigned* st;
};

__device__ __forceinline__ XcdBarrier xcd_barrier_post(unsigned* bar, volatile LAS unsigned* st) {
    XcdBarrier b; b.bar = bar; b.x = xb_xcc_id(); b.st = st;
    if (threadIdx.x == 0) (void)xb_add(&bar[XB_XCNT(b.x)], 1u);
    return b;
}
__device__ __forceinline__ void xcd_barrier_complete(unsigned* bar, unsigned x, unsigned& nloc, unsigned& nx) {
    const unsigned G = gridDim.x * gridDim.y * gridDim.z;
    unsigned sum, cnt, mine, sp = 0u;
    for (;;) {
        sum = 0u; cnt = 0u; mine = 0u;
#pragma unroll
        for (unsigned j = 0; j < 16; ++j) { const unsigned c = xb_ld(&bar[XB_XCNT(j)]); sum += c; cnt += (c > 0u) ? 1u : 0u; mine = (j == x) ? c : mine; }
        if (sum == G) break;
        __builtin_amdgcn_s_sleep(1);
        if ((++sp & 255u) == 0u) { if (xb_ld(&bar[XB_TMO])) break; if (sp > XB_SPIN_CAP) { atomicAdd(&bar[XB_TMO], 1u); break; } }
    }
    nloc = mine > 0u ? mine : 1u; nx = cnt > 0u ? cnt : 1u;
}

__device__ __forceinline__ void xcd_barrier(const XcdBarrier& b) {
    asm volatile("s_waitcnt vmcnt(0)" ::: "memory");
    __syncthreads();
    if (threadIdx.x == 0) {
        unsigned* bar = b.bar;
        __builtin_amdgcn_s_waitcnt(0);
        unsigned nloc = b.st[0], nx = b.st[1];
        if (nloc == 0u) { xcd_barrier_complete(bar, b.x, nloc, nx); b.st[0] = nloc; b.st[1] = nx; }
        const unsigned old = xb_add(&bar[XB_XSUB(b.x)], 1u);
        const unsigned gen = old / nloc;
        if (old + 1u == (gen + 1u) * nloc) {
            __builtin_amdgcn_fence(__ATOMIC_RELEASE, "agent");
            asm volatile("s_waitcnt vmcnt(0)" ::: "memory");
            const unsigned og = xb_add(&bar[XB_TOP], 1u);
            const unsigned tg = og / nx;
            if (og + 1u == (tg + 1u) * nx) xb_add(&bar[XB_TOPGEN], 1u);
            else XB_SPIN(xb_ld(&bar[XB_TOPGEN]) == tg, bar);
            __builtin_amdgcn_fence(__ATOMIC_ACQUIRE, "agent");
            xb_add(&bar[XB_XGEN(b.x)], 1u);
            asm volatile("s_waitcnt vmcnt(0)" ::: "memory");
        } else {
            XB_SPIN(xb_ld(&bar[XB_XGEN(b.x)]) == gen, bar);
            __builtin_amdgcn_fence(__ATOMIC_ACQUIRE, "agent");
            asm volatile("s_waitcnt vmcnt(0)" ::: "memory");
        }
    }
    __syncthreads();
}

constexpr int LDS_BYTES = 147456;
constexpr int MISC_OFF = LDS_BYTES - 256;
constexpr int CW_BAR = 4096;
constexpr size_t CTL_ZERO_BYTES = 1u << 20;

template <int l>
__device__ __forceinline__ void layer_body(const Ctx& c, LAS unsigned char* lds, const XcdBarrier& bar, int bid, int nb) {
    OPQ_PTRS; bf16* XN = (bf16*)(ws_ + WS_XN);
        { pg8::Gemm g{XN, (const bf16*)(ws_ + WS_WIN + l * SZ_WIN), MT, DINP, DM, DM}; pg8::StaticOrder S; S.init(MT, DINP, nb, bid); S.mix27 = true;
          pg8::EpiIn E{(bf16*)(ws_ + WS_PROJ), PBP, (float*)(ws_ + WS_SIDE), (bf16*)(ws_ + WS_QB), (bf16*)(ws_ + WS_KB), (bf16*)(ws_ + WS_VB),
                       out_ + O_FKP + (size_t)l * TP * 1024, out_ + O_FKS + (size_t)l * MS * 1024, out_ + O_FVP + (size_t)l * TP * 1024, out_ + O_FVS + (size_t)l * MS * 1024,
                       kc_->in[I_GFQ] + l * 128, kc_->in[I_GFK] + l * 128, (PG8_LAS float*)(lds + 131072), TP, EPS,
                       pg8::RowScale{(const float*)(ws_ + WS_SSP) + (size_t)(2 * l) * MT * 8, 1.f / DM, EPS, (PG8_LAS float*)(lds + 143360)}};
          pg8::gemm_phase<pg8::EpiIn, pg8::StaticOrder, true, true, false, true>(lds, g, S, E); }
        constexpr int NU_IN = (MT / 256) * (DINP / 256);
        constexpr int I_P1 = (DM / 64) * (DM / 32) + (DM / 64) * (2 * DFF / 32) + (DFF / 64) * (DM / 32);
        const int f_idle = NU_IN % nb, n_idle = f_idle ? nb - f_idle : 0, x_head = n_idle * 56 < I_P1 ? n_idle * 56 : I_P1;
        if (n_idle && bid >= f_idle) { __syncthreads(); phase_convert(c, l, lds, bid - f_idle, n_idle, 1, 0, x_head); __syncthreads(); }
        xcd_barrier(bar);
        phase_fox_cumsum2(c, l, lds, bid, nb); phase_mix_u(c, l, bid, nb);
        xcd_barrier(bar);
        phase_scans(c, l, bid, nb);
        if (bid & 1) { __syncthreads(); phase_convert(c, l, lds, bid, nb, 1, x_head); if (l + 1 < NL) phase_convert(c, l + 1, lds, bid, nb, 0); __syncthreads(); phase_fox_sample_half(c, l, lds, bid, nb); }
        phase_fox_prompt_split(c, l, lds, bid, nb);
        if (!(bid & 1)) { phase_fox_sample_half(c, l, lds, bid, nb); __syncthreads(); phase_convert(c, l, lds, bid, nb, 1, x_head); if (l + 1 < NL) phase_convert(c, l + 1, lds, bid, nb, 0); __syncthreads(); }
        xcd_barrier(bar);
        phase_fox_sample_merge(c, l, bid, nb); phase_fox_merge(c, l, bid, nb); phase_mix_o(c, l, lds, bid, nb);
        xcd_barrier(bar);
        { pg8::Gemm g{(const bf16*)(ws_ + WS_MRG), (const bf16*)(ws_ + WS_WOUT + l * SZ_WOUT), TP, DM, DM, DM, (const bf16*)(ws_ + WS_MRG) + (size_t)TP * DM}; pg8::StaticOrder S; S.init(TP, DM, nb, bid);
          typedef pg8::EpiResT<(l > 0), false> ER;
          ER E{kc_->in[I_XP], kc_->in[I_XS], TP, nullptr, DM, XN, (float*)(ws_ + WS_SSP) + (size_t)(2 * l + 1) * MT * 8, (PG8_LAS float*)(lds + 131072), XN}; pg8::gemm_phase<ER, pg8::StaticOrder, true, true, true>(lds, g, S, E); }
        xcd_barrier(bar);
        { pg8::Gemm g{XN, (const bf16*)(ws_ + WS_WGU + l * SZ_WGU), MT, 2 * DFF, DM, DM}; pg8::StaticOrder S; S.init(MT, 2 * DFF, nb, bid);
          pg8::EpiSwiGLU E{(bf16*)(ws_ + WS_ACT), DFF, pg8::RowScale{(const float*)(ws_ + WS_SSP) + (size_t)(2 * l + 1) * MT * 8, 1.f / DM, EPS, (PG8_LAS float*)(lds + 143360)}}; pg8::gemm_phase<pg8::EpiSwiGLU, pg8::StaticOrder, true, true, false, true>(lds, g, S, E); }
        xcd_barrier(bar);
        { float* dst = l == NL - 1 ? out_ + O_YP : nullptr;
          pg8::Gemm g{(const bf16*)(ws_ + WS_ACT), (const bf16*)(ws_ + WS_WDN + l * SZ_WDN), TP, DM, DFF, DFF, (const bf16*)(ws_ + WS_ACT) + (size_t)TP * DFF}; pg8::StaticOrder S; S.init(TP, DM, nb, bid);
          typedef pg8::EpiResT<true, (l == NL - 1)> ER;
          ER E{nullptr, nullptr, TP, dst, DM, l == NL - 1 ? nullptr : XN, (float*)(ws_ + WS_SSP) + (size_t)(2 * l + 2) * MT * 8, (PG8_LAS float*)(lds + 131072), XN}; pg8::gemm_phase<ER, pg8::StaticOrder, true, true, true>(lds, g, S, E); }
        if (l + 1 < NL) xcd_barrier(bar);
}

__global__ void __launch_bounds__(512, 2) fwd_mega(const Ctx c) {
    extern __shared__ __attribute__((aligned(16))) unsigned char shm[];
    LAS unsigned char* lds = (LAS unsigned char*)shm;
    const int bid = blockIdx.x, nb = gridDim.x;
    for (int u = threadIdx.x; u < (LDS_BYTES - MISC_OFF) / 4; u += 512) ((LAS unsigned*)(lds + MISC_OFF))[u] = 0u;
    __syncthreads();
    XcdBarrier bar = xcd_barrier_post((unsigned*)(kctx()->ws + WS_CTL) + CW_BAR, (volatile LAS unsigned*)(lds + MISC_OFF) + 8);
    phase_convert(c, 0, lds, bid, nb, 0);
    { OPQ_PTRS; (void)out_; phase_rope_tables((float*)(ws_ + WS_TABC), (float*)(ws_ + WS_TABS), bid, nb); }
    { OPQ_PTRS; phase_x_to_bf16(kc_->in[I_XP], kc_->in[I_XS], (bf16*)(ws_ + WS_XN), (float*)(ws_ + WS_SSP), bid, nb); (void)out_; }
    xcd_barrier(bar);
    layer_body<0>(c, lds, bar, bid, nb); layer_body<1>(c, lds, bar, bid, nb); layer_body<2>(c, lds, bar, bid, nb); layer_body<3>(c, lds, bar, bid, nb);
}

extern "C" void kernel_launch(void* const* d_in, const int* in_sizes, int n_in, void* d_out, int out_size, void* d_ws, size_t ws_size, hipStream_t stream) {
    if (n_in != N_IN || (size_t)out_size != O_END || ws_size < WS_END) { fprintf(stderr, "kernel_launch: unexpected shapes (n_in %d out %d ws %zu, need %zu)\n", n_in, out_size, ws_size, (size_t)WS_END); return; }
    Ctx c{}; for (int i = 0; i < N_IN; ++i) c.in[i] = (const float*)d_in[i]; c.out = (float*)d_out; c.ws = (unsigned char*)d_ws;
    int dev = 0, cus = 0, per_cu = 0;
    if (hipGetDevice(&dev) != hipSuccess || hipDeviceGetAttribute(&cus, hipDeviceAttributeMultiprocessorCount, dev) != hipSuccess || cus <= 0) { fprintf(stderr, "kernel_launch: device query failed\n"); return; }
    if (hipFuncSetAttribute((const void*)fwd_mega, hipFuncAttributeMaxDynamicSharedMemorySize, LDS_BYTES) != hipSuccess) { fprintf(stderr, "kernel_launch: hipFuncSetAttribute failed\n"); return; }
    if (hipOccupancyMaxActiveBlocksPerMultiprocessor(&per_cu, (const void*)fwd_mega, 512, LDS_BYTES) != hipSuccess || per_cu < 1) { fprintf(stderr, "kernel_launch: occupancy query says %d blocks per CU\n", per_cu); (void)hipGetLastError(); per_cu = 1; }
    const int grid = cus;
    (void)hipMemsetAsync((char*)d_ws + WS_CTL, 0, CTL_ZERO_BYTES, stream);
    hipLaunchKernelGGL(fwd_mega, dim3(grid), dim3(512), LDS_BYTES, stream, c);
}
```
